# Optimizing an MI355X kernel written in HIP

```python
import math
import jax, jax.numpy as jnp
from jax import lax
import numpy as np

D_MODEL = 4096
BATCH = 4
SEQ = 4096
DEPTH = 4

N_MEM = 256
EPS = 1e-6
BLOCK = 128
MIX_WIDTH = D_MODEL
X_HEADS = 4
X_HEAD_DIM = MIX_WIDTH // 4 // X_HEADS
X_WIDTH = X_HEADS * X_HEAD_DIM
SELF_WIDTH = MIX_WIDTH - X_WIDTH
A_NOPE = 128
A_ROPE = 64
A_VDIM = 128
A_HEADS = SELF_WIDTH // A_VDIM
A_Q_RANK = 1024
A_KV_RANK = 512
ROPE_THETA = 10000.0
B_HEAD_DIM = 64
B_HEADS = SELF_WIDTH // B_HEAD_DIM
B_KV_HEADS = 8
B_GROUP = B_HEADS // B_KV_HEADS
WINDOW = 128
N_BUCKETS = 32
MAX_EXACT = N_BUCKETS // 2
MAX_DIST = WINDOW
N_MIXERS = 2
N_A = (DEPTH + 1) // 2
N_B = DEPTH // 2
A_IN = A_Q_RANK + A_KV_RANK + A_ROPE + X_WIDTH + MIX_WIDTH
B_IN = B_HEADS * B_HEAD_DIM + 2 * B_KV_HEADS * B_HEAD_DIM + X_WIDTH + MIX_WIDTH

kernel_name = "hybrid_mla_swa_sink_memxattn_gated"


def rmsnorm(x, g):
    xf = x.astype(jnp.float32)
    y = xf * lax.rsqrt(jnp.mean(xf * xf, axis=-1, keepdims=True) + EPS)
    return (y * g.astype(jnp.float32)).astype(x.dtype)


def split_cols(t, sizes):
    outs, off = [], 0
    for s in sizes:
        outs.append(t[..., off:off + s])
        off += s
    return outs


def rope_tables(positions):
    inv = ROPE_THETA ** (-jnp.arange(0, A_ROPE, 2, dtype=jnp.float32) / A_ROPE)
    ang = positions.astype(jnp.float32)[..., None] * inv
    return jnp.cos(ang), jnp.sin(ang)


def apply_rope(t, cos, sin):
    tf = t.astype(jnp.float32)
    t1, t2 = tf[..., :A_ROPE // 2], tf[..., A_ROPE // 2:]
    return jnp.concatenate([t1 * cos - t2 * sin, t2 * cos + t1 * sin], axis=-1).astype(t.dtype)


def t5_bucket(dist):
    n = jnp.maximum(dist, 0)
    nf = jnp.maximum(n, 1).astype(jnp.float32)
    large = MAX_EXACT + (jnp.log(nf / MAX_EXACT) / math.log(MAX_DIST / MAX_EXACT)
                         * (N_BUCKETS - MAX_EXACT)).astype(jnp.int32)
    large = jnp.minimum(large, N_BUCKETS - 1)
    return jnp.where(n < MAX_EXACT, n, large)


def memory_attention(q, mem_k, mem_v):
    B, S = q.shape[:2]
    s = jnp.einsum('bshd,bmhd->bhsm', q, mem_k).astype(jnp.float32) * (X_HEAD_DIM ** -0.5)
    p = jax.nn.softmax(s, axis=-1).astype(mem_v.dtype)
    return jnp.einsum('bhsm,bmhd->bshd', p, mem_v).reshape(B, S, X_WIDTH)


def mla_attention(q_nope, q_rope, k_nope, k_rope, v):
    B, S = q_nope.shape[:2]
    nblk = S // BLOCK
    scale = (A_NOPE + A_ROPE) ** -0.5
    key_idx = jnp.arange(S)
    q_local = jnp.arange(BLOCK)

    def to_blocks(t):
        return t.reshape(B, nblk, BLOCK, *t.shape[2:]).swapaxes(0, 1)

    def one_block(args):
        qn, qr, blk = args
        s = (jnp.einsum('bqhd,bkhd->bhqk', qn, k_nope)
             + jnp.einsum('bqhr,bkr->bhqk', qr, k_rope)).astype(jnp.float32) * scale
        causal = key_idx[None, :] <= (blk * BLOCK + q_local)[:, None]
        s = jnp.where(causal, s, -jnp.inf)
        p = jax.nn.softmax(s, axis=-1).astype(v.dtype)
        return jnp.einsum('bhqk,bkhd->bqhd', p, v)

    out = lax.map(one_block, (to_blocks(q_nope), to_blocks(q_rope), jnp.arange(nblk)))
    return out.swapaxes(0, 1).reshape(B, S, A_HEADS * A_VDIM)


def swa_attention(q, k, v, sinks, rel_bias):
    B, S = q.shape[:2]
    nblk = S // BLOCK

    def kv_bands(t):
        tp = jnp.pad(t, ((0, 0), (BLOCK, 0), (0, 0), (0, 0)))
        blocks = tp.reshape(B, nblk + 1, BLOCK, B_KV_HEADS, B_HEAD_DIM)
        return jnp.concatenate([blocks[:, :-1], blocks[:, 1:]], axis=2).swapaxes(0, 1)

    qb = q.reshape(B, nblk, BLOCK, B_KV_HEADS, B_GROUP, B_HEAD_DIM).swapaxes(0, 1)
    q_local = jnp.arange(BLOCK)[:, None]
    k_local = jnp.arange(2 * BLOCK)[None, :]
    dist = q_local + BLOCK - k_local
    in_window = (dist >= 0) & (dist < WINDOW)
    bias = rel_bias.astype(jnp.float32)[t5_bucket(dist)]
    bias = bias.transpose(2, 0, 1).reshape(B_KV_HEADS, B_GROUP, BLOCK, 2 * BLOCK)
    sink = sinks.astype(jnp.float32).reshape(B_KV_HEADS, B_GROUP)[None, :, :, None]
    scale = B_HEAD_DIM ** -0.5

    def one_block(args):
        qblk, kblk, vblk, blk = args
        s = jnp.einsum('bqhgd,bkhd->bhgqk', qblk, kblk).astype(jnp.float32) * scale + bias
        valid = in_window & (blk * BLOCK - BLOCK + k_local >= 0)
        s = jnp.where(valid, s, -jnp.inf)
        m = jnp.maximum(jnp.max(s, axis=-1), sink)
        p = jnp.exp(s - m[..., None])
        denom = jnp.sum(p, axis=-1) + jnp.exp(sink - m)
        p = (p / denom[..., None]).astype(vblk.dtype)
        return jnp.einsum('bhgqk,bkhd->bqhgd', p, vblk)

    out = lax.map(one_block, (qb, kv_bands(k), kv_bands(v), jnp.arange(nblk)))
    return out.swapaxes(0, 1).reshape(B, S, B_HEADS * B_HEAD_DIM)


def mla_mixer(h, cos, sin, w_in, q_norm_g, kv_norm_g, w_qb, w_kvb):
    B, S, _ = h.shape
    proj = jnp.einsum('bsd,de->bse', h, w_in)
    c_q, c_kv, k_rope, xq, z = split_cols(proj, [A_Q_RANK, A_KV_RANK, A_ROPE, X_WIDTH, MIX_WIDTH])
    q = jnp.einsum('bsr,re->bse', rmsnorm(c_q, q_norm_g), w_qb).reshape(B, S, A_HEADS, A_NOPE + A_ROPE)
    q_nope = q[..., :A_NOPE]
    q_rope = apply_rope(q[..., A_NOPE:], cos[:, :, None, :], sin[:, :, None, :])
    kv = jnp.einsum('bsr,re->bse', rmsnorm(c_kv, kv_norm_g), w_kvb).reshape(B, S, A_HEADS, A_NOPE + A_VDIM)
    k_nope, v = kv[..., :A_NOPE], kv[..., A_NOPE:]
    k_rope = apply_rope(k_rope, cos, sin)
    out = mla_attention(q_nope, q_rope, k_nope, k_rope, v)
    return out, xq.reshape(B, S, X_HEADS, X_HEAD_DIM), z


def swa_mixer(h, w_in, sinks, rel_bias):
    B, S, _ = h.shape
    proj = jnp.einsum('bsd,de->bse', h, w_in)
    q, k, v, xq, z = split_cols(proj, [B_HEADS * B_HEAD_DIM, B_KV_HEADS * B_HEAD_DIM,
                                       B_KV_HEADS * B_HEAD_DIM, X_WIDTH, MIX_WIDTH])
    q = q.reshape(B, S, B_HEADS, B_HEAD_DIM)
    k = k.reshape(B, S, B_KV_HEADS, B_HEAD_DIM)
    v = v.reshape(B, S, B_KV_HEADS, B_HEAD_DIM)
    out = swa_attention(q, k, v, sinks, rel_bias)
    return out, xq.reshape(B, S, X_HEADS, X_HEAD_DIM), z


def setup_inputs(seed: int = 0) -> dict:
    key = jax.random.key(seed)
    ks = jax.random.split(key, 20)
    f32 = jnp.float32

    def w(k, shape, fan_in):
        return jax.random.normal(k, shape, f32) * (fan_in ** -0.5)

    def gain(k, shape):
        return 1.0 + 0.02 * jax.random.normal(k, shape, f32)

    x = jax.random.normal(ks[0], (BATCH, SEQ, D_MODEL), f32)
    mem = jax.random.normal(ks[1], (BATCH, N_MEM, D_MODEL), f32)
    offset = jax.random.randint(ks[2], (BATCH, 1), 0, 1024, dtype=jnp.int32)
    positions = (offset + jnp.arange(SEQ, dtype=jnp.int32)[None, :]).astype(jnp.int32)
    return {
        "x": x,
        "mem": mem,
        "positions": positions,
        "norm_g": gain(ks[3], (DEPTH, D_MODEL)),
        "mem_norm_g": gain(ks[4], (DEPTH, D_MODEL)),
        "final_norm_g": gain(ks[5], (D_MODEL,)),
        "w_mem_kv": w(ks[6], (DEPTH, D_MODEL, 2 * X_WIDTH), D_MODEL),
        "w_out": w(ks[7], (DEPTH, MIX_WIDTH, D_MODEL), MIX_WIDTH),
        "a_w_in": w(ks[8], (N_A, D_MODEL, A_IN), D_MODEL),
        "a_q_norm_g": gain(ks[9], (N_A, A_Q_RANK)),
        "a_kv_norm_g": gain(ks[10], (N_A, A_KV_RANK)),
        "a_w_qb": w(ks[11], (N_A, A_Q_RANK, A_HEADS * (A_NOPE + A_ROPE)), A_Q_RANK),
        "a_w_kvb": w(ks[12], (N_A, A_KV_RANK, A_HEADS * (A_NOPE + A_VDIM)), A_KV_RANK),
        "b_w_in": w(ks[13], (N_B, D_MODEL, B_IN), D_MODEL),
        "b_sinks": 0.5 * jax.random.normal(ks[14], (N_B, B_HEADS), f32),
        "rel_bias": 0.5 * jax.random.normal(ks[15], (N_BUCKETS, B_HEADS), f32),
    }


def reference(x, mem, positions, norm_g, mem_norm_g, final_norm_g, w_mem_kv, w_out,
              a_w_in, a_q_norm_g, a_kv_norm_g, a_w_qb, a_w_kvb, b_w_in, b_sinks, rel_bias):
    B = x.shape[0]
    cos, sin = rope_tables(positions)
    for i in range(DEPTH):
        h = rmsnorm(x, norm_g[i])
        mn = rmsnorm(mem, mem_norm_g[i])
        mkv = jnp.einsum('bmd,de->bme', mn, w_mem_kv[i]).reshape(B, N_MEM, 2, X_HEADS, X_HEAD_DIM)
        j = i // N_MIXERS
        if i % N_MIXERS == 0:
            self_out, xq, z = mla_mixer(h, cos, sin, a_w_in[j], a_q_norm_g[j], a_kv_norm_g[j],
                                        a_w_qb[j], a_w_kvb[j])
        else:
            self_out, xq, z = swa_mixer(h, b_w_in[j], b_sinks[j], rel_bias)
        mem_out = memory_attention(xq, mkv[:, :, 0], mkv[:, :, 1])
        y = jnp.concatenate([self_out, mem_out], axis=-1) * jax.nn.silu(z)
        x = x + jnp.einsum('bse,ed->bsd', y, w_out[i])
    return rmsnorm(x, final_norm_g)
```

```cpp
#include <hip/hip_runtime.h>
#include <cstdio>
#include <cstdint>
#include <cmath>
namespace pg8 {
#define PG8_LAS __attribute__((address_space(3)))
typedef unsigned short bf16_t;
typedef short bf16x8 __attribute__((ext_vector_type(8)));
typedef float f32x4 __attribute__((ext_vector_type(4)));
typedef unsigned u32x4 __attribute__((ext_vector_type(4)));
constexpr int BM = 256, BK = 64, HALF = 128, HTB = HALF * BK * 2  , STAGE_BYTES = 8 * HTB, NXCD = 8, WGM = 8;

__host__ __device__ __forceinline__ int lds_byte(int r, int c) { const int st = (r >> 4) * 2 + (c >> 5), rr = r & 15, cc = c & 31, ob = rr * 64 + cc * 2; return st * 1024 + (ob ^ (((ob >> 9) & 1) << 5)); }
__host__ __device__ __forceinline__ void stage_rc(int b, int& R, int& C) { const int st = b / 1024, sb = b % 1024, swz = sb ^ (((sb >> 9) & 1) << 5); R = (st >> 1) * 16 + swz / 64; C = (st & 1) * 32 + (swz % 64) / 2; }
__host__ __device__ __forceinline__ int perm32(int rho) { const int n = rho >> 4, i = rho & 15; return 8 * (i >> 2) + 4 * n + (i & 3); }

struct Unit { int pm, pn; };
struct Gemm { const bf16_t* A; const bf16_t* Bt; int lda, ldb, K; };

struct StaticOrder {
    int nM, nN, nwg, nX, G, c;
    __host__ __device__ void init(int nM_, int nN_, int nX_, int G_, int c_) { nM = nM_; nN = nN_; nwg = nM * nN; nX = nX_; G = G_; c = c_; }
    __host__ __device__ __forceinline__ bool next(int i, Unit& u) const {
        const long L = (long)i * G + c; if (L >= nwg + nX) return false;
        if (L >= nwg) { u.pm = -1; u.pn = (int)(L - nwg); return true; }
        map((int)L, u); return true;
    }
    __host__ __device__ __forceinline__ void map(int L, Unit& u) const {
        int wgid = L; { const int q = nwg / NXCD, r = nwg % NXCD, xcd = wgid % NXCD, off = wgid / NXCD; wgid = (xcd < r ? xcd * (q + 1) : r * (q + 1) + (xcd - r) * q) + off; }
        const int nig = WGM * nN, gid = wgid / nig, fm = gid * WGM, gsz = (nM - fm) < WGM ? (nM - fm) : WGM;
        u.pm = fm + ((wgid % nig) % gsz); u.pn = (wgid % nig) / gsz;
    }
};

typedef float f32x2_t __attribute__((ext_vector_type(2))); typedef __bf16 bf16x2_t __attribute__((ext_vector_type(2)));
__device__ __forceinline__ unsigned cvt_pk_bf16(float lo, float hi) { const f32x2_t v = {lo, hi}; const bf16x2_t b = __builtin_convertvector(v, bf16x2_t); return __builtin_bit_cast(unsigned, b); }


template <class Epi, class Sched, bool ALIGN_EPI = false, bool SP2 = false>
__device__ __forceinline__ void gemm_phase(PG8_LAS unsigned char* lds, const Gemm g, const Sched& S, const Epi& E, int tid_in) {
    int tid_ = tid_in; asm volatile("" : "+v"(tid_));
    const int tid = tid_, wid = __builtin_amdgcn_readfirstlane(tid >> 6), lane = tid & 63, wr = wid >> 2, wc = wid & 3, fr = lane & 15, fq = lane >> 4;
    const int K = g.K, nt = K / BK;
    unsigned voffA[2], voffB[2];
#pragma unroll
    for (int i = 0; i < 2; ++i) { int R, C; stage_rc(tid * 16 + i * 8192, R, C); const int Rb = Epi::PERM ? ((R & ~31) + perm32(R & 31)) : R;
        voffA[i] = (unsigned)(R * g.lda + C) * 2u; voffB[i] = (unsigned)(Rb * g.ldb + C) * 2u; }
    const size_t kstep = (size_t)(BK * 2);
    const size_t hstepA = (size_t)HALF * g.lda * 2, hstepB = (size_t)HALF * g.ldb * 2;
    const size_t tstepA = 2 * hstepA, tstepB = 2 * hstepB;
    const unsigned ldsw = (unsigned)wid * 1024u;
    const int aoff = lds_byte(wr * 64 + fr, fq * 8), boff = lds_byte(wc * 32 + fr, fq * 8);
#define PG8_SA(b, h) (((b) * 2 + (h)) * HTB)
#define PG8_SB(b, h) ((4 + (b) * 2 + (h)) * HTB)
#define PG8_STAGE(bufoff, gbase, voff) do { _Pragma("unroll") for (int _i = 0; _i < 2; ++_i) \
        __builtin_amdgcn_global_load_lds((const unsigned*)((const char*)(gbase) + (voff)[_i]), (PG8_LAS unsigned*)(lds + (bufoff) + ldsw + _i * 8192), 16, 0, 0); } while (0)
#define PG8_LDA(dst, b, h) do { _Pragma("unroll") for (int m = 0; m < 4; ++m) _Pragma("unroll") for (int k = 0; k < 2; ++k) dst[m][k] = *(const PG8_LAS bf16x8*)(lds + PG8_SA(b, h) + aoff + m * 2048 + k * 1024); } while (0)
#define PG8_LDB(dst, b, h) do { _Pragma("unroll") for (int n = 0; n < 2; ++n) _Pragma("unroll") for (int k = 0; k < 2; ++k) dst[n][k] = *(const PG8_LAS bf16x8*)(lds + PG8_SB(b, h) + boff + n * 2048 + k * 1024); } while (0)
#define PG8_MMA(ai, bj, At, Bt) do { __builtin_amdgcn_s_setprio(1); _Pragma("unroll") for (int m = 0; m < 4; ++m) _Pragma("unroll") for (int n = 0; n < 2; ++n) _Pragma("unroll") for (int k = 0; k < 2; ++k) \
        acc[ai][bj][m][n] = __builtin_amdgcn_mfma_f32_16x16x32_bf16(Bt[n][k], At[m][k], acc[ai][bj][m][n], 0, 0, 0); __builtin_amdgcn_s_setprio(0); } while (0)
#define PG8_WAIT_V(n) asm volatile("s_waitcnt vmcnt(" #n ")" ::: "memory")
#define PG8_WAIT_L(n) asm volatile("s_waitcnt lgkmcnt(" #n ")" ::: "memory")
#define PG8_BAR __builtin_amdgcn_s_barrier()
#define PG8_SCHED __builtin_amdgcn_sched_barrier(0)
    Unit cur, nxt; int ui = 0;
    if (!S.next(0, cur)) return;
    S.fix(cur);
    f32x4 acc[2][2][4][2];
#pragma unroll
    for (int a = 0; a < 2; ++a)
#pragma unroll
        for (int b = 0; b < 2; ++b)
#pragma unroll
            for (int m = 0; m < 4; ++m)
#pragma unroll
                for (int n = 0; n < 2; ++n) acc[a][b][m][n] = (f32x4){0.f, 0.f, 0.f, 0.f};
    bf16x8 At[4][2], B0[2][2], B1[2][2];
    const char* cA = (const char*)g.A + (size_t)cur.pm * tstepA; const char* cB = (const char*)g.Bt + (size_t)cur.pn * tstepB;
    if constexpr (SP2) {
        PG8_STAGE(PG8_SB(0, 0), cB, voffB); PG8_STAGE(PG8_SB(0, 1), cB + hstepB, voffB); PG8_STAGE(PG8_SA(0, 0), cA, voffA); PG8_STAGE(PG8_SA(0, 1), cA + hstepA, voffA);
        if (wr == 1) PG8_BAR;
        PG8_WAIT_V(2); PG8_BAR;
        PG8_STAGE(PG8_SB(1, 0), cB + kstep, voffB); PG8_STAGE(PG8_SA(1, 0), cA + kstep, voffA); PG8_STAGE(PG8_SB(1, 1), cB + hstepB + kstep, voffB);
        PG8_WAIT_V(6); PG8_BAR;
    } else {
        PG8_STAGE(PG8_SB(0, 0), cB, voffB); PG8_STAGE(PG8_SA(0, 0), cA, voffA); PG8_STAGE(PG8_SB(0, 1), cB + hstepB, voffB); PG8_STAGE(PG8_SA(0, 1), cA + hstepA, voffA);
        if (wr == 1) PG8_BAR;
        PG8_WAIT_V(4); PG8_BAR;
        PG8_STAGE(PG8_SB(1, 0), cB + kstep, voffB); PG8_STAGE(PG8_SA(1, 0), cA + kstep, voffA); PG8_STAGE(PG8_SB(1, 1), cB + hstepB + kstep, voffB);
        PG8_WAIT_V(6); PG8_BAR;
    }
    for (;;) {
        bool has_next = S.next(ui + 1, nxt);
        if (has_next) S.fix(nxt);
        const char* nA = has_next ? (const char*)g.A + (size_t)nxt.pm * tstepA : cA; const char* nB = has_next ? (const char*)g.Bt + (size_t)nxt.pn * tstepB : cB;
        for (int t = 0; t < nt; t += 2) {
            const bool last = (t == nt - 2);
            const char* a1 = cA + (size_t)(t + 1) * kstep;
            const char* a2 = last ? nA : cA + (size_t)(t + 2) * kstep; const char* b2 = last ? nB : cB + (size_t)(t + 2) * kstep;
            const char* a3 = a2 + kstep; const char* b3 = b2 + kstep;
            if constexpr (SP2) {
            PG8_LDB(B0, 0, 0); PG8_LDB(B1, 0, 1); PG8_SCHED; PG8_LDA(At, 0, 0); PG8_STAGE(PG8_SA(1, 1), a1 + hstepA, voffA);
            PG8_WAIT_V(8); PG8_WAIT_L(0); PG8_BAR; PG8_MMA(0, 0, At, B0); PG8_MMA(0, 1, At, B1); PG8_BAR; PG8_SCHED;
            PG8_LDA(At, 0, 1); PG8_STAGE(PG8_SB(0, 0), b2, voffB); PG8_STAGE(PG8_SB(0, 1), b2 + hstepB, voffB); PG8_STAGE(PG8_SA(0, 0), a2, voffA);
            PG8_WAIT_V(8); PG8_WAIT_L(0); PG8_BAR; PG8_MMA(1, 0, At, B0); PG8_MMA(1, 1, At, B1); PG8_BAR; PG8_SCHED;
            PG8_LDB(B0, 1, 0); PG8_LDB(B1, 1, 1); PG8_SCHED; PG8_LDA(At, 1, 0); PG8_STAGE(PG8_SA(0, 1), a2 + hstepA, voffA);
            PG8_WAIT_V(8); PG8_WAIT_L(0); PG8_BAR; PG8_MMA(0, 0, At, B0); PG8_MMA(0, 1, At, B1); PG8_BAR; PG8_SCHED;
            PG8_LDA(At, 1, 1); PG8_STAGE(PG8_SB(1, 0), b3, voffB); PG8_STAGE(PG8_SB(1, 1), b3 + hstepB, voffB); PG8_STAGE(PG8_SA(1, 0), a3, voffA);
            PG8_WAIT_V(8); PG8_WAIT_L(0); PG8_BAR; PG8_MMA(1, 0, At, B0); PG8_MMA(1, 1, At, B1); PG8_BAR; PG8_SCHED;
            } else {
            PG8_LDB(B0, 0, 0); PG8_SCHED; PG8_LDA(At, 0, 0); PG8_STAGE(PG8_SA(1, 1), a1 + hstepA, voffA);
            PG8_WAIT_L(8); PG8_BAR; PG8_WAIT_L(0); PG8_MMA(0, 0, At, B0); PG8_BAR; PG8_SCHED;
            PG8_LDB(B1, 0, 1); PG8_STAGE(PG8_SB(0, 0), b2, voffB);
            PG8_BAR; PG8_WAIT_L(0); PG8_MMA(0, 1, At, B1); PG8_BAR;
            PG8_LDA(At, 0, 1); PG8_STAGE(PG8_SA(0, 0), a2, voffA);
            PG8_BAR; PG8_WAIT_L(0); PG8_MMA(1, 0, At, B0); PG8_BAR; PG8_SCHED;
            PG8_STAGE(PG8_SB(0, 1), b2 + hstepB, voffB);
            PG8_WAIT_V(6); PG8_BAR; PG8_MMA(1, 1, At, B1); PG8_BAR;
            PG8_LDB(B0, 1, 0); PG8_SCHED; PG8_LDA(At, 1, 0); PG8_STAGE(PG8_SA(0, 1), a2 + hstepA, voffA);
            PG8_WAIT_L(8); PG8_BAR; PG8_WAIT_L(0); PG8_MMA(0, 0, At, B0); PG8_BAR; PG8_SCHED;
            PG8_LDB(B1, 1, 1); PG8_STAGE(PG8_SB(1, 0), b3, voffB);
            PG8_BAR; PG8_WAIT_L(0); PG8_MMA(0, 1, At, B1); PG8_BAR;
            PG8_LDA(At, 1, 1); PG8_STAGE(PG8_SA(1, 0), a3, voffA);
            PG8_BAR; PG8_WAIT_L(0); PG8_MMA(1, 0, At, B0); PG8_BAR; PG8_SCHED;
            PG8_STAGE(PG8_SB(1, 1), b3 + hstepB, voffB);
            PG8_WAIT_V(6); PG8_BAR; PG8_MMA(1, 1, At, B1); PG8_BAR;
            }
        }
        if constexpr (ALIGN_EPI) { if (wr == 0) PG8_BAR; }
        E(acc, cur, wr, wc, fr, fq);
        if (!has_next) break;
#pragma unroll
        for (int a = 0; a < 2; ++a)
#pragma unroll
            for (int b = 0; b < 2; ++b)
#pragma unroll
                for (int m = 0; m < 4; ++m)
#pragma unroll
                    for (int n = 0; n < 2; ++n) acc[a][b][m][n] = (f32x4){0.f, 0.f, 0.f, 0.f};
        cur = nxt; cA = nA; cB = nB; ++ui;
        if constexpr (ALIGN_EPI) { if (wr == 1) PG8_BAR; }
    }
    PG8_WAIT_V(0);
    if constexpr (!ALIGN_EPI) { if (wr == 0) PG8_BAR; }
    PG8_BAR;
#undef PG8_SA
#undef PG8_SB
#undef PG8_STAGE
#undef PG8_LDA
#undef PG8_LDB
#undef PG8_MMA
#undef PG8_WAIT_V
#undef PG8_WAIT_L
#undef PG8_BAR
#undef PG8_SCHED
}
}
constexpr int D_MODEL = 4096, BATCH = 4, SEQ = 4096, M_TOK = BATCH * SEQ, N_MEM = 256, M_MEM = BATCH * N_MEM;
constexpr int A_IN = 6720, A_LDP = 6912, B_IN = 9216;
constexpr int A_OFF_CQ = 0, A_OFF_CKV = 1024, A_OFF_KR = 1536, A_OFF_XQ = 1600, A_OFF_Z = 2624;
constexpr int B_OFF_Q = 0, B_OFF_K = 3072, B_OFF_V = 3584, B_OFF_XQ = 4096, B_OFF_Z = 5120;
constexpr int QW = 4608, KVW = 6144;
constexpr float LOG2E = 1.4426950408889634f;
constexpr float C2_MLA = 0.07216878364870322f * LOG2E;
constexpr float C2_SWA = 0.125f * LOG2E;
constexpr float C2_MEM = 0.0625f * LOG2E;
constexpr float EPS = 1e-6f;

namespace pg8 {
__device__ __forceinline__ float silu_f(float z) { return z * __builtin_amdgcn_rcpf(1.0f + __builtin_amdgcn_exp2f(-z * LOG2E)); }
__device__ __forceinline__ void store8(bf16_t* p, f32x4 v0, f32x4 v1) {
    u32x4 w; w.x = cvt_pk_bf16(v0[0], v0[1]); w.y = cvt_pk_bf16(v0[2], v0[3]); w.z = cvt_pk_bf16(v1[0], v1[1]); w.w = cvt_pk_bf16(v1[2], v1[3]); *(u32x4*)p = w;
}
__device__ __forceinline__ void rope8(f32x4& v0, f32x4& v1, const f32x4 cs, const f32x4 sn) {
    float a, b;
    a = v0[0]; b = v0[1]; v0[0] = a * cs[0] - b * sn[0]; v0[1] = b * cs[0] + a * sn[0];
    a = v0[2]; b = v0[3]; v0[2] = a * cs[1] - b * sn[1]; v0[3] = b * cs[1] + a * sn[1];
    a = v1[0]; b = v1[1]; v1[0] = a * cs[2] - b * sn[2]; v1[1] = b * cs[2] + a * sn[2];
    a = v1[2]; b = v1[3]; v1[2] = a * cs[3] - b * sn[3]; v1[3] = b * cs[3] + a * sn[3];
}

__device__ __forceinline__ float rr_slow(const float* p, int n, float inv) { float s = 0.f;
#pragma unroll 1
    for (int i = 0; i < n; ++i) s += p[i];
    return 1.0f / sqrtf(s * inv + EPS); }
struct EpiAin {
    static constexpr bool PERM = true;
    bf16_t* proj;
    bf16_t* mkv;
    const float* cosT; const float* sinT;
    const float* rr;
    const PG8_LAS float* rrl; int pmc;
    float* part;
    __device__ __forceinline__ void operator()(const f32x4 (&acc)[2][2][4][2], const Unit& u, int wr, int wc, int fr, int fq) const {
        if (u.pn >= 27) {
            const int l = (u.pn - 27) >> 3, ct = (u.pn - 27) & 7;
            bf16_t* base = mkv + (size_t)l * M_MEM * 2048;
            int opq = 0; asm volatile("" : "+v"(opq));
            const int row0 = (u.pm - 64) * BM + wr * 64 + fr + opq, col0 = ct * BM + wc * 32 + 8 * fq;
#pragma unroll
            for (int ai = 0; ai < 2; ++ai)
#pragma unroll
                for (int m = 0; m < 4; ++m) { bf16_t* rowp = base + (size_t)(row0 + ai * HALF + m * 16) * 2048 + col0;
#pragma unroll
                    for (int bj = 0; bj < 2; ++bj) store8(rowp + bj * HALF, acc[ai][bj][m][0], acc[ai][bj][m][1]); }
            return;
        }
        int opq = 0; asm volatile("" : "+v"(opq));
        const int lrow0 = wr * 64 + fr + opq, row0 = u.pm * BM + lrow0;
#pragma unroll
        for (int bj = 0; bj < 2; ++bj) {
            const int cw = u.pn * BM + bj * HALF + wc * 32;
            if (cw >= A_IN) continue;
            const int col0 = cw + 8 * fq;
            const int cls = cw < A_OFF_KR ? 0 : (cw < A_OFF_XQ ? 1 : (cw < A_OFF_Z ? 2 : 3));
#pragma unroll
            for (int ai = 0; ai < 2; ++ai)
#pragma unroll
                for (int m = 0; m < 4; ++m) { const int row = row0 + ai * HALF + m * 16; const float r = (u.pm == pmc) ? rrl[lrow0 + ai * HALF + m * 16] : rr[row];
                    f32x4 v0 = acc[ai][bj][m][0] * r, v1 = acc[ai][bj][m][1] * r;
                    if (cls == 0) { float ss = ((v0[0] * v0[0] + v0[1] * v0[1]) + (v0[2] * v0[2] + v0[3] * v0[3])) + ((v1[0] * v1[0] + v1[1] * v1[1]) + (v1[2] * v1[2] + v1[3] * v1[3]));
                        { const int ln = fr + 16 * fq;
                          ss += __builtin_bit_cast(float, __builtin_amdgcn_ds_bpermute((ln ^ 16) << 2, __builtin_bit_cast(int, ss)));
                          ss += __builtin_bit_cast(float, __builtin_amdgcn_ds_bpermute((ln ^ 32) << 2, __builtin_bit_cast(int, ss))); }
                        if (fq == 0) part[(size_t)row * 48 + (cw >> 5)] = ss; }
                    if (cls == 1) { const int i0 = (col0 - A_OFF_KR) >> 1;
                        const f32x4 cs = *(const f32x4*)(cosT + (size_t)row * 32 + i0), sn = *(const f32x4*)(sinT + (size_t)row * 32 + i0);
                        rope8(v0, v1, cs, sn); }
                    else if (cls == 2) { v0 = v0 * C2_MEM; v1 = v1 * C2_MEM; }
                    else if (cls == 3) {
#pragma unroll
                        for (int e = 0; e < 4; ++e) { v0[e] = silu_f(v0[e]); v1[e] = silu_f(v1[e]); } }
                    store8(proj + (size_t)row * A_LDP + col0, v0, v1); }
        }
    }
};
struct EpiBin {
    static constexpr bool PERM = true;
    bf16_t* proj;
    const float* rr; const PG8_LAS float* rrl; int pmc;
    __device__ __forceinline__ void operator()(const f32x4 (&acc)[2][2][4][2], const Unit& u, int wr, int wc, int fr, int fq) const {
        int opq = 0; asm volatile("" : "+v"(opq));
        const int lrow0 = wr * 64 + fr + opq, row0 = u.pm * BM + lrow0, col0 = u.pn * BM + wc * 32 + 8 * fq;
        const int cls = u.pn < 12 ? 0 : (u.pn < 16 ? 1 : (u.pn < 20 ? 2 : 3));
#pragma unroll
        for (int ai = 0; ai < 2; ++ai)
#pragma unroll
            for (int m = 0; m < 4; ++m) { const int row = row0 + ai * HALF + m * 16; bf16_t* rowp = proj + (size_t)row * B_IN + col0;
                const float r = (u.pm == pmc) ? rrl[lrow0 + ai * HALF + m * 16] : rr[row], rs = cls == 0 ? r * C2_SWA : (cls == 2 ? r * C2_MEM : r);
#pragma unroll
                for (int bj = 0; bj < 2; ++bj) { f32x4 v0 = acc[ai][bj][m][0] * rs, v1 = acc[ai][bj][m][1] * rs;
                    if (cls == 3) {
#pragma unroll
                        for (int e = 0; e < 4; ++e) { v0[e] = silu_f(v0[e]); v1[e] = silu_f(v1[e]); } }
                    store8(rowp + bj * HALF, v0, v1); } }
    }
};
struct EpiQ {
    static constexpr bool PERM = true;
    bf16_t* q;
    const float* cosT; const float* sinT;
    const float* part; const PG8_LAS float* rrl; int pmc;
    __device__ __forceinline__ void operator()(const f32x4 (&acc)[2][2][4][2], const Unit& u, int wr, int wc, int fr, int fq) const {
        int opq = 0; asm volatile("" : "+v"(opq));
        const int lrow0 = wr * 64 + fr + opq, row0 = u.pm * BM + lrow0;
#pragma unroll
        for (int bj = 0; bj < 2; ++bj) {
            const int cw = u.pn * BM + bj * HALF + wc * 32, hc = cw % 192;
            const int col0 = cw + 8 * fq;
            const bool rope = hc >= 128;
            const int i0 = (hc - 128 + 8 * fq) >> 1;
#pragma unroll
            for (int ai = 0; ai < 2; ++ai)
#pragma unroll
                for (int m = 0; m < 4; ++m) { const int row = row0 + ai * HALF + m * 16;
                    const float r = C2_MLA * ((u.pm == pmc) ? rrl[lrow0 + ai * HALF + m * 16] : rr_slow(part + (size_t)row * 48, 32, 1.f / 1024.f));
                    f32x4 v0 = acc[ai][bj][m][0] * r, v1 = acc[ai][bj][m][1] * r;
                    if (rope) { const f32x4 cs = *(const f32x4*)(cosT + (size_t)row * 32 + i0), sn = *(const f32x4*)(sinT + (size_t)row * 32 + i0);
                        rope8(v0, v1, cs, sn); }
                    store8(q + (size_t)row * QW + col0, v0, v1); }
        }
    }
};
struct EpiPlain {
    static constexpr bool PERM = true;
    bf16_t* o; int ldc;
    __device__ __forceinline__ void operator()(const f32x4 (&acc)[2][2][4][2], const Unit& u, int wr, int wc, int fr, int fq) const {
        int opq = 0; asm volatile("" : "+v"(opq));
        const int row0 = u.pm * BM + wr * 64 + fr + opq, col0 = u.pn * BM + wc * 32 + 8 * fq;
#pragma unroll
        for (int ai = 0; ai < 2; ++ai)
#pragma unroll
            for (int m = 0; m < 4; ++m) { bf16_t* rowp = o + (size_t)(row0 + ai * HALF + m * 16) * ldc + col0;
#pragma unroll
                for (int bj = 0; bj < 2; ++bj) store8(rowp + bj * HALF, acc[ai][bj][m][0], acc[ai][bj][m][1]); }
    }
};
struct EpiKV {
    static constexpr bool PERM = true;
    bf16_t* o;
    const float* part; const PG8_LAS float* rrl; int pmc;
    __device__ __forceinline__ void operator()(const f32x4 (&acc)[2][2][4][2], const Unit& u, int wr, int wc, int fr, int fq) const {
        int opq = 0; asm volatile("" : "+v"(opq));
        const int lrow0 = wr * 64 + fr + opq, row0 = u.pm * BM + lrow0, col0 = u.pn * BM + wc * 32 + 8 * fq;
#pragma unroll
        for (int ai = 0; ai < 2; ++ai)
#pragma unroll
            for (int m = 0; m < 4; ++m) { const int row = row0 + ai * HALF + m * 16; bf16_t* rowp = o + (size_t)row * KVW + col0;
                const float r = (u.pm == pmc) ? rrl[lrow0 + ai * HALF + m * 16] : rr_slow(part + (size_t)row * 48 + 32, 16, 1.f / 512.f);
#pragma unroll
                for (int bj = 0; bj < 2; ++bj) store8(rowp + bj * HALF, acc[ai][bj][m][0] * r, acc[ai][bj][m][1] * r); }
    }
};
struct SchedKV { StaticOrder o;
    __device__ __forceinline__ bool next(int i, Unit& u) const {
        if (o.G != 256) return o.next(i, u);
        int L; if (i < 5) L = i * 256 + o.c; else if (o.c >= 128 && i < 7) L = 1280 + (i - 5) * 128 + (o.c - 128); else return false;
        o.map(L, u); return true; }
    __device__ __forceinline__ void fix(Unit&) const {} };
struct SchedRange { StaticOrder o; int i0, n;
    __device__ __forceinline__ bool next(int i, Unit& u) const { return i < n && o.next(i0 + i, u); } __device__ __forceinline__ void fix(Unit&) const {} };
struct SchedPlain { StaticOrder o; __device__ __forceinline__ bool next(int i, Unit& u) const { return o.next(i, u); } __device__ __forceinline__ void fix(Unit&) const {} };
struct SchedAin { StaticOrder o; __device__ __forceinline__ bool next(int i, Unit& u) const { return o.next(i, u); }
    __device__ __forceinline__ void fix(Unit& u) const { if (u.pm < 0) { const int e = u.pn, l = e >> 5, r = e & 31; u.pm = 64 + (r >> 3); u.pn = 27 + l * 8 + (r & 7); } } };
}
namespace att {
#define ATT_LAS __attribute__((address_space(3)))
typedef unsigned short bf16_t;
typedef short bf16x8 __attribute__((ext_vector_type(8)));
typedef short s16x4 __attribute__((ext_vector_type(4)));
typedef float f32x16 __attribute__((ext_vector_type(16)));
typedef float f32x4 __attribute__((ext_vector_type(4)));
typedef unsigned u32x4 __attribute__((ext_vector_type(4)));
#define ATT_SBAR() __builtin_amdgcn_sched_barrier(0)
constexpr float THR2 = 8.0f;

template <int DQK> __device__ __forceinline__ int kswz(int row, int chunk) {
    const int sw = (DQK == 256 || DQK == 128) ? (row & 15) : ((row >> 1) & 7);
    return row * (DQK * 2) + ((chunk ^ sw) << 4);
}
template <int DV> __device__ __forceinline__ int v_st(int k, int c) { constexpr int NCB = DV / 32; const int kk = (k & ~0xC) | ((k & 4) << 1) | ((k & 8) >> 1); return ((kk >> 3) * NCB + (c >> 5)) * 512 + ((kk & 7) * 32 + (c & 31)) * 2; }
__device__ __forceinline__ int v_rd_base(int lane) { return ((lane & 3) << 3) | (((lane >> 2) & 3) << 6) | (((lane >> 4) & 1) << 5) | (((lane >> 5) & 1) << 8); }
__device__ __forceinline__ int crow(int r, int hi) { return (r & 3) + 8 * (r >> 2) + 4 * hi; }
__device__ __forceinline__ unsigned cvtpk(float lo, float hi) { return pg8::cvt_pk_bf16(lo, hi); }
__device__ __forceinline__ const char* uptr(const char* p) { const unsigned long long v = (unsigned long long)(uintptr_t)p;
    unsigned lo = __builtin_amdgcn_readfirstlane((unsigned)v), hi = __builtin_amdgcn_readfirstlane((unsigned)(v >> 32)); asm volatile("" : "+s"(lo), "+s"(hi));
    return (const char*)(uintptr_t)(((unsigned long long)hi << 32) | lo); }
__device__ __forceinline__ float bf2f(bf16_t v) { return __uint_as_float(((unsigned)v) << 16); }

__device__ __forceinline__ void softmax_exp(f32x16& p0, f32x16& p1, float& m_reg, float& alpha) {
    float pmax = p0[0];
#pragma unroll
    for (int r = 1; r < 16; ++r) pmax = fmaxf(pmax, p0[r]);
#pragma unroll
    for (int r = 0; r < 16; ++r) pmax = fmaxf(pmax, p1[r]);
    { auto rr = __builtin_amdgcn_permlane32_swap(__float_as_uint(pmax), __float_as_uint(pmax), false, false);
      pmax = fmaxf(__uint_as_float(rr[0]), __uint_as_float(rr[1])); }
    float mn;
    if (__builtin_expect(__all(pmax - m_reg <= THR2), 1)) { mn = m_reg; alpha = 1.f; }
    else { mn = fmaxf(m_reg, pmax); alpha = __builtin_amdgcn_exp2f(m_reg - mn); m_reg = mn; }
#pragma unroll
    for (int r = 0; r < 16; ++r) p0[r] = __builtin_amdgcn_exp2f(p0[r] - mn);
#pragma unroll
    for (int r = 0; r < 16; ++r) p1[r] = __builtin_amdgcn_exp2f(p1[r] - mn);
}
__device__ __forceinline__ void softmax_pack(const f32x16& p0, const f32x16& p1, float alpha, float& l_reg, bf16x8& pa0, bf16x8& pa1, bf16x8& pa2, bf16x8& pa3) {
    float ps = 0.f;
    { float s0 = p0[0] + p0[1], s1 = p0[2] + p0[3], s2 = p1[0] + p1[1], s3 = p1[2] + p1[3];
#pragma unroll
      for (int r = 4; r < 16; r += 4) { s0 += p0[r] + p0[r + 1]; s1 += p0[r + 2] + p0[r + 3]; s2 += p1[r] + p1[r + 1]; s3 += p1[r + 2] + p1[r + 3]; }
      ps = (s0 + s1) + (s2 + s3); }
    { auto rr = __builtin_amdgcn_permlane32_swap(__float_as_uint(ps), __float_as_uint(ps), false, false);
      ps = __uint_as_float(rr[0]) + __uint_as_float(rr[1]); }
    l_reg = l_reg * alpha + ps;
#define ATT_PK4(P, B_, OUT) do { unsigned a0 = cvtpk(P[B_+0], P[B_+1]), a1 = cvtpk(P[B_+2], P[B_+3]);                          \
        unsigned b0 = cvtpk(P[B_+4], P[B_+5]), b1 = cvtpk(P[B_+6], P[B_+7]);                                             \
        auto r0 = __builtin_amdgcn_permlane32_swap(a0, b0, false, false); auto r1 = __builtin_amdgcn_permlane32_swap(a1, b1, false, false); \
        u32x4 w = {r0[0], r1[0], r0[1], r1[1]}; OUT = __builtin_bit_cast(bf16x8, w); } while (0)
    ATT_PK4(p0, 0, pa0); ATT_PK4(p0, 8, pa1); ATT_PK4(p1, 0, pa2); ATT_PK4(p1, 8, pa3);
#undef ATT_PK4
}
template <int DQK, int GD>
__device__ __forceinline__ void qkt(f32x16& p0, f32x16& p1, const ATT_LAS char* Kb, int r32, int hi, const bf16x8* qr) {
    constexpr int ND = DQK / 16, NG = ND / GD; static_assert(ND % GD == 0, "qkt group size");
    p0 = f32x16{}; p1 = f32x16{};
    const ATT_LAS char* kb[4];
#pragma unroll
    for (int dd = 0; dd < 4; ++dd) kb[dd] = Kb + kswz<DQK>(r32, dd * 2 + hi);
    bf16x8 fa[2][GD], fb[2][GD];
#define ATT_KLD(G_, B_) do { _Pragma("unroll") for (int i_ = 0; i_ < GD; ++i_) { const int d0_ = (G_) * GD + i_; \
        const ATT_LAS char* a_ = (DQK >= 128) ? (const ATT_LAS char*)(((unsigned)(uintptr_t)kb[d0_ & 3] ^ (unsigned)(((d0_ >> 2) & 1) << 7))) + (d0_ >> 3) * 256 : kb[d0_ & 3] + (d0_ >> 2) * 128;     \
        fa[B_][i_] = *(const ATT_LAS bf16x8*)(a_); fb[B_][i_] = *(const ATT_LAS bf16x8*)(a_ + 32 * DQK * 2); } } while (0)
    ATT_KLD(0, 0);
#pragma unroll
    for (int g = 0; g < NG; ++g) {
        if (g + 1 < NG) { if ((g & 1) == 0) ATT_KLD(g + 1, 1); else ATT_KLD(g + 1, 0); }
        ATT_SBAR();
#pragma unroll
        for (int i = 0; i < GD; ++i) {
            p0 = __builtin_amdgcn_mfma_f32_32x32x16_bf16(fa[g & 1][i], qr[g * GD + i], p0, 0, 0, 0);
            p1 = __builtin_amdgcn_mfma_f32_32x32x16_bf16(fb[g & 1][i], qr[g * GD + i], p1, 0, 0, 0); }
        ATT_SBAR();
    }
#undef ATT_KLD
}
template <int DV, int VOFF>
__device__ __forceinline__ void pv_tile(f32x16* o, int vb0, bf16x8 pa0, bf16x8 pa1, bf16x8 pa2, bf16x8 pa3) {
    constexpr int NCB = DV / 32, KS = NCB * 1024, HF = NCB * 512;
#define ATT_TRRD(dst, off) asm volatile("ds_read_b64_tr_b16 %0, %1 offset:%2" : "=&v"(dst) : "v"(vb0), "i"(off) : "memory")
#define ATT_VLD(B_, D_) do { constexpr int b_ = VOFF + (D_) * 512; \
        ATT_TRRD(vl[B_][0], b_); ATT_TRRD(vh[B_][0], b_ + HF); ATT_TRRD(vl[B_][1], b_ + KS); ATT_TRRD(vh[B_][1], b_ + KS + HF); \
        ATT_TRRD(vl[B_][2], b_ + 2 * KS); ATT_TRRD(vh[B_][2], b_ + 2 * KS + HF); ATT_TRRD(vl[B_][3], b_ + 3 * KS); ATT_TRRD(vh[B_][3], b_ + 3 * KS + HF); } while (0)
#define ATT_VFR(B_, k_) (bf16x8){vl[B_][k_][0], vl[B_][k_][1], vl[B_][k_][2], vl[B_][k_][3], vh[B_][k_][0], vh[B_][k_][1], vh[B_][k_][2], vh[B_][k_][3]}
#define ATT_PVD(B_, D_) do { o[D_] = __builtin_amdgcn_mfma_f32_32x32x16_bf16(pa0, ATT_VFR(B_, 0), o[D_], 0, 0, 0); o[D_] = __builtin_amdgcn_mfma_f32_32x32x16_bf16(pa1, ATT_VFR(B_, 1), o[D_], 0, 0, 0); \
        o[D_] = __builtin_amdgcn_mfma_f32_32x32x16_bf16(pa2, ATT_VFR(B_, 2), o[D_], 0, 0, 0); o[D_] = __builtin_amdgcn_mfma_f32_32x32x16_bf16(pa3, ATT_VFR(B_, 3), o[D_], 0, 0, 0); } while (0)
    s16x4 vl[2][4], vh[2][4];
    ATT_VLD(0, 0);
    if constexpr (NCB == 2) {
        ATT_VLD(1, 1); asm volatile("s_waitcnt lgkmcnt(8)" ::: "memory"); ATT_SBAR(); ATT_PVD(0, 0);
        asm volatile("s_waitcnt lgkmcnt(0)" ::: "memory"); ATT_SBAR(); ATT_PVD(1, 1);
    } else {
        static_assert(NCB == 4 || NCB == 2, "pv_tile: DV is 64 or 128");
        ATT_VLD(1, 1); asm volatile("s_waitcnt lgkmcnt(8)" ::: "memory"); ATT_SBAR(); ATT_PVD(0, 0); ATT_SBAR();
        ATT_VLD(0, 2); asm volatile("s_waitcnt lgkmcnt(8)" ::: "memory"); ATT_SBAR(); ATT_PVD(1, 1); ATT_SBAR();
        ATT_VLD(1, 3); asm volatile("s_waitcnt lgkmcnt(8)" ::: "memory"); ATT_SBAR(); ATT_PVD(0, 2); ATT_SBAR();
        asm volatile("s_waitcnt lgkmcnt(0)" ::: "memory"); ATT_SBAR(); ATT_PVD(1, 3);
    }
#undef ATT_TRRD
#undef ATT_VLD
#undef ATT_VFR
#undef ATT_PVD
}

template <int DV>
__device__ __forceinline__ void epilogue_rows(const f32x16* o, float l_reg, ATT_LAS float* li_l, ATT_LAS char* stg, const bf16_t* Gw, int ldg, bf16_t* Yw, int ldy, int lane) {
    constexpr int NCB = DV / 32, RS = DV * 2 + 16, CH = DV / 8, RPP = 64 / CH, NP = 32 / RPP;
    const int r32 = lane & 31, hi = lane >> 5;
    if (hi == 0) li_l[r32] = l_reg;
    asm volatile("s_waitcnt lgkmcnt(0)" ::: "memory");
#pragma unroll
    for (int r = 0; r < 16; ++r) { const int orow = crow(r, hi); const float rl = __builtin_amdgcn_rcpf(li_l[orow]);
#pragma unroll
        for (int d0 = 0; d0 < NCB; ++d0) { const unsigned w = cvtpk(o[d0][r] * rl, 0.f); *(ATT_LAS unsigned short*)(stg + orow * RS + (d0 * 32 + r32) * 2) = (unsigned short)w; } }
    asm volatile("s_waitcnt lgkmcnt(0)" ::: "memory");
    int opq = 0; asm volatile("" : "+v"(opq));
#pragma unroll
    for (int i = 0; i < NP; ++i) { const int row = i * RPP + lane / CH + opq, ch = lane % CH;
        const u32x4 ov = *(const ATT_LAS u32x4*)(stg + row * RS + ch * 16);
        const u32x4 gv = *(const u32x4*)(Gw + (size_t)row * ldg + ch * 8);
        u32x4 yv;
#pragma unroll
        for (int e = 0; e < 4; ++e) { const float a0 = __uint_as_float(ov[e] << 16) * __uint_as_float(gv[e] << 16), a1 = __uint_as_float(ov[e] & 0xffff0000u) * __uint_as_float(gv[e] & 0xffff0000u); yv[e] = cvtpk(a0, a1); }
        *(u32x4*)(Yw + (size_t)row * ldy + ch * 8) = yv; }
}

template <int DV>
__device__ __forceinline__ void gate_prefetch(u32x4 (&gv)[32 / (64 / (DV / 8))], const bf16_t* Gw, int ldg, int lane) {
    constexpr int CH = DV / 8, RPP = 64 / CH, NP = 32 / RPP;
#pragma unroll
    for (int i = 0; i < NP; ++i) { const int row = i * RPP + lane / CH, ch = lane % CH; gv[i] = *(const u32x4*)(Gw + (size_t)row * ldg + ch * 8); }
}
template <int DV>
__device__ __forceinline__ void epilogue_rows_pre(const f32x16* o, float l_reg, ATT_LAS float* li_l, ATT_LAS char* stg, const u32x4 (&gv)[32 / (64 / (DV / 8))], bf16_t* Yw, int ldy, int lane) {
    constexpr int NCB = DV / 32, RS = DV * 2 + 16, CH = DV / 8, RPP = 64 / CH, NP = 32 / RPP;
    const int r32 = lane & 31, hi = lane >> 5;
    if (hi == 0) li_l[r32] = l_reg;
    asm volatile("s_waitcnt lgkmcnt(0)" ::: "memory");
#pragma unroll
    for (int r = 0; r < 16; ++r) { const int orow = crow(r, hi); const float rl = __builtin_amdgcn_rcpf(li_l[orow]);
#pragma unroll
        for (int d0 = 0; d0 < NCB; ++d0) { const unsigned w = cvtpk(o[d0][r] * rl, 0.f); *(ATT_LAS unsigned short*)(stg + orow * RS + (d0 * 32 + r32) * 2) = (unsigned short)w; } }
    asm volatile("s_waitcnt lgkmcnt(0)" ::: "memory");
    int opq = 0; asm volatile("" : "+v"(opq));
#pragma unroll
    for (int i = 0; i < NP; ++i) { const int row = i * RPP + lane / CH + opq, ch = lane % CH;
        const u32x4 ov = *(const ATT_LAS u32x4*)(stg + row * RS + ch * 16);
        u32x4 yv;
#pragma unroll
        for (int e = 0; e < 4; ++e) { const float a0 = __uint_as_float(ov[e] << 16) * __uint_as_float(gv[i][e] << 16), a1 = __uint_as_float(ov[e] & 0xffff0000u) * __uint_as_float(gv[i][e] & 0xffff0000u); yv[e] = cvtpk(a0, a1); }
        *(u32x4*)(Yw + (size_t)row * ldy + ch * 8) = yv; }
}

__device__ __forceinline__ void mla_core_dma(ATT_LAS char* lds, const bf16_t* Qw, int ldq, const bf16_t* K0, int ldk0, const bf16_t* K1, int ldk1, const bf16_t* V, int ldv,
        int NT, int qpos0, const bf16_t* Gw, int ldg, bf16_t* Yw, int ldy, int tid_in) {
    constexpr int DQK = 192, DV = 128, NCB = 4, VBY = 16384, KBY = 24576, K_OFF = 2 * VBY, WS_OFF = K_OFF + 2 * KBY, ROPE = 16384;
    int tid_ = tid_in; asm volatile("" : "+v"(tid_));
    const int tid = tid_, wid = __builtin_amdgcn_readfirstlane(tid >> 6), lane = tid & 63, r32 = lane & 31, hi = lane >> 5;
    ATT_LAS float* ws = (ATT_LAS float*)(lds + WS_OFF) + wid * 64; ATT_LAS float* li_l = ws; ATT_LAS float* al_l = ws + 32;
    const int vb0 = (int)(unsigned)(uintptr_t)lds + v_rd_base(lane);
    unsigned sn0, sr0, sv0;
    { const int row = 4 * wid + (lane >> 4), cp = lane & 15, ch = cp ^ (row & 15);
      sn0 = (unsigned)(row * ldk0 + ch * 8) * 2u; }
    { const int row = 8 * wid + (lane >> 3), cp = lane & 7, ch = cp ^ ((row >> 1) & 7);
      sr0 = (unsigned)(row * ldk1 + ch * 8) * 2u; }
    { const int st = 2 * wid + (lane >> 5), kkh = st >> 2, cb = st & 3, q = (lane & 31) >> 2, c = cb * 32 + (lane & 3) * 8;
      const int kk = kkh * 8 + q, k = (kk & ~0xC) | ((kk & 4) << 1) | ((kk & 8) >> 1);
      sv0 = (unsigned)(k * ldv + c) * 2u; }
    const size_t stepK0 = (size_t)64 * ldk0 * 2, stepK1 = (size_t)64 * ldk1 * 2, stepV = (size_t)64 * ldv * 2;
    const unsigned ldsw = (unsigned)wid * 1024u;
#define MLA_DMA(BUF, t_) do { const char* kb0_ = uptr((const char*)K0 + (size_t)(t_) * stepK0); const char* kb0b_ = uptr((const char*)K0 + (size_t)(t_) * stepK0 + (size_t)64 * ldk0); \
        const char* kb1_ = uptr((const char*)K1 + (size_t)(t_) * stepK1); const char* vb_ = uptr((const char*)V + (size_t)(t_) * stepV); const char* vbb_ = uptr((const char*)V + (size_t)(t_) * stepV + (size_t)64 * ldv); \
        unsigned sn0_ = sn0, sr0_ = sr0, sv0_ = sv0; asm volatile("" : "+v"(sn0_), "+v"(sr0_), "+v"(sv0_));     \
        __builtin_amdgcn_global_load_lds((const unsigned*)(kb0_ + sn0_), (ATT_LAS unsigned*)(lds + K_OFF + (BUF) * KBY + ldsw), 16, 0, 0); \
        __builtin_amdgcn_global_load_lds((const unsigned*)(kb0b_ + sn0_), (ATT_LAS unsigned*)(lds + K_OFF + (BUF) * KBY + 8192 + ldsw), 16, 0, 0); \
        __builtin_amdgcn_global_load_lds((const unsigned*)(kb1_ + sr0_), (ATT_LAS unsigned*)(lds + K_OFF + (BUF) * KBY + ROPE + ldsw), 16, 0, 0); \
        __builtin_amdgcn_global_load_lds((const unsigned*)(vb_ + sv0_), (ATT_LAS unsigned*)(lds + (BUF) * VBY + ldsw), 16, 0, 0); \
        __builtin_amdgcn_global_load_lds((const unsigned*)(vbb_ + sv0_), (ATT_LAS unsigned*)(lds + (BUF) * VBY + 8192 + ldsw), 16, 0, 0); } while (0)
    MLA_DMA(0, 0);
    bf16x8 qr[DQK / 16];
    { const char* qb_ = uptr((const char*)Qw); unsigned qo_ = (unsigned)(r32 * ldq + hi * 8) * 2u; asm volatile("" : "+v"(qo_));
#pragma unroll
      for (int d0 = 0; d0 < DQK / 16; ++d0) qr[d0] = *(const __attribute__((address_space(1))) bf16x8*)(uintptr_t)(qb_ + qo_ + d0 * 32); }
    float m_reg = -1e30f, l_reg = 0.f; f32x16 o[NCB];
    { float z_ = 0.f; asm volatile("" : "+v"(z_));
#pragma unroll
      for (int d = 0; d < NCB; ++d)
#pragma unroll
          for (int r = 0; r < 16; ++r) o[d][r] = z_; }
    asm volatile("s_waitcnt vmcnt(0)" ::: "memory");
    __syncthreads();
    const int qm = qpos0 + r32 - 4 * hi;
    const int kn0 = r32 * 256 + ((hi ^ (r32 & 15)) << 4), kr0 = ROPE + r32 * 128 + ((hi ^ ((r32 >> 1) & 7)) << 4);
#define MLA_KA(d0) ((d0) < 8 ? (kn0 ^ ((((d0) & 3) << 5) | (((d0) >> 2) << 7))) : (kr0 ^ (((d0) - 8) << 5)))
#define MLA_KH(d0) ((d0) < 8 ? 8192 : 4096)
#define MLA_KLD(G_, B_) do { _Pragma("unroll") for (int i_ = 0; i_ < 4; ++i_) { const int d0_ = (G_) * 4 + i_; \
        fa[B_][i_] = *(const ATT_LAS bf16x8*)(Kb_ + MLA_KA(d0_)); fb[B_][i_] = *(const ATT_LAS bf16x8*)(Kb_ + MLA_KA(d0_) + MLA_KH(d0_)); } } while (0)
#define MLA_QKT(BUF) do { const ATT_LAS char* Kb_ = lds + K_OFF + (BUF) * KBY; bf16x8 fa[2][4], fb[2][4]; p0 = f32x16{}; p1 = f32x16{}; \
        MLA_KLD(0, 0); \
        _Pragma("unroll") for (int g = 0; g < 3; ++g) { \
            if (g + 1 < 3) { if ((g & 1) == 0) MLA_KLD(g + 1, 1); else MLA_KLD(g + 1, 0); } \
            ATT_SBAR(); \
            _Pragma("unroll") for (int i = 0; i < 4; ++i) { p0 = __builtin_amdgcn_mfma_f32_32x32x16_bf16(fa[g & 1][i], qr[g * 4 + i], p0, 0, 0, 0); p1 = __builtin_amdgcn_mfma_f32_32x32x16_bf16(fb[g & 1][i], qr[g * 4 + i], p1, 0, 0, 0); } \
            ATT_SBAR(); } } while (0)
#define MLA_STEP(BF, t) do { \
        const int kb_ = (t) * 64; \
        if ((t) + 1 < NT) MLA_DMA(1 - (BF), (t) + 1); \
        ATT_SBAR(); \
        if (kb_ <= qpos0 + 31) {                                                 \
        f32x16 p0, p1; \
        MLA_QKT(BF); \
        if (kb_ + 63 > qpos0) { const int dq = qm - kb_; const float NEG = -__builtin_inff(); \
            _Pragma("unroll") for (int r = 0; r < 16; ++r) { const int c = (r & 3) + 8 * (r >> 2); if (dq - c < 0) p0[r] = NEG; if (dq - c - 32 < 0) p1[r] = NEG; } } \
        float alpha; softmax_exp(p0, p1, m_reg, alpha); \
        if (__any(alpha < 1.f)) { int l_; asm volatile("v_mbcnt_lo_u32_b32 %0, -1, 0\n\tv_mbcnt_hi_u32_b32 %0, -1, %0" : "=v"(l_));     \
            ATT_LAS float* al2_ = (ATT_LAS float*)(lds + WS_OFF) + wid * 64 + 32; const int hi_ = l_ >> 5; \
            if (hi_ == 0) al2_[l_] = alpha; asm volatile("s_waitcnt lgkmcnt(0)" ::: "memory"); \
            _Pragma("unroll") for (int d_ = 0; d_ < NCB; ++d_) _Pragma("unroll") for (int r = 0; r < 16; ++r) o[d_][r] *= al2_[crow(r, hi_)]; } \
        bf16x8 pa0, pa1, pa2, pa3; softmax_pack(p0, p1, alpha, l_reg, pa0, pa1, pa2, pa3); ATT_SBAR(); \
        pv_tile<DV, (BF) * VBY>(o, vb0, pa0, pa1, pa2, pa3); \
        } \
        asm volatile("s_waitcnt vmcnt(0)" ::: "memory"); \
        __syncthreads(); } while (0)
    for (int t = 0; t < NT; t += 2) { MLA_STEP(0, t); MLA_STEP(1, t + 1); }
#undef MLA_STEP
#undef MLA_QKT
#undef MLA_KLD
#undef MLA_KA
#undef MLA_KH
#undef MLA_DMA
    { int lane2; asm volatile("v_mbcnt_lo_u32_b32 %0, -1, 0\n\tv_mbcnt_hi_u32_b32 %0, -1, %0" : "=v"(lane2));
      epilogue_rows<DV>(o, l_reg, (ATT_LAS float*)(lds + WS_OFF) + wid * 64, lds + wid * (32 * (DV * 2 + 16)), Gw, ldg, Yw, ldy, lane2); }
    __syncthreads();
}

__device__ __forceinline__ void mem_core_dma(ATT_LAS char* lds, const bf16_t* Qw, int ldq, const bf16_t* K0, int ldk0, const bf16_t* V, int ldv,
        const bf16_t* Gw, int ldg, bf16_t* Yw, int ldy, int tid_in) {
    constexpr int DQK = 256, DV = 128, NCB = 4, VBY = 16384, KBY = 32768, K_OFF = 2 * VBY, WS_OFF = K_OFF + 2 * KBY, NT = 4;
    int tid_ = tid_in; asm volatile("" : "+v"(tid_));
    const int tid = tid_, wid = __builtin_amdgcn_readfirstlane(tid >> 6), lane = tid & 63, r32 = lane & 31, hi = lane >> 5;
    ATT_LAS float* ws = (ATT_LAS float*)(lds + WS_OFF) + wid * 64; ATT_LAS float* li_l = ws; ATT_LAS float* al_l = ws + 32;
    const int vb0 = (int)(unsigned)(uintptr_t)lds + v_rd_base(lane);
    const char* sk0; const char* sv0; const char* sv1;
    { const int row = 2 * wid + (lane >> 5), cp = lane & 31, ch = (cp & 16) | ((cp & 15) ^ (row & 15));
      sk0 = (const char*)(K0 + (size_t)row * ldk0 + ch * 8); }
    { const int st = 2 * wid + (lane >> 5), kkh = st >> 2, cb = st & 3, q = (lane & 31) >> 2, c = cb * 32 + (lane & 3) * 8;
      const int kk = kkh * 8 + q, k = (kk & ~0xC) | ((kk & 4) << 1) | ((kk & 8) >> 1);
      sv0 = (const char*)(V + (size_t)k * ldv + c);
      const int st1 = st + 16, kkh1 = st1 >> 2, kk1 = kkh1 * 8 + q, k1 = (kk1 & ~0xC) | ((kk1 & 4) << 1) | ((kk1 & 8) >> 1);
      sv1 = (const char*)(V + (size_t)k1 * ldv + c); }
    const size_t stepK = (size_t)64 * ldk0 * 2, stepV = (size_t)64 * ldv * 2, rows16 = (size_t)16 * ldk0 * 2;
    const unsigned ldsw = (unsigned)wid * 1024u;
#define MEM_DMA(BUF, t_) do { \
        _Pragma("unroll") for (int i_ = 0; i_ < 4; ++i_) \
            __builtin_amdgcn_global_load_lds((const unsigned*)(sk0 + (size_t)(t_) * stepK + i_ * rows16), (ATT_LAS unsigned*)(lds + K_OFF + (BUF) * KBY + i_ * 8192 + ldsw), 16, 0, 0); \
        __builtin_amdgcn_global_load_lds((const unsigned*)(sv0 + (size_t)(t_) * stepV), (ATT_LAS unsigned*)(lds + (BUF) * VBY + ldsw), 16, 0, 0); \
        __builtin_amdgcn_global_load_lds((const unsigned*)(sv1 + (size_t)(t_) * stepV), (ATT_LAS unsigned*)(lds + (BUF) * VBY + 8192 + ldsw), 16, 0, 0); } while (0)
    MEM_DMA(0, 0);
    bf16x8 qr[DQK / 16];
#pragma unroll
    for (int d0 = 0; d0 < DQK / 16; ++d0) qr[d0] = *(const bf16x8*)(Qw + (size_t)r32 * ldq + d0 * 16 + hi * 8);
    float m_reg = -1e30f, l_reg = 0.f; f32x16 o[NCB];
    { float z_ = 0.f; asm volatile("" : "+v"(z_));
#pragma unroll
      for (int d = 0; d < NCB; ++d)
#pragma unroll
          for (int r = 0; r < 16; ++r) o[d][r] = z_; }
    asm volatile("s_waitcnt vmcnt(0)" ::: "memory");
    __syncthreads();
#define MEM_STEP(BF, t) do { \
        if ((t) + 1 < NT) MEM_DMA(1 - (BF), (t) + 1); \
        ATT_SBAR(); \
        f32x16 p0, p1; \
        qkt<DQK, 2>(p0, p1, lds + K_OFF + (BF) * KBY, r32, hi, qr); \
        float alpha; softmax_exp(p0, p1, m_reg, alpha); \
        if (__any(alpha < 1.f)) { if (hi == 0) al_l[r32] = alpha; asm volatile("s_waitcnt lgkmcnt(0)" ::: "memory"); \
            _Pragma("unroll") for (int d_ = 0; d_ < NCB; ++d_) _Pragma("unroll") for (int r = 0; r < 16; ++r) o[d_][r] *= al_l[crow(r, hi)]; } \
        bf16x8 pa0, pa1, pa2, pa3; softmax_pack(p0, p1, alpha, l_reg, pa0, pa1, pa2, pa3); ATT_SBAR(); \
        pv_tile<DV, (BF) * VBY>(o, vb0, pa0, pa1, pa2, pa3); \
        asm volatile("s_waitcnt vmcnt(0)" ::: "memory"); \
        __syncthreads(); } while (0)
    MEM_STEP(0, 0); MEM_STEP(1, 1); MEM_STEP(0, 2); MEM_STEP(1, 3);
#undef MEM_STEP
#undef MEM_DMA
    epilogue_rows<DV>(o, l_reg, li_l, lds + wid * (32 * (DV * 2 + 16)), Gw, ldg, Yw, ldy, lane);
    __syncthreads();
}

__device__ __forceinline__ void mem_core2(ATT_LAS char* lds, const bf16_t* Qw, int ldq, const bf16_t* K0, int ldk0, const bf16_t* V, int ldv,
        const bf16_t* Gw, int ldg, bf16_t* Yw, int ldy, int tid_in) {
    constexpr int DQK = 256, DV = 128, NCB = 4, VBY = 16384, KBY = 32768, K_OFF = 2 * VBY, WS_OFF = 102400;
    int tid_ = tid_in; asm volatile("" : "+v"(tid_));
    const int tid = tid_, wid = __builtin_amdgcn_readfirstlane(tid >> 6), lane = tid & 63, r32 = lane & 31, hi = lane >> 5;
    ATT_LAS float* ws = (ATT_LAS float*)(lds + WS_OFF) + wid * 160; ATT_LAS float* li_l = ws; ATT_LAS float* al_l = ws + 32;
    const int vb0 = (int)(unsigned)(uintptr_t)lds + v_rd_base(lane);
    const char* sk0; const char* sv0; const char* sv1;
    { const int row = 2 * wid + (lane >> 5), cp = lane & 31, ch = (cp & 16) | ((cp & 15) ^ (row & 15));
      sk0 = (const char*)(K0 + (size_t)row * ldk0 + ch * 8); }
    { const int st = 2 * wid + (lane >> 5), kkh = st >> 2, cb = st & 3, q = (lane & 31) >> 2, c = cb * 32 + (lane & 3) * 8;
      const int kk = kkh * 8 + q, k = (kk & ~0xC) | ((kk & 4) << 1) | ((kk & 8) >> 1);
      sv0 = (const char*)(V + (size_t)k * ldv + c);
      const int st1 = st + 16, kkh1 = st1 >> 2, kk1 = kkh1 * 8 + q, k1 = (kk1 & ~0xC) | ((kk1 & 4) << 1) | ((kk1 & 8) >> 1);
      sv1 = (const char*)(V + (size_t)k1 * ldv + c); }
    const size_t stepK = (size_t)64 * ldk0 * 2, stepV = (size_t)64 * ldv * 2, rows16 = (size_t)16 * ldk0 * 2;
    const unsigned ldsw = (unsigned)wid * 1024u;
#define MEM_DMAK(BUF, t_) do { _Pragma("unroll") for (int i_ = 0; i_ < 4; ++i_) \
            __builtin_amdgcn_global_load_lds((const unsigned*)(sk0 + (size_t)(t_) * stepK + i_ * rows16), (ATT_LAS unsigned*)(lds + K_OFF + (BUF) * KBY + i_ * 8192 + ldsw), 16, 0, 0); } while (0)
#define MEM_DMAV(BUF, i_) do { \
        __builtin_amdgcn_global_load_lds((const unsigned*)(sv0 + (size_t)((i_) & 3) * stepV + ((i_) >> 2) * 256), (ATT_LAS unsigned*)(lds + (BUF) * VBY + ldsw), 16, 0, 0); \
        __builtin_amdgcn_global_load_lds((const unsigned*)(sv1 + (size_t)((i_) & 3) * stepV + ((i_) >> 2) * 256), (ATT_LAS unsigned*)(lds + (BUF) * VBY + 8192 + ldsw), 16, 0, 0); } while (0)
    MEM_DMAK(0, 0);
    bf16x8 qr[DQK / 16];
#pragma unroll
    for (int d0 = 0; d0 < DQK / 16; ++d0) qr[d0] = *(const bf16x8*)(Qw + (size_t)r32 * ldq + d0 * 16 + hi * 8);
    float m_reg = -1e30f, l_reg = 0.f;
    asm volatile("s_waitcnt vmcnt(0)" ::: "memory");
    __syncthreads();
    bf16x8 P0[4], P1[4], P2[4], P3[4]; bool fl1 = false, fl2 = false, fl3 = false;
#define MEM_QK(BF, t, PP, FL) do { \
        if ((t) + 1 < 4) MEM_DMAK(1 - (BF), (t) + 1); \
        if ((t) == 2) MEM_DMAV(0, 0); \
        if ((t) == 3) MEM_DMAV(1, 1); \
        ATT_SBAR(); \
        f32x16 p0, p1; \
        qkt<DQK, 2>(p0, p1, lds + K_OFF + (BF) * KBY, r32, hi, qr); \
        float alpha; softmax_exp(p0, p1, m_reg, alpha); \
        FL = __any(alpha < 1.f); \
        if (hi == 0) al_l[(t) * 32 + r32] = alpha; \
        softmax_pack(p0, p1, alpha, l_reg, PP[0], PP[1], PP[2], PP[3]); ATT_SBAR(); \
        asm volatile("s_waitcnt vmcnt(0) lgkmcnt(0)" ::: "memory"); \
        __syncthreads(); } while (0)
    { bool fl0; MEM_QK(0, 0, P0, fl0); (void)fl0; } MEM_QK(1, 1, P1, fl1); MEM_QK(0, 2, P2, fl2); MEM_QK(1, 3, P3, fl3);
#undef MEM_QK
#define MEM_PV(i, PP, FL) do { \
        if ((i) >= 1 && (i) + 1 < 8) MEM_DMAV(((i) + 1) & 1, (i) + 1); \
        if (((i) & 3) == 1) { asm volatile("" ::: "memory"); ATT_SBAR(); gate_prefetch<DV>(gv, Gw + ((i) >> 2) * 128, ldg, lane); }     \
        ATT_SBAR(); \
        if (((i) & 3) != 0 && (FL)) { _Pragma("unroll") for (int d_ = 0; d_ < NCB; ++d_) _Pragma("unroll") for (int r = 0; r < 16; ++r) o[d_][r] *= al_l[((i) & 3) * 32 + crow(r, hi)]; } \
        pv_tile<DV, ((i) & 1) * VBY>(o, vb0, PP[0], PP[1], PP[2], PP[3]); \
        if (((i) & 3) == 3) epilogue_rows_pre<DV>(o, l_reg, li_l, lds + K_OFF + wid * (32 * (DV * 2 + 16)), gv, Yw + ((i) >> 2) * 128, ldy, lane); \
        if (((i) & 3) == 1) asm volatile("s_waitcnt vmcnt(8)" ::: "memory");          \
        else asm volatile("s_waitcnt vmcnt(0)" ::: "memory"); \
        __builtin_amdgcn_s_barrier(); } while (0)
#pragma unroll
    for (int h = 0; h < 2; ++h) {
        f32x16 o[NCB]; u32x4 gv[8];
        { float z_ = 0.f; asm volatile("" : "+v"(z_));
#pragma unroll
          for (int d = 0; d < NCB; ++d)
#pragma unroll
              for (int r = 0; r < 16; ++r) o[d][r] = z_; }
        if (h == 0) { MEM_PV(0, P0, false); MEM_PV(1, P1, fl1); MEM_PV(2, P2, fl2); MEM_PV(3, P3, fl3); }
        else        { MEM_PV(4, P0, false); MEM_PV(5, P1, fl1); MEM_PV(6, P2, fl2); MEM_PV(7, P3, fl3); }
    }
#undef MEM_PV
#undef MEM_DMAK
#undef MEM_DMAV
}

struct SwaUnit { int b, kvh, qb; };
__device__ __forceinline__ SwaUnit swa_decode(int U) { SwaUnit u; u.qb = U & 31; u.kvh = (U >> 5) & 7; u.b = U >> 8; return u; }
struct SwaPre { bf16x8 k[4], v[4]; };
constexpr int SWA_TN = 320, SWA_TOFF = 96;
constexpr int SWA_V = 0, SWA_K = 32768, SWA_WS = 65536, SWA_BIAS = 65536 + 2048, SWA_STG = 83968, SWA_NU = 1024;
__device__ __forceinline__ void swa_prefetch(SwaPre& P, const SwaUnit& u, const bf16_t* proj, int tid) {
    const int j_lo = (2 * u.qb - 2) > 0 ? (2 * u.qb - 2) : 0, NT = 2 * u.qb + 2 - j_lo;
    const size_t kr0 = (size_t)u.b * SEQ + j_lo * 64 + (tid >> 3);
    const bf16_t* kp = proj + kr0 * B_IN + B_OFF_K + u.kvh * 64 + (tid & 7) * 8;
    const bf16_t* vp = proj + kr0 * B_IN + B_OFF_V + u.kvh * 64 + (tid & 7) * 8;
#pragma unroll
    for (int tt = 0; tt < 4; ++tt) if (tt < NT) { P.k[tt] = *(const bf16x8*)(kp + (size_t)tt * 64 * B_IN); P.v[tt] = *(const bf16x8*)(vp + (size_t)tt * 64 * B_IN); }
}
__device__ __forceinline__ void swa_bias_dma(ATT_LAS char* lds, int tb, const SwaUnit& u, const float* ebias, int wid, int lane) {
    __builtin_amdgcn_global_load_lds((const unsigned*)((const char*)(ebias + (size_t)u.kvh * 6 * SWA_TN) + (wid * 64 + lane) * 16), (ATT_LAS unsigned*)(lds + SWA_BIAS + tb * 8192 + wid * 1024), 16, 0, 0);
}
__device__ __forceinline__ void swa_prefetch_q(bf16x8 (&q)[4], const SwaUnit& u, int pass, const bf16_t* proj, int wid, int r32, int hi) {
    const int head = u.kvh * 6 + pass * 2 + (wid >> 2), pos0 = u.qb * 128 + (wid & 3) * 32;
    const bf16_t* qp = proj + ((size_t)u.b * SEQ + pos0 + r32) * B_IN + B_OFF_Q + head * 64 + hi * 8;
#pragma unroll
    for (int d0 = 0; d0 < 4; ++d0) q[d0] = *(const bf16x8*)(qp + d0 * 16);
}
__device__ __forceinline__ void swa_phase(ATT_LAS char* lds, const bf16_t* proj, bf16_t* Y, const float* ebias, const float* sinks  , int vcu, int G, int tid_in) {
    int tid_ = tid_in; asm volatile("" : "+v"(tid_));
    const int tid = tid_, wid = __builtin_amdgcn_readfirstlane(tid >> 6), lane = tid & 63, r32 = lane & 31, hi = lane >> 5;
    ATT_LAS float* ws = (ATT_LAS float*)(lds + SWA_WS) + wid * 64; ATT_LAS float* li_l = ws; ATT_LAS float* al_l = ws + 32;
    const int vb0 = (int)(unsigned)(uintptr_t)lds + SWA_V + v_rd_base(lane);
    constexpr int NU = SWA_NU;
    int U = vcu; if (U >= NU) return;
    SwaPre P; bf16x8 qn[4]; SwaUnit u = swa_decode(U); int tb = 0;
    swa_bias_dma(lds, 0, u, ebias, wid, lane);
    swa_prefetch(P, u, proj, tid);
    swa_prefetch_q(qn, u, 0, proj, wid, r32, hi);
#pragma unroll 1
    for (;;) {
        const int j_lo = (2 * u.qb - 2) > 0 ? (2 * u.qb - 2) : 0, NT = 2 * u.qb + 2 - j_lo, kbase = j_lo * 64;
        { const int rr = tid >> 3, rc = (tid & 7) * 8;
#pragma unroll
          for (int tt = 0; tt < 4; ++tt) if (tt < NT) { *(ATT_LAS bf16x8*)(lds + SWA_V + tt * 8192 + v_st<64>(rr, rc)) = P.v[tt]; *(ATT_LAS bf16x8*)(lds + SWA_K + tt * 8192 + kswz<64>(rr, tid & 7)) = P.k[tt]; }
        }
        asm volatile("s_waitcnt vmcnt(0)" ::: "memory");
        __syncthreads();
        const int Un = U + G; const bool more = Un < NU; SwaUnit un = u;
        if (more) { un = swa_decode(Un); swa_prefetch(P, un, proj, tid); }
        ATT_SBAR();
#pragma unroll 1
        for (int pass = 0; pass < 3; ++pass) {
            bf16x8 qr[4];
#pragma unroll
            for (int d0 = 0; d0 < 4; ++d0) qr[d0] = qn[d0];
            if (pass < 2) swa_prefetch_q(qn, u, pass + 1, proj, wid, r32, hi); else if (more) swa_prefetch_q(qn, un, 0, proj, wid, r32, hi);
            ATT_SBAR();
            const int hsel = pass * 2 + (wid >> 2), head = u.kvh * 6 + hsel, pos0 = u.qb * 128 + (wid & 3) * 32;
            const ATT_LAS float* biasS = (const ATT_LAS float*)(lds + SWA_BIAS + tb * 8192) + hsel * SWA_TN;
            float m_reg = sinks[head] * LOG2E, l_reg = 1.f; f32x16 o[2]; o[0] = f32x16{}; o[1] = f32x16{};
            const int qm = pos0 + r32 - 4 * hi;
#pragma unroll 1
            for (int tt = 0; tt < NT; ++tt) {
                const int kb_ = kbase + tt * 64;
                if (!(kb_ <= pos0 + 31 && kb_ + 63 >= pos0 - 127)) continue;
                f32x16 b0, b1;
                { const ATT_LAS float* bp = biasS + (qm - kb_ + SWA_TOFF - 59);
#pragma unroll
                  for (int r = 0; r < 16; ++r) { const int c = (r & 3) + 8 * (r >> 2); b0[r] = bp[59 - c]; b1[r] = bp[59 - c - 32]; } }
                f32x16 p0, p1;
                qkt<64, 4>(p0, p1, lds + SWA_K + tt * 8192, r32, hi, qr);
#pragma unroll
                for (int r = 0; r < 16; ++r) { p0[r] += b0[r]; p1[r] += b1[r]; }
                float alpha; softmax_exp(p0, p1, m_reg, alpha);
                if (__any(alpha < 1.f)) { if (hi == 0) al_l[r32] = alpha; asm volatile("s_waitcnt lgkmcnt(0)" ::: "memory");
#pragma unroll
                    for (int d_ = 0; d_ < 2; ++d_)
#pragma unroll
                        for (int r = 0; r < 16; ++r) o[d_][r] *= al_l[crow(r, hi)]; }
                bf16x8 pa0, pa1, pa2, pa3; softmax_pack(p0, p1, alpha, l_reg, pa0, pa1, pa2, pa3); ATT_SBAR();
                pv_tile<64, 0>(o, vb0 + tt * 8192, pa0, pa1, pa2, pa3);
            }
            { const size_t rows0 = (size_t)u.b * SEQ + pos0;
              epilogue_rows<64>(o, l_reg, li_l, lds + SWA_STG + wid * (32 * 144), proj + rows0 * B_IN + B_OFF_Z + head * 64, B_IN, Y + rows0 * D_MODEL + head * 64, D_MODEL, lane); }
        }
        if (!more) break;
        swa_bias_dma(lds, 1 - tb, un, ebias, wid, lane);
        U = Un; u = un; tb = 1 - tb;
        __syncthreads();
    }
    __syncthreads();
}
}
constexpr int NWAVES = 8;
constexpr size_t MiB = 1u << 20;
constexpr size_t WS_CTL = 0, CTL_ZERO_BYTES = 1 * MiB;
constexpr size_t WS_COS = 1 * MiB, WS_SIN = 3 * MiB, WS_BIAS = 5 * MiB;
constexpr size_t WS_RR = 6 * MiB;
constexpr size_t WS_MKV = 8 * MiB;
constexpr size_t WS_WIN = 16 * MiB;
constexpr size_t WS_WQB = 102 * MiB;
constexpr size_t WS_WKVB = 111 * MiB;
constexpr size_t WS_WOUT = 117 * MiB;
constexpr size_t WS_HB = 150 * MiB;
constexpr size_t WS_PROJ = 286 * MiB;
constexpr size_t WS_Q = 574 * MiB;
constexpr size_t WS_HI = 718 * MiB;
constexpr size_t WS_LO = 854 * MiB;
constexpr size_t WS_WOUT2 = 982 * MiB;
constexpr size_t WS_PART = 1014 * MiB;
constexpr size_t WS_END = 1018 * MiB;
constexpr int CW_BAR = 4096;
constexpr int RING_BYTES = 131072, LDSCTL_OFF = RING_BYTES, MISC_OFF = LDSCTL_OFF + 320, LDS_BYTES = 147456;
constexpr int RRL_OFF = RING_BYTES + 2048;

#define GAS __attribute__((address_space(1)))
#define LAS __attribute__((address_space(3)))
typedef unsigned short bf16;
typedef unsigned v4u __attribute__((ext_vector_type(4)));
typedef float f32x4 __attribute__((ext_vector_type(4)));
typedef GAS unsigned gu32;
#define RLX_AGENT __ATOMIC_RELAXED, __HIP_MEMORY_SCOPE_AGENT
#define LDS_WAIT() asm volatile("s_waitcnt lgkmcnt(0)" ::: "memory")
#define VM_WAIT() asm volatile("s_waitcnt vmcnt(0)" ::: "memory")
__device__ __forceinline__ unsigned f2bf(float f) { unsigned u = __builtin_bit_cast(unsigned, f); return (u + 0x7fffu + ((u >> 16) & 1u)) >> 16; }
__device__ __forceinline__ unsigned pk2(float lo, float hi) { return f2bf(lo) | (f2bf(hi) << 16); }

#define XB_TMO      128
#define XB_XCNT(j)  (256  + 64 * (j))
#define XB_XSUB(j)  (1280 + 64 * (j))
#define XB_XGEN(j)  (2304 + 64 * (j))
#define XB_TOP      3328
#define XB_TOPGEN   3392
#define XCD_BAR_WORDS 3456
#define XB_SPIN_CAP (1u << 21)

__device__ __forceinline__ unsigned xb_ld(unsigned* p)              { return __hip_atomic_load(p, __ATOMIC_RELAXED, __HIP_MEMORY_SCOPE_AGENT); }
__device__ __forceinline__ unsigned xb_add(unsigned* p, unsigned v) { return __hip_atomic_fetch_add(p, v, __ATOMIC_RELAXED, __HIP_MEMORY_SCOPE_AGENT); }
__device__ __forceinline__ unsigned xb_xcc_id() { return (unsigned)__builtin_amdgcn_s_getreg((3 << 11) | 20) & 0xFu; }
#define XB_SPIN(cond, bar) do { unsigned _sp = 0; while (cond) { __builtin_amdgcn_s_sleep(1); \
    if ((++_sp & 255u) == 0u) { if (xb_ld(&(bar)[XB_TMO])) break; if (_sp > XB_SPIN_CAP) { atomicAdd(&(bar)[XB_TMO], 1u); break; } } } } while (0)

__device__ __forceinline__ int fresh_tid(int wave) { int l; asm volatile("v_mbcnt_lo_u32_b32 %0, -1, 0\n\tv_mbcnt_hi_u32_b32 %0, -1, %0" : "=v"(l)); return wave * 64 + l; }
struct XcdBarrier {
    unsigned* bar; unsigned x;
    volatile LAS unsigned* st;
};
__device__ __forceinline__ XcdBarrier xcd_barrier_post(unsigned* bar, volatile LAS unsigned* st) {
    XcdBarrier b; b.bar = bar; b.x = xb_xcc_id(); b.st = st;
    if (threadIdx.x == 0) (void)xb_add(&bar[XB_XCNT(b.x)], 1u);
    return b;
}
__device__ __forceinline__ void xcd_barrier_complete(unsigned* bar, unsigned x, unsigned& nloc, unsigned& nx) {
    const unsigned G = gridDim.x * gridDim.y * gridDim.z;
    unsigned sum, cnt, mine, sp = 0u;
    for (;;) {
        sum = 0u; cnt = 0u; mine = 0u;
#pragma unroll
        for (unsigned j = 0; j < 16; ++j) { const unsigned c = xb_ld(&bar[XB_XCNT(j)]); sum += c; cnt += (c > 0u) ? 1u : 0u; mine = (j == x) ? c : mine; }
        if (sum == G) break;
        __builtin_amdgcn_s_sleep(1);
        if ((++sp & 255u) == 0u) { if (xb_ld(&bar[XB_TMO])) break; if (sp > XB_SPIN_CAP) { atomicAdd(&bar[XB_TMO], 1u); break; } }
    }
    nloc = mine > 0u ? mine : 1u; nx = cnt > 0u ? cnt : 1u;
}
__device__ __forceinline__ void xcd_barrier(const XcdBarrier& b, int wave) {
    asm volatile("s_waitcnt vmcnt(0)" ::: "memory");
    __syncthreads();
    if (fresh_tid(wave) == 0) {
        unsigned* bar = b.bar;
        __builtin_amdgcn_s_waitcnt(0);
        unsigned nloc = b.st[0], nx = b.st[1];
        if (nloc == 0u) { xcd_barrier_complete(bar, b.x, nloc, nx); b.st[0] = nloc; b.st[1] = nx; }
        const unsigned old = xb_add(&bar[XB_XSUB(b.x)], 1u);
        const unsigned gen = old / nloc;
        if (old + 1u == (gen + 1u) * nloc) {
            __builtin_amdgcn_fence(__ATOMIC_RELEASE, "agent");
            asm volatile("s_waitcnt vmcnt(0)" ::: "memory");
            const unsigned og = xb_add(&bar[XB_TOP], 1u);
            const unsigned tg = og / nx;
            if (og + 1u == (tg + 1u) * nx) xb_add(&bar[XB_TOPGEN], 1u);
            else XB_SPIN(xb_ld(&bar[XB_TOPGEN]) == tg, bar);
            __builtin_amdgcn_fence(__ATOMIC_ACQUIRE, "agent");
            xb_add(&bar[XB_XGEN(b.x)], 1u);
            asm volatile("s_waitcnt vmcnt(0)" ::: "memory");
        } else {
            XB_SPIN(xb_ld(&bar[XB_XGEN(b.x)]) == gen, bar);
            __builtin_amdgcn_fence(__ATOMIC_ACQUIRE, "agent");
            asm volatile("s_waitcnt vmcnt(0)" ::: "memory");
        }
    }
    __syncthreads();
}

__device__ __forceinline__ float shx(float v, int lane, int o) { return __builtin_bit_cast(float, __builtin_amdgcn_ds_bpermute((lane ^ o) << 2, __builtin_bit_cast(int, v))); }
__device__ __forceinline__ float wave_sum(float v, int lane) {
#pragma unroll
    for (int o = 1; o < 64; o <<= 1) v += shx(v, lane, o);
    return v;
}
__device__ const unsigned char T5B[128] = {0, 1, 2, 3, 4, 5, 6, 7, 8, 9, 10, 11, 12, 13, 14, 15, 16, 16, 16, 17, 17, 18, 18, 18, 19, 19, 19, 20, 20, 20, 20, 21, 21, 21, 21, 22, 22, 22, 22, 22, 23, 23, 23, 23, 23, 23, 24, 24, 24, 24, 24, 24, 25, 25, 25, 25, 25, 25, 25, 26, 26, 26, 26, 26, 26, 26, 26, 27, 27, 27, 27, 27, 27, 27, 27, 27, 27, 28, 28, 28, 28, 28, 28, 28, 28, 28, 28, 29, 29, 29, 29, 29, 29, 29, 29, 29, 29, 29, 29, 30, 30, 30, 30, 30, 30, 30, 30, 30, 30, 30, 30, 30, 30, 31, 31, 31, 31, 31, 31, 31, 31, 31, 31, 31, 31, 31, 31, 31};

__device__ const float INVF[32] = {1.000000000e+00f, 7.498942614e-01f, 5.623413324e-01f, 4.216965139e-01f, 3.162277639e-01f, 2.371373773e-01f, 1.778279394e-01f, 1.333521307e-01f, 1.000000015e-01f, 7.498941571e-02f, 5.623413250e-02f, 4.216965288e-02f, 3.162277490e-02f, 2.371373773e-02f, 1.778279431e-02f, 1.333521493e-02f, 9.999999776e-03f, 7.498941850e-03f, 5.623413250e-03f, 4.216964822e-03f, 3.162277630e-03f, 2.371373586e-03f, 1.778279431e-03f, 1.333521446e-03f, 1.000000047e-03f, 7.498942432e-04f, 5.623413017e-04f, 4.216965172e-04f, 3.162277571e-04f, 2.371373703e-04f, 1.778279402e-04f, 1.333521504e-04f};
__device__ __forceinline__ int permrope(int i) { return i < 32 ? 2 * i : 2 * (i - 32) + 1; }
struct TrItem { const float* W; const float* gain; bf16* WT; int K, N, row_off, map, item; };
__device__ __forceinline__ void tr_load(const TrItem& d, f32x4 (&v)[16], float (&g)[16], int lane) {
    const int nblk = d.N / 64, kb = d.item / nblk, nb = d.item - kb * nblk, k0 = 64 * kb, n0 = 64 * nb, lr = lane >> 4, lc = (lane & 15) * 4;
#pragma unroll
    for (int i = 0; i < 16; ++i) v[i] = __builtin_nontemporal_load((const GAS f32x4*)(d.W + (size_t)(k0 + 4 * i + lr) * d.N + n0 + lc));
#pragma unroll
    for (int i = 0; i < 16; ++i) g[i] = d.gain ? d.gain[k0 + 4 * i + lr] : 1.0f;
}
__device__ __forceinline__ void tr_finish(const TrItem& d, const f32x4 (&v)[16], const float (&g)[16], LAS float* scr_f, int lane) {
    constexpr int ROWB = 144;
    LAS unsigned char* scr = (LAS unsigned char*)scr_f;
    const int nblk = d.N / 64, kb = d.item / nblk, nb = d.item - kb * nblk, k0 = 64 * kb, n0 = 64 * nb, lr = lane >> 4, lc = (lane & 15) * 4;
#pragma unroll
    for (int i = 0; i < 16; ++i) { const f32x4 w = v[i] * g[i];
        *(LAS unsigned long long*)(scr + (4 * i + lr) * ROWB + lc * 2) = (unsigned long long)pk2(w.x, w.y) | ((unsigned long long)pk2(w.z, w.w) << 32); }
    LDS_WAIT(); asm volatile("" ::: "memory");
    const int gq = lane >> 4, i16 = lane & 15, q = (lane >> 2) & 3, p = lane & 3;
    const int rbase = (int)(unsigned)(uintptr_t)scr + (8 * gq + q) * ROWB + 8 * p;
    typedef short s16x4 __attribute__((ext_vector_type(4)));
#pragma unroll
    for (int nb16 = 0; nb16 < 4; ++nb16)
#pragma unroll
        for (int ph = 0; ph < 2; ++ph) { s16x4 lo, hi;
            asm volatile("ds_read_b64_tr_b16 %0, %1 offset:%2" : "=&v"(lo) : "v"(rbase), "i"(ph * 32 * ROWB + nb16 * 32) : "memory");
            asm volatile("ds_read_b64_tr_b16 %0, %1 offset:%2" : "=&v"(hi) : "v"(rbase), "i"(ph * 32 * ROWB + nb16 * 32 + 4 * ROWB) : "memory");
            asm volatile("s_waitcnt lgkmcnt(0)" ::: "memory");
            int dn = n0 + 16 * nb16 + i16;
            if (d.map == 1) { if (dn >= A_OFF_KR && dn < A_OFF_XQ) dn = A_OFF_KR + permrope(dn - A_OFF_KR); }
            if (d.map == 2) { const int hc = dn % 192; if (hc >= 128) dn = dn - hc + 128 + permrope(hc - 128); }
            v4u o; o.x = (unsigned)(unsigned short)lo[0] | ((unsigned)(unsigned short)lo[1] << 16); o.y = (unsigned)(unsigned short)lo[2] | ((unsigned)(unsigned short)lo[3] << 16);
            o.z = (unsigned)(unsigned short)hi[0] | ((unsigned)(unsigned short)hi[1] << 16); o.w = (unsigned)(unsigned short)hi[2] | ((unsigned)(unsigned short)hi[3] << 16);
            *(GAS v4u*)(d.WT + (size_t)(d.row_off + dn) * d.K + k0 + 8 * (4 * ph + gq)) = o; }
    asm volatile("s_waitcnt lgkmcnt(0)" ::: "memory");
}
#define CONV_RUN(NITEMS_, DEC) do { f32x4 va_[16], vb_[16]; float ga_[16], gb_[16]; TrItem da_, db_; int it_ = gw; \
        if (it_ < (NITEMS_)) { DEC(da_, it_); tr_load(da_, va_, ga_, lane); \
            for (;;) { { const int nx_ = (it_ + NGW < (NITEMS_)) ? it_ + NGW : it_; DEC(db_, nx_); tr_load(db_, vb_, gb_, lane); }     \
                       tr_finish(da_, va_, ga_, scr, lane); it_ += NGW; if (it_ >= (NITEMS_)) break; \
                       { const int nx_ = (it_ + NGW < (NITEMS_)) ? it_ + NGW : it_; DEC(da_, nx_); tr_load(da_, va_, ga_, lane); } \
                       tr_finish(db_, vb_, gb_, scr, lane); it_ += NGW; if (it_ >= (NITEMS_)) break; } } } while (0)
__device__ __forceinline__ void rms_row_bf16(const float* xrow, const bf16* drow, float* xout, bf16* orow, int lane) {
    const GAS f32x4* xr = (const GAS f32x4*)xrow + lane;
    f32x4 v[16]; float s = 0.f;
#pragma unroll
    for (int j = 0; j < 16; ++j) v[j] = xr[64 * j];
    if (drow) { const GAS unsigned long long* dr = (const GAS unsigned long long*)drow + lane;
#pragma unroll
        for (int j = 0; j < 16; ++j) { const unsigned long long d = dr[64 * j]; const unsigned lo = (unsigned)d, hi = (unsigned)(d >> 32);
            v[j].x += __uint_as_float(lo << 16); v[j].y += __uint_as_float(lo & 0xffff0000u); v[j].z += __uint_as_float(hi << 16); v[j].w += __uint_as_float(hi & 0xffff0000u); } }
    if (xout) { GAS f32x4* xo = (GAS f32x4*)xout + lane;
#pragma unroll
        for (int j = 0; j < 16; ++j) xo[64 * j] = v[j]; }
#pragma unroll
    for (int j = 0; j < 16; ++j) s += (v[j].x * v[j].x + v[j].y * v[j].y) + (v[j].z * v[j].z + v[j].w * v[j].w);
    const float r = 1.0f / sqrtf(wave_sum(s, lane) * (1.f / D_MODEL) + EPS);
    GAS unsigned long long* o8 = (GAS unsigned long long*)orow + lane;
#pragma unroll
    for (int j = 0; j < 16; ++j) o8[64 * j] = (unsigned long long)pk2(v[j].x * r, v[j].y * r) | ((unsigned long long)pk2(v[j].z * r, v[j].w * r) << 32);
}
typedef unsigned v2u __attribute__((ext_vector_type(2)));
typedef unsigned char u8;
__device__ __forceinline__ float bf_lo(unsigned u) { return __uint_as_float(u << 16); }
__device__ __forceinline__ float bf_hi(unsigned u) { return __uint_as_float(u & 0xffff0000u); }
__device__ __forceinline__ unsigned lo_ebits(float hif) { const unsigned e = __float_as_uint(hif) & 0x7f800000u; return e > (16u << 23) ? e : (16u << 23); }
__device__ __forceinline__ float lo_dec(unsigned q, float hif) { return ((float)q - 128.f) * __uint_as_float(lo_ebits(hif) - (15u << 23)); }
__device__ __forceinline__ unsigned lo_enc(float x, float hif) { const float r = (x - hif) * __uint_as_float((269u << 23) - lo_ebits(hif)) + 128.5f;
    return (unsigned)fminf(fmaxf(r, 1.f), 255.f); }
__device__ __forceinline__ void split2(float a, float b, unsigned& h, unsigned& la, unsigned& lb) {
    const unsigned ha = f2bf(a), hb = f2bf(b); h = ha | (hb << 16); la = lo_enc(a, __uint_as_float(ha << 16)); lb = lo_enc(b, __uint_as_float(hb << 16)); }
__device__ __forceinline__ void xrow_first(const float* xrow, bf16* hrow, float* rr, int lane) {
    const GAS f32x4* xr = (const GAS f32x4*)xrow + lane; f32x4 v[16]; float s = 0.f;
#pragma unroll
    for (int j = 0; j < 16; ++j) v[j] = xr[64 * j];
    GAS unsigned long long* o8 = (GAS unsigned long long*)hrow + lane;
#pragma unroll
    for (int j = 0; j < 16; ++j) { s += (v[j].x * v[j].x + v[j].y * v[j].y) + (v[j].z * v[j].z + v[j].w * v[j].w);
        o8[64 * j] = (unsigned long long)pk2(v[j].x, v[j].y) | ((unsigned long long)pk2(v[j].z, v[j].w) << 32); }
    const float r = 1.0f / sqrtf(wave_sum(s, lane) * (1.f / D_MODEL) + EPS);
    if (lane == 0) *(GAS float*)rr = r;
}
__device__ __forceinline__ void xrow_f32(const float* xrow, const bf16* drow, bf16* hrow, u8* lrow, float* rr, int lane) {
    const GAS f32x4* xr = (const GAS f32x4*)xrow + lane; const GAS unsigned long long* dr = (const GAS unsigned long long*)drow + lane;
    f32x4 v[16]; unsigned long long d[16]; float s = 0.f;
#pragma unroll
    for (int j = 0; j < 16; ++j) v[j] = xr[64 * j];
#pragma unroll
    for (int j = 0; j < 16; ++j) d[j] = dr[64 * j];
    GAS unsigned long long* h8 = (GAS unsigned long long*)hrow + lane; GAS unsigned* l4 = (GAS unsigned*)lrow + lane;
#pragma unroll
    for (int j = 0; j < 16; ++j) { const unsigned d0 = (unsigned)d[j], d1 = (unsigned)(d[j] >> 32);
        const float a = v[j].x + bf_lo(d0), b = v[j].y + bf_hi(d0), c = v[j].z + bf_lo(d1), e = v[j].w + bf_hi(d1);
        s += (a * a + b * b) + (c * c + e * e);
        unsigned h0, h1, q0, q1, q2, q3; split2(a, b, h0, q0, q1); split2(c, e, h1, q2, q3);
        h8[64 * j] = (unsigned long long)h0 | ((unsigned long long)h1 << 32); l4[64 * j] = q0 | (q1 << 8) | (q2 << 16) | (q3 << 24); }
    const float r = 1.0f / sqrtf(wave_sum(s, lane) * (1.f / D_MODEL) + EPS);
    if (lane == 0) *(GAS float*)rr = r;
}
__device__ __forceinline__ void xrow_hl(bf16* hrow, u8* lrow, const bf16* drow, float* rr, int lane) {
    GAS v4u* hp = (GAS v4u*)hrow + lane; GAS v2u* lp = (GAS v2u*)lrow + lane; const GAS v4u* dp = (const GAS v4u*)drow + lane;
    v4u h[8], d[8]; v2u l[8]; float s = 0.f;
#pragma unroll
    for (int j = 0; j < 8; ++j) { h[j] = hp[64 * j]; l[j] = lp[64 * j]; d[j] = dp[64 * j]; }
#pragma unroll
    for (int j = 0; j < 8; ++j) { v4u ho; v2u lo = {0u, 0u};
#pragma unroll
        for (int e = 0; e < 4; ++e) { const unsigned lw = l[j][e >> 1]; const int sh = (e & 1) * 16;
            const float h0 = bf_lo(h[j][e]), h1 = bf_hi(h[j][e]);
            const float a = (h0 + lo_dec((lw >> sh) & 255u, h0)) + bf_lo(d[j][e]), b = (h1 + lo_dec((lw >> (sh + 8)) & 255u, h1)) + bf_hi(d[j][e]);
            s += a * a + b * b; unsigned hh, qa, qb; split2(a, b, hh, qa, qb); ho[e] = hh; lo[e >> 1] |= (qa << sh) | (qb << (sh + 8)); }
        hp[64 * j] = ho; lp[64 * j] = lo; }
    const float r = 1.0f / sqrtf(wave_sum(s, lane) * (1.f / D_MODEL) + EPS);
    if (lane == 0) *(GAS float*)rr = r;
}
__device__ __forceinline__ void xrow_final(float* orow, const bf16* hrow, const u8* lrow, const bf16* drow, const float* g, int lane) {
    GAS f32x4* xo = (GAS f32x4*)orow + lane; const GAS f32x4* gr = (const GAS f32x4*)g + lane;
    const GAS unsigned long long* hr = (const GAS unsigned long long*)hrow + lane; const GAS unsigned* lr = (const GAS unsigned*)lrow + lane;
    const GAS unsigned long long* dr = (const GAS unsigned long long*)drow + lane;
    unsigned long long h[16], d[16]; unsigned l[16]; f32x4 v[16]; float s = 0.f;
#pragma unroll
    for (int j = 0; j < 16; ++j) { h[j] = hr[64 * j]; l[j] = lr[64 * j]; d[j] = dr[64 * j]; }
#pragma unroll
    for (int j = 0; j < 16; ++j) { const unsigned h0 = (unsigned)h[j], h1 = (unsigned)(h[j] >> 32), d0 = (unsigned)d[j], d1 = (unsigned)(d[j] >> 32), lw = l[j];
        const float a0 = bf_lo(h0), a1 = bf_hi(h0), a2 = bf_lo(h1), a3 = bf_hi(h1);
        v[j].x = (a0 + lo_dec(lw & 255u, a0)) + bf_lo(d0); v[j].y = (a1 + lo_dec((lw >> 8) & 255u, a1)) + bf_hi(d0);
        v[j].z = (a2 + lo_dec((lw >> 16) & 255u, a2)) + bf_lo(d1); v[j].w = (a3 + lo_dec(lw >> 24, a3)) + bf_hi(d1);
        s += (v[j].x * v[j].x + v[j].y * v[j].y) + (v[j].z * v[j].z + v[j].w * v[j].w); }
    const float r = 1.0f / sqrtf(wave_sum(s, lane) * (1.f / D_MODEL) + EPS);
#pragma unroll
    for (int j = 0; j < 16; ++j) { const f32x4 gg = gr[64 * j]; xo[64 * j] = (v[j] * r) * gg; }
}
__device__ __forceinline__ float sumsq8(v4u a) {
    float s = 0.f;
#pragma unroll
    for (int i = 0; i < 4; ++i) { const float lo = __uint_as_float(a[i] << 16), hi = __uint_as_float(a[i] & 0xffff0000u); s += lo * lo + hi * hi; }
    return s;
}
__device__ __forceinline__ v4u scale8(v4u a, float r) {
    v4u o;
#pragma unroll
    for (int i = 0; i < 4; ++i) { const float lo = __uint_as_float(a[i] << 16), hi = __uint_as_float(a[i] & 0xffff0000u); o[i] = pk2(lo * r, hi * r); }
    return o;
}
__device__ __forceinline__ void cnorm_row(bf16* prow, int lane) {
    GAS v4u* p = (GAS v4u*)prow + lane;
    const v4u a = p[0], b = p[64], c = p[128];
    const float sq = wave_sum(sumsq8(a) + sumsq8(b), lane), sk = wave_sum(sumsq8(c), lane);
    const float rq = 1.0f / sqrtf(sq * (1.f / 1024.f) + EPS), rk = 1.0f / sqrtf(sk * (1.f / 512.f) + EPS);
    p[0] = scale8(a, rq); p[64] = scale8(b, rq); p[128] = scale8(c, rk);
}

#define SETI(d, W_, g_, WT_, K_, N_, ro_, map_, it_) do { d.W = (W_); d.gain = (g_); d.WT = (WT_); d.K = (K_); d.N = (N_); d.row_off = (ro_); d.map = (map_); d.item = (it_); } while (0)
#define DEC_A(d, it) do { int r_ = (it); \
        if (r_ < CA_IN) { SETI(d, a_w_in + (size_t)cj_ * D_MODEL * A_IN, norm_g + (2 * cj_) * D_MODEL, W_IN, D_MODEL, A_IN, 0, 1, r_); } \
        else if (r_ < CA_IN + CA_MKV) { SETI(d, w_mem_kv + (size_t)(2 * cj_) * D_MODEL * 2048, mem_norm_g + (2 * cj_) * D_MODEL, W_IN, D_MODEL, 2048, A_LDP, 0, r_ - CA_IN); } \
        else if (r_ < CA_IN + 2 * CA_MKV) { SETI(d, w_mem_kv + (size_t)(2 * cj_ + 1) * D_MODEL * 2048, mem_norm_g + (2 * cj_ + 1) * D_MODEL, W_IN, D_MODEL, 2048, A_LDP + 2048, 0, r_ - CA_IN - CA_MKV); } \
        else if (r_ < CA_IN + 2 * CA_MKV + CA_QB) { SETI(d, a_w_qb + (size_t)cj_ * 1024 * QW, a_q_g + cj_ * 1024, W_QB, 1024, QW, 0, 2, r_ - CA_IN - 2 * CA_MKV); } \
        else if (r_ < CA_IN + 2 * CA_MKV + CA_QB + CA_KVB) { SETI(d, a_w_kvb + (size_t)cj_ * 512 * KVW, a_kv_g + cj_ * 512, W_KVB, 512, KVW, 0, 0, r_ - CA_IN - 2 * CA_MKV - CA_QB); } \
        else { SETI(d, w_out + (size_t)(2 * cj_) * D_MODEL * D_MODEL, (const float*)nullptr, (bf16*)(ws + WS_WOUT), D_MODEL, D_MODEL, 0, 0, r_ - CA_IN - 2 * CA_MKV - CA_QB - CA_KVB); } } while (0)
#define CONV_A(jj) do { constexpr int CA_IN = 64 * (A_IN / 64), CA_MKV = 64 * 32, CA_QB = 16 * (QW / 64), CA_KVB = 8 * (KVW / 64), CA_OUT = 64 * 64; \
        constexpr int NITEMS = CA_IN + 2 * CA_MKV + CA_QB + CA_KVB + CA_OUT; const int cj_ = (jj); \
        CONV_RUN(NITEMS, DEC_A); } while (0)
#define DEC_B(d, it) do { const int r_ = (it); \
        if (r_ < CB_IN) { SETI(d, b_w_in + (size_t)cj_ * D_MODEL * B_IN, norm_g + (2 * cj_ + 1) * D_MODEL, W_IN, D_MODEL, B_IN, 0, 0, r_); } \
        else { SETI(d, w_out + (size_t)(2 * cj_ + 1) * D_MODEL * D_MODEL, (const float*)nullptr, (bf16*)(ws + WS_WOUT2), D_MODEL, D_MODEL, 0, 0, r_ - CB_IN); } } while (0)
#define CONV_B(jj) do { constexpr int CB_IN = 64 * (B_IN / 64), CB_OUT = 64 * 64, NITEMS = CB_IN + CB_OUT; const int cj_ = (jj); \
        CONV_RUN(NITEMS, DEC_B); } while (0)

struct Args { const float* in[16]; float* out; unsigned char* ws; int ph_lo, ph_hi; };

__global__ void __launch_bounds__(NWAVES * 64, 2) fwd_kernel(Args args) {
    extern __shared__ __attribute__((aligned(16))) unsigned char lds_raw[];
    LAS unsigned char* lds = (LAS unsigned char*)lds_raw;
    volatile LAS unsigned* MISC = (volatile LAS unsigned*)(lds + MISC_OFF);
    const int wave_k = __builtin_amdgcn_readfirstlane(threadIdx.x >> 6);
    const int G = gridDim.x, bx = blockIdx.x, vcu = (G % 8 == 0) ? (bx % 8) * (G / 8) + bx / 8 : bx;
#define PH_PTRS \
    const int tid = fresh_tid(wave_k), lane = tid & 63, wave = wave_k; \
    const int gw = vcu * NWAVES + wave, NGW = G * NWAVES; LAS float* scr = (LAS float*)(lds + wave * 16384); (void)lane; (void)gw; (void)NGW; (void)scr; \
    const __attribute__((address_space(4))) Args* ap_ = (const __attribute__((address_space(4))) Args*)__builtin_amdgcn_kernarg_segment_ptr(); asm volatile("" : "+s"(ap_)); \
    unsigned char* ws = ap_->ws; float* out = ap_->out; \
    const float* x_in = ap_->in[0]; const float* mem_in = ap_->in[1]; const int* pos_in = (const int*)ap_->in[2]; \
    const float* norm_g = ap_->in[3]; const float* mem_norm_g = ap_->in[4]; const float* final_g = ap_->in[5]; \
    const float* w_mem_kv = ap_->in[6]; const float* w_out = ap_->in[7]; const float* a_w_in = ap_->in[8]; \
    const float* a_q_g = ap_->in[9]; const float* a_kv_g = ap_->in[10]; const float* a_w_qb = ap_->in[11]; const float* a_w_kvb = ap_->in[12]; \
    const float* b_w_in = ap_->in[13]; const float* b_sinks = ap_->in[14]; const float* rel_bias = ap_->in[15]; \
    float* cosT = (float*)(ws + WS_COS); float* sinT = (float*)(ws + WS_SIN); float* bias2 = (float*)(ws + WS_BIAS); \
    bf16* MKV = (bf16*)(ws + WS_MKV); bf16* W_IN = (bf16*)(ws + WS_WIN); bf16* W_QB = (bf16*)(ws + WS_WQB); bf16* W_KVB = (bf16*)(ws + WS_WKVB); bf16* W_OUT = (bf16*)(ws + WS_WOUT); \
    float* PART = (float*)(ws + WS_PART); bf16* HI = (bf16*)(ws + WS_HI); u8* LO = (u8*)(ws + WS_LO); float* RR = (float*)(ws + WS_RR); bf16* Y = (bf16*)(ws + WS_HB); bf16* PROJ = (bf16*)(ws + WS_PROJ); bf16* QB = (bf16*)(ws + WS_Q); bf16* KVB = (bf16*)out; \
    (void)out; (void)x_in; (void)mem_in; (void)pos_in; (void)norm_g; (void)mem_norm_g; (void)final_g; (void)w_mem_kv; (void)w_out; (void)a_w_in; (void)a_q_g; (void)a_kv_g; (void)a_w_qb; (void)a_w_kvb; \
    (void)b_w_in; (void)b_sinks; (void)rel_bias; (void)cosT; (void)sinT; (void)bias2; (void)MKV; (void)W_IN; (void)W_QB; (void)W_KVB; (void)W_OUT; (void)PART; (void)HI; (void)LO; (void)RR; (void)Y; (void)PROJ; (void)QB; (void)KVB;
    unsigned* ctl = (unsigned*)(args.ws + WS_CTL);

    for (int u = threadIdx.x; u < (LDS_BYTES - LDSCTL_OFF) / 4; u += NWAVES * 64) ((LAS unsigned*)(lds + LDSCTL_OFF))[u] = 0u;
    __syncthreads();
    XcdBarrier bar = xcd_barrier_post(ctl + CW_BAR, MISC + 8);
    const int lo = args.ph_lo, hi = args.ph_hi;
    int pc = 0;
#define PH_RUN() (pc >= lo && pc < hi)
#define PH_END() do { if (pc >= lo && pc + 1 < hi) xcd_barrier(bar, wave_k); ++pc; } while (0)

#pragma unroll 1
    for (int j = 0; j < 2; ++j) {
        const int la = 2 * j, lb = 2 * j + 1;
        if (PH_RUN()) { PH_PTRS
            if (j == 0) CONV_A(0);
            const bf16* DL = (const bf16*)(ws + WS_Q);
            if (j == 0) { for (int m = gw; m < M_TOK; m += NGW) xrow_first(x_in + (size_t)m * D_MODEL, HI + (size_t)m * D_MODEL, RR + m, lane); }
            else { for (int m = gw; m < M_TOK; m += NGW) xrow_hl(HI + (size_t)m * D_MODEL, LO + (size_t)m * D_MODEL, DL + (size_t)m * D_MODEL, RR + m, lane); }
            if (j == 0) {
                for (int m = gw; m < M_MEM; m += NGW) rms_row_bf16(mem_in + (size_t)m * D_MODEL, nullptr, nullptr, HI + (size_t)(M_TOK + m) * D_MODEL, lane);
                for (int e = (vcu * NWAVES * 64) + tid; e < M_TOK * 32; e += G * NWAVES * 64) {
                    const int tok = e >> 5, i = e & 31;
                    const float inv = INVF[i];
                    const float ang = (float)pos_in[tok] * inv;
                    const double rev = (double)ang * 0.15915494309189535; const double fr = rev - rint(rev);
                    const float rad = (float)(fr * 6.283185307179586);
                    cosT[e] = cosf(rad); sinT[e] = sinf(rad);
                }
                for (int e = (vcu * NWAVES * 64) + tid; e < 49 * 320; e += G * NWAVES * 64) { const int h = e / 320, d = e - h * 320 - 96;
                    bias2[e] = (h < 48 && (unsigned)d < 128u) ? rel_bias[(int)T5B[d] * 48 + h] * LOG2E : -__builtin_inff(); }
            }
        }
        PH_END();
        if (PH_RUN()) { PH_PTRS
            pg8::Gemm g{HI, W_IN, D_MODEL, D_MODEL, D_MODEL}; pg8::SchedAin S; S.o.init(64, 27, 64, G, bx);
            pg8::Unit u0; u0.pm = 0; u0.pn = 0; (void)S.o.next(0, u0);
            LAS float* rrl = (LAS float*)(lds + RRL_OFF); if (tid < 256) rrl[tid] = RR[u0.pm * 256 + tid]; __syncthreads();
            pg8::EpiAin E{PROJ, MKV, cosT, sinT, RR, rrl, u0.pm, PART};
            pg8::gemm_phase<pg8::EpiAin, pg8::SchedAin, true, true>(lds, g, S, E, tid);
        }
        PH_END();
        if (PH_RUN()) { PH_PTRS
            pg8::Unit u0; u0.pm = 0; u0.pn = 0; { pg8::StaticOrder o; o.init(64, QW / 256, 0, G, bx); (void)o.next(0, u0); }
            LAS float* rrq = (LAS float*)(lds + RRL_OFF); LAS float* rrk = rrq + 256;
            { const int r = tid >> 1, hs = tid & 1; const GAS f32x4* p4 = (const GAS f32x4*)(PART + (size_t)(u0.pm * 256 + r) * 48);
              float sq = 0.f, sk = 0.f;
#pragma unroll
              for (int i = 0; i < 4; ++i) { const f32x4 a = p4[hs * 4 + i]; sq += (a.x + a.y) + (a.z + a.w); }
#pragma unroll
              for (int i = 0; i < 2; ++i) { const f32x4 a = p4[8 + hs * 2 + i]; sk += (a.x + a.y) + (a.z + a.w); }
              sq += shx(sq, lane, 1); sk += shx(sk, lane, 1);
              if (hs == 0) { rrq[r] = 1.0f / sqrtf(sq * (1.f / 1024.f) + EPS); rrk[r] = 1.0f / sqrtf(sk * (1.f / 512.f) + EPS); }
              __syncthreads(); }
            { pg8::Gemm g{PROJ + A_OFF_CQ, W_QB, A_LDP, 1024, 1024}; pg8::SchedPlain S; S.o.init(64, QW / 256, 0, G, bx);
              pg8::EpiQ E{QB, cosT, sinT, PART, rrq, u0.pm}; pg8::gemm_phase<pg8::EpiQ, pg8::SchedPlain, true, true>(lds, g, S, E, tid); }
            { pg8::Gemm g{PROJ + A_OFF_CKV, W_KVB, A_LDP, 512, 512}; pg8::SchedKV S; S.o.init(64, KVW / 256, 0, G, bx);
              pg8::EpiKV E{KVB, PART, rrk, u0.pm}; pg8::gemm_phase<pg8::EpiKV, pg8::SchedKV, true, true>(lds, g, S, E, tid); }
        }
        PH_END();
        if (PH_RUN()) { PH_PTRS
#pragma unroll 1
            for (int P = vcu; P < 768; P += G) {
                const int bh = P >> 3, xq = P & 7, b = bh / 24, h = bh % 24;
#pragma unroll 1
                for (int pass = 0; pass < 2; ++pass) {
                    const int qb = pass ? 15 - xq : xq; const size_t rows0 = (size_t)b * SEQ + qb * 256 + wave * 32, kr0 = (size_t)b * SEQ;
                    att::mla_core_dma((LAS char*)lds, QB + rows0 * QW + h * 192, QW, KVB + kr0 * KVW + h * 256, KVW, PROJ + kr0 * A_LDP + A_OFF_KR, A_LDP,
                                  KVB + kr0 * KVW + h * 256 + 128, KVW, 4 * (qb + 1), qb * 256 + wave * 32,
                                  PROJ + rows0 * A_LDP + A_OFF_Z + h * 128, A_LDP, Y + rows0 * D_MODEL + h * 128, D_MODEL, fresh_tid(wave_k));
                }
            }
#pragma unroll 1
            for (int U = vcu; U < 256; U += G) {
                const int qb = U & 15, xh = (U >> 4) & 3, b = U >> 6; const size_t rows0 = (size_t)b * SEQ + qb * 256 + wave * 32;
                const bf16* mk = MKV + (size_t)(b * N_MEM) * 2048; const int yc = 3072 + xh * 256;
                att::mem_core2((LAS char*)lds, PROJ + rows0 * A_LDP + A_OFF_XQ + xh * 256, A_LDP, mk + xh * 256, 2048, mk + 1024 + xh * 256, 2048,
                                  PROJ + rows0 * A_LDP + A_OFF_Z + yc, A_LDP, Y + rows0 * D_MODEL + yc, D_MODEL, fresh_tid(wave_k));
            }
        }
        PH_END();
        if (PH_RUN()) { PH_PTRS
            pg8::Gemm g{Y, (bf16*)(ws + WS_WOUT), D_MODEL, D_MODEL, D_MODEL};
            pg8::EpiPlain E{(bf16*)(ws + WS_Q), D_MODEL};
            const int nb = (bx & 7) & 3;
            { pg8::SchedRange S; S.o.init(64, 16, 0, G, bx); S.i0 = 0; S.n = nb; pg8::gemm_phase<pg8::EpiPlain, pg8::SchedRange, true, true>(lds, g, S, E, tid); }
            CONV_B(j); __syncthreads();
            { pg8::SchedRange S; S.o.init(64, 16, 0, G, bx); S.i0 = nb; S.n = 1 << 30; pg8::gemm_phase<pg8::EpiPlain, pg8::SchedRange, true, true>(lds, g, S, E, tid); }
        }
        PH_END();
        if (PH_RUN()) { PH_PTRS
            { const bf16* DL = (const bf16*)(ws + WS_Q);
              if (j == 0) { for (int m = gw; m < M_TOK; m += NGW) xrow_f32(x_in + (size_t)m * D_MODEL, DL + (size_t)m * D_MODEL, HI + (size_t)m * D_MODEL, LO + (size_t)m * D_MODEL, RR + m, lane); }
              else { for (int m = gw; m < M_TOK; m += NGW) xrow_hl(HI + (size_t)m * D_MODEL, LO + (size_t)m * D_MODEL, DL + (size_t)m * D_MODEL, RR + m, lane); } }
        }
        PH_END();
        if (PH_RUN()) { PH_PTRS
            pg8::Gemm g{HI, W_IN, D_MODEL, D_MODEL, D_MODEL}; pg8::SchedPlain S; S.o.init(64, B_IN / 256, 0, G, bx);
            pg8::Unit u0; u0.pm = 0; u0.pn = 0; (void)S.o.next(0, u0);
            LAS float* rrl = (LAS float*)(lds + RRL_OFF); if (tid < 256) rrl[tid] = RR[u0.pm * 256 + tid]; __syncthreads();
            pg8::EpiBin E{PROJ, RR, rrl, u0.pm};
            pg8::gemm_phase<pg8::EpiBin, pg8::SchedPlain, true, true>(lds, g, S, E, tid);
        }
        PH_END();
        if (PH_RUN()) { PH_PTRS
            { att::swa_phase((LAS char*)lds, PROJ, Y, bias2, b_sinks + j * 48, vcu, G, tid); }
#pragma unroll 1
            for (int U = vcu; U < 256; U += G) {
                const int qb = U & 15, xh = (U >> 4) & 3, b = U >> 6; const size_t rows0 = (size_t)b * SEQ + qb * 256 + wave * 32;
                const bf16* mk = MKV + (size_t)M_MEM * 2048 + (size_t)(b * N_MEM) * 2048; const int yc = 3072 + xh * 256;
                att::mem_core2((LAS char*)lds, PROJ + rows0 * B_IN + B_OFF_XQ + xh * 256, B_IN, mk + xh * 256, 2048, mk + 1024 + xh * 256, 2048,
                                  PROJ + rows0 * B_IN + B_OFF_Z + yc, B_IN, Y + rows0 * D_MODEL + yc, D_MODEL, fresh_tid(wave_k));
            }
        }
        PH_END();
        if (PH_RUN()) { PH_PTRS
            pg8::Gemm g{Y, (bf16*)(ws + WS_WOUT2), D_MODEL, D_MODEL, D_MODEL};
            pg8::EpiPlain E{(bf16*)(ws + WS_Q), D_MODEL};
            const int nb = (bx & 7) & 3;
            { pg8::SchedRange S; S.o.init(64, 16, 0, G, bx); S.i0 = 0; S.n = nb; pg8::gemm_phase<pg8::EpiPlain, pg8::SchedRange, true, true>(lds, g, S, E, tid); }
            if (j == 0) CONV_A(1);
            __syncthreads();
            { pg8::SchedRange S; S.o.init(64, 16, 0, G, bx); S.i0 = nb; S.n = 1 << 30; pg8::gemm_phase<pg8::EpiPlain, pg8::SchedRange, true, true>(lds, g, S, E, tid); }
        }
        PH_END();
    }
    if (PH_RUN()) { PH_PTRS for (int m = gw; m < M_TOK; m += NGW) xrow_final(out + (size_t)m * D_MODEL, HI + (size_t)m * D_MODEL, LO + (size_t)m * D_MODEL, (const bf16*)(ws + WS_Q) + (size_t)m * D_MODEL, final_g, lane); }
#undef PH_RUN
#undef PH_END
}

constexpr int N_PHASES = 19;
extern "C" void kernel_launch(void* const* d_in, const int* in_sizes, int n_in, void* d_out, int out_size, void* d_ws, size_t ws_size, hipStream_t stream) {
    static int grid = 0;
    if (grid == 0) {
        if (n_in != 16 || in_sizes[0] != M_TOK * D_MODEL || out_size != M_TOK * D_MODEL || ws_size < WS_END) {
            fprintf(stderr, "kernel_launch: unexpected shapes (n_in %d, in0 %d, out %d, ws %zu)\n", n_in, n_in > 0 ? in_sizes[0] : -1, out_size, ws_size); grid = -1; return; }
        int dev = 0, cus = 0, per_cu = 0;
        if (hipGetDevice(&dev) != hipSuccess || hipDeviceGetAttribute(&cus, hipDeviceAttributeMultiprocessorCount, dev) != hipSuccess) { grid = -1; return; }
        if (hipFuncSetAttribute((const void*)fwd_kernel, hipFuncAttributeMaxDynamicSharedMemorySize, LDS_BYTES) != hipSuccess) { fprintf(stderr, "kernel_launch: hipFuncSetAttribute failed\n"); grid = -1; return; }
        if (hipOccupancyMaxActiveBlocksPerMultiprocessor(&per_cu, (const void*)fwd_kernel, NWAVES * 64, LDS_BYTES) != hipSuccess || per_cu < 1)
            fprintf(stderr, "kernel_launch: note: occupancy query reports %d workgroups per CU\n", per_cu);
        (void)hipGetLastError();
        grid = cus;
    }
    if (grid < 0) return;
    if (hipMemsetAsync((char*)d_ws + WS_CTL, 0, CTL_ZERO_BYTES, stream) != hipSuccess) return;
    Args a{};
    for (int i = 0; i < 16; ++i) a.in[i] = (const float*)d_in[i];
    a.out = (float*)d_out; a.ws = (unsigned char*)d_ws;
#if defined(MK_PER_PHASE)
    for (int p = 0; p < N_PHASES; ++p) { a.ph_lo = p; a.ph_hi = p + 1; hipLaunchKernelGGL(fwd_kernel, dim3(grid), dim3(NWAVES * 64), LDS_BYTES, stream, a); }
#else
    a.ph_lo = 0; a.ph_hi = N_PHASES;
    hipLaunchKernelGGL(fwd_kernel, dim3(grid), dim3(NWAVES * 64), LDS_BYTES, stream, a);
#endif
    const hipError_t le = hipPeekAtLastError();
    if (le != hipSuccess) fprintf(stderr, "kernel_launch: launch failed: %s\n", hipGetErrorName(le));
}
```

```cpp
#include <hip/hip_runtime.h>
#include <cstdio>
#include <cstdint>
#include <cmath>
namespace pg8 {
#define PG8_LAS __attribute__((address_space(3)))
typedef unsigned short bf16_t;
typedef short bf16x8 __attribute__((ext_vector_type(8)));
typedef float f32x4 __attribute__((ext_vector_type(4)));
typedef unsigned u32x4 __attribute__((ext_vector_type(4)));
constexpr int BM = 256, BK = 64, HALF = 128, HTB = HALF * BK * 2  , STAGE_BYTES = 8 * HTB, NXCD = 8, WGM = 8;

__host__ __device__ __forceinline__ int lds_byte(int r, int c) { const int st = (r >> 4) * 2 + (c >> 5), rr = r & 15, cc = c & 31, ob = rr * 64 + cc * 2; return st * 1024 + (ob ^ (((ob >> 9) & 1) << 5)); }
__host__ __device__ __forceinline__ void stage_rc(int b, int& R, int& C) { const int st = b / 1024, sb = b % 1024, swz = sb ^ (((sb >> 9) & 1) << 5); R = (st >> 1) * 16 + swz / 64; C = (st & 1) * 32 + (swz % 64) / 2; }
__host__ __device__ __forceinline__ int perm32(int rho) { const int n = rho >> 4, i = rho & 15; return 8 * (i >> 2) + 4 * n + (i & 3); }

struct Unit { int pm, pn; };
struct Gemm { const bf16_t* A; const bf16_t* Bt; int lda, ldb, K; };

struct StaticOrder {
    int nM, nN, nwg, nX, G, c;
    __host__ __device__ void init(int nM_, int nN_, int nX_, int G_, int c_) { nM = nM_; nN = nN_; nwg = nM * nN; nX = nX_; G = G_; c = c_; }
    __host__ __device__ __forceinline__ bool next(int i, Unit& u) const {
        const long L = (long)i * G + c; if (L >= nwg + nX) return false;
        if (L >= nwg) { u.pm = -1; u.pn = (int)(L - nwg); return true; }
        map((int)L, u); return true;
    }
    __host__ __device__ __forceinline__ void map(int L, Unit& u) const {
        int wgid = L; { const int q = nwg / NXCD, r = nwg % NXCD, xcd = wgid % NXCD, off = wgid / NXCD; wgid = (xcd < r ? xcd * (q + 1) : r * (q + 1) + (xcd - r) * q) + off; }
        const int nig = WGM * nN, gid = wgid / nig, fm = gid * WGM, gsz = (nM - fm) < WGM ? (nM - fm) : WGM;
        u.pm = fm + ((wgid % nig) % gsz); u.pn = (wgid % nig) / gsz;
    }
};

typedef float f32x2_t __attribute__((ext_vector_type(2))); typedef __bf16 bf16x2_t __attribute__((ext_vector_type(2)));
__device__ __forceinline__ unsigned cvt_pk_bf16(float lo, float hi) { const f32x2_t v = {lo, hi}; const bf16x2_t b = __builtin_convertvector(v, bf16x2_t); return __builtin_bit_cast(unsigned, b); }


template <class Epi, class Sched, bool ALIGN_EPI = false, bool SP2 = false>
__device__ __forceinline__ void gemm_phase(PG8_LAS unsigned char* lds, const Gemm g, const Sched& S, const Epi& E, int tid_in) {
    int tid_ = tid_in; asm volatile("" : "+v"(tid_));
    const int tid = tid_, wid = __builtin_amdgcn_readfirstlane(tid >> 6), lane = tid & 63, wr = wid >> 2, wc = wid & 3, fr = lane & 15, fq = lane >> 4;
    const int K = g.K, nt = K / BK;
    unsigned voffA[2], voffB[2];
#pragma unroll
    for (int i = 0; i < 2; ++i) { int R, C; stage_rc(tid * 16 + i * 8192, R, C); const int Rb = Epi::PERM ? ((R & ~31) + perm32(R & 31)) : R;
        voffA[i] = (unsigned)(R * g.lda + C) * 2u; voffB[i] = (unsigned)(Rb * g.ldb + C) * 2u; }
    const size_t kstep = (size_t)(BK * 2);
    const size_t hstepA = (size_t)HALF * g.lda * 2, hstepB = (size_t)HALF * g.ldb * 2;
    const size_t tstepA = 2 * hstepA, tstepB = 2 * hstepB;
    const unsigned ldsw = (unsigned)wid * 1024u;
    const int aoff = lds_byte(wr * 64 + fr, fq * 8), boff = lds_byte(wc * 32 + fr, fq * 8);
#define PG8_SA(b, h) (((b) * 2 + (h)) * HTB)
#define PG8_SB(b, h) ((4 + (b) * 2 + (h)) * HTB)
#define PG8_STAGE(bufoff, gbase, voff) do { _Pragma("unroll") for (int _i = 0; _i < 2; ++_i) \
        __builtin_amdgcn_global_load_lds((const unsigned*)((const char*)(gbase) + (voff)[_i]), (PG8_LAS unsigned*)(lds + (bufoff) + ldsw + _i * 8192), 16, 0, 0); } while (0)
#define PG8_LDA(dst, b, h) do { _Pragma("unroll") for (int m = 0; m < 4; ++m) _Pragma("unroll") for (int k = 0; k < 2; ++k) dst[m][k] = *(const PG8_LAS bf16x8*)(lds + PG8_SA(b, h) + aoff + m * 2048 + k * 1024); } while (0)
#define PG8_LDB(dst, b, h) do { _Pragma("unroll") for (int n = 0; n < 2; ++n) _Pragma("unroll") for (int k = 0; k < 2; ++k) dst[n][k] = *(const PG8_LAS bf16x8*)(lds + PG8_SB(b, h) + boff + n * 2048 + k * 1024); } while (0)
#define PG8_MMA(ai, bj, At, Bt) do { __builtin_amdgcn_s_setprio(1); _Pragma("unroll") for (int m = 0; m < 4; ++m) _Pragma("unroll") for (int n = 0; n < 2; ++n) _Pragma("unroll") for (int k = 0; k < 2; ++k) \
        acc[ai][bj][m][n] = __builtin_amdgcn_mfma_f32_16x16x32_bf16(Bt[n][k], At[m][k], acc[ai][bj][m][n], 0, 0, 0); __builtin_amdgcn_s_setprio(0); } while (0)
#define PG8_WAIT_V(n) asm volatile("s_waitcnt vmcnt(" #n ")" ::: "memory")
#define PG8_WAIT_L(n) asm volatile("s_waitcnt lgkmcnt(" #n ")" ::: "memory")
#define PG8_BAR __builtin_amdgcn_s_barrier()
#define PG8_SCHED __builtin_amdgcn_sched_barrier(0)
    Unit cur, nxt; int ui = 0;
    if (!S.next(0, cur)) return;
    S.fix(cur);
    f32x4 acc[2][2][4][2];
#pragma unroll
    for (int a = 0; a < 2; ++a)
#pragma unroll
        for (int b = 0; b < 2; ++b)
#pragma unroll
            for (int m = 0; m < 4; ++m)
#pragma unroll
                for (int n = 0; n < 2; ++n) acc[a][b][m][n] = (f32x4){0.f, 0.f, 0.f, 0.f};
    bf16x8 At[4][2], B0[2][2], B1[2][2];
    const char* cA = (const char*)g.A + (size_t)cur.pm * tstepA; const char* cB = (const char*)g.Bt + (size_t)cur.pn * tstepB;
    if constexpr (SP2) {
        PG8_STAGE(PG8_SB(0, 0), cB, voffB); PG8_STAGE(PG8_SB(0, 1), cB + hstepB, voffB); PG8_STAGE(PG8_SA(0, 0), cA, voffA); PG8_STAGE(PG8_SA(0, 1), cA + hstepA, voffA);
        if (wr == 1) PG8_BAR;
        PG8_WAIT_V(2); PG8_BAR;
        PG8_STAGE(PG8_SB(1, 0), cB + kstep, voffB); PG8_STAGE(PG8_SA(1, 0), cA + kstep, voffA); PG8_STAGE(PG8_SB(1, 1), cB + hstepB + kstep, voffB);
        PG8_WAIT_V(6); PG8_BAR;
    } else {
        PG8_STAGE(PG8_SB(0, 0), cB, voffB); PG8_STAGE(PG8_SA(0, 0), cA, voffA); PG8_STAGE(PG8_SB(0, 1), cB + hstepB, voffB); PG8_STAGE(PG8_SA(0, 1), cA + hstepA, voffA);
        if (wr == 1) PG8_BAR;
        PG8_WAIT_V(4); PG8_BAR;
        PG8_STAGE(PG8_SB(1, 0), cB + kstep, voffB); PG8_STAGE(PG8_SA(1, 0), cA + kstep, voffA); PG8_STAGE(PG8_SB(1, 1), cB + hstepB + kstep, voffB);
        PG8_WAIT_V(6); PG8_BAR;
    }
    for (;;) {
        bool has_next = S.next(ui + 1, nxt);
        if (has_next) S.fix(nxt);
        const char* nA = has_next ? (const char*)g.A + (size_t)nxt.pm * tstepA : cA; const char* nB = has_next ? (const char*)g.Bt + (size_t)nxt.pn * tstepB : cB;
        for (int t = 0; t < nt; t += 2) {
            const bool last = (t == nt - 2);
            const char* a1 = cA + (size_t)(t + 1) * kstep;
            const char* a2 = last ? nA : cA + (size_t)(t + 2) * kstep; const char* b2 = last ? nB : cB + (size_t)(t + 2) * kstep;
            const char* a3 = a2 + kstep; const char* b3 = b2 + kstep;
            if constexpr (SP2) {
            PG8_LDB(B0, 0, 0); PG8_LDB(B1, 0, 1); PG8_SCHED; PG8_LDA(At, 0, 0); PG8_STAGE(PG8_SA(1, 1), a1 + hstepA, voffA);
            PG8_WAIT_V(8); PG8_WAIT_L(0); PG8_BAR; PG8_MMA(0, 0, At, B0); PG8_MMA(0, 1, At, B1); PG8_BAR; PG8_SCHED;
            PG8_LDA(At, 0, 1); PG8_STAGE(PG8_SB(0, 0), b2, voffB); PG8_STAGE(PG8_SB(0, 1), b2 + hstepB, voffB); PG8_STAGE(PG8_SA(0, 0), a2, voffA);
            PG8_WAIT_V(8); PG8_WAIT_L(0); PG8_BAR; PG8_MMA(1, 0, At, B0); PG8_MMA(1, 1, At, B1); PG8_BAR; PG8_SCHED;
            PG8_LDB(B0, 1, 0); PG8_LDB(B1, 1, 1); PG8_SCHED; PG8_LDA(At, 1, 0); PG8_STAGE(PG8_SA(0, 1), a2 + hstepA, voffA);
            PG8_WAIT_V(8); PG8_WAIT_L(0); PG8_BAR; PG8_MMA(0, 0, At, B0); PG8_MMA(0, 1, At, B1); PG8_BAR; PG8_SCHED;
            PG8_LDA(At, 1, 1); PG8_STAGE(PG8_SB(1, 0), b3, voffB); PG8_STAGE(PG8_SB(1, 1), b3 + hstepB, voffB); PG8_STAGE(PG8_SA(1, 0), a3, voffA);
            PG8_WAIT_V(8); PG8_WAIT_L(0); PG8_BAR; PG8_MMA(1, 0, At, B0); PG8_MMA(1, 1, At, B1); PG8_BAR; PG8_SCHED;
            } else {
            PG8_LDB(B0, 0, 0); PG8_SCHED; PG8_LDA(At, 0, 0); PG8_STAGE(PG8_SA(1, 1), a1 + hstepA, voffA);
            PG8_WAIT_L(8); PG8_BAR; PG8_WAIT_L(0); PG8_MMA(0, 0, At, B0); PG8_BAR; PG8_SCHED;
            PG8_LDB(B1, 0, 1); PG8_STAGE(PG8_SB(0, 0), b2, voffB);
            PG8_BAR; PG8_WAIT_L(0); PG8_MMA(0, 1, At, B1); PG8_BAR;
            PG8_LDA(At, 0, 1); PG8_STAGE(PG8_SA(0, 0), a2, voffA);
            PG8_BAR; PG8_WAIT_L(0); PG8_MMA(1, 0, At, B0); PG8_BAR; PG8_SCHED;
            PG8_STAGE(PG8_SB(0, 1), b2 + hstepB, voffB);
            PG8_WAIT_V(6); PG8_BAR; PG8_MMA(1, 1, At, B1); PG8_BAR;
            PG8_LDB(B0, 1, 0); PG8_SCHED; PG8_LDA(At, 1, 0); PG8_STAGE(PG8_SA(0, 1), a2 + hstepA, voffA);
            PG8_WAIT_L(8); PG8_BAR; PG8_WAIT_L(0); PG8_MMA(0, 0, At, B0); PG8_BAR; PG8_SCHED;
            PG8_LDB(B1, 1, 1); PG8_STAGE(PG8_SB(1, 0), b3, voffB);
            PG8_BAR; PG8_WAIT_L(0); PG8_MMA(0, 1, At, B1); PG8_BAR;
            PG8_LDA(At, 1, 1); PG8_STAGE(PG8_SA(1, 0), a3, voffA);
            PG8_BAR; PG8_WAIT_L(0); PG8_MMA(1, 0, At, B0); PG8_BAR; PG8_SCHED;
            PG8_STAGE(PG8_SB(1, 1), b3 + hstepB, voffB);
            PG8_WAIT_V(6); PG8_BAR; PG8_MMA(1, 1, At, B1); PG8_BAR;
            }
        }
        if constexpr (ALIGN_EPI) { if (wr == 0) PG8_BAR; }
        E(acc, cur, wr, wc, fr, fq);
        if (!has_next) break;
#pragma unroll
        for (int a = 0; a < 2; ++a)
#pragma unroll
            for (int b = 0; b < 2; ++b)
#pragma unroll
                for (int m = 0; m < 4; ++m)
#pragma unroll
                    for (int n = 0; n < 2; ++n) acc[a][b][m][n] = (f32x4){0.f, 0.f, 0.f, 0.f};
        cur = nxt; cA = nA; cB = nB; ++ui;
        if constexpr (ALIGN_EPI) { if (wr == 1) PG8_BAR; }
    }
    PG8_WAIT_V(0);
    if constexpr (!ALIGN_EPI) { if (wr == 0) PG8_BAR; }
    PG8_BAR;
#undef PG8_SA
#undef PG8_SB
#undef PG8_STAGE
#undef PG8_LDA
#undef PG8_LDB
#undef PG8_MMA
#undef PG8_WAIT_V
#undef PG8_WAIT_L
#undef PG8_BAR
#undef PG8_SCHED
}
}
constexpr int D_MODEL = 4096, BATCH = 4, SEQ = 4096, M_TOK = BATCH * SEQ, N_MEM = 256, M_MEM = BATCH * N_MEM;
constexpr int A_IN = 6720, A_LDP = 6912, B_IN = 9216;
constexpr int A_OFF_CQ = 0, A_OFF_CKV = 1024, A_OFF_KR = 1536, A_OFF_XQ = 1600, A_OFF_Z = 2624;
constexpr int B_OFF_Q = 0, B_OFF_K = 3072, B_OFF_V = 3584, B_OFF_XQ = 4096, B_OFF_Z = 5120;
constexpr int QW = 4608, KVW = 6144;
constexpr float LOG2E = 1.4426950408889634f;
constexpr float C2_MLA = 0.07216878364870322f * LOG2E;
constexpr float C2_SWA = 0.125f * LOG2E;
constexpr float C2_MEM = 0.0625f * LOG2E;
constexpr float EPS = 1e-6f;

namespace pg8 {
__device__ __forceinline__ float silu_f(float z) { return z * __builtin_amdgcn_rcpf(1.0f + __builtin_amdgcn_exp2f(-z * LOG2E)); }
__device__ __forceinline__ void store8(bf16_t* p, f32x4 v0, f32x4 v1) {
    u32x4 w; w.x = cvt_pk_bf16(v0[0], v0[1]); w.y = cvt_pk_bf16(v0[2], v0[3]); w.z = cvt_pk_bf16(v1[0], v1[1]); w.w = cvt_pk_bf16(v1[2], v1[3]); *(u32x4*)p = w;
}
__device__ __forceinline__ void rope8(f32x4& v0, f32x4& v1, const f32x4 cs, const f32x4 sn) {
    float a, b;
    a = v0[0]; b = v0[1]; v0[0] = a * cs[0] - b * sn[0]; v0[1] = b * cs[0] + a * sn[0];
    a = v0[2]; b = v0[3]; v0[2] = a * cs[1] - b * sn[1]; v0[3] = b * cs[1] + a * sn[1];
    a = v1[0]; b = v1[1]; v1[0] = a * cs[2] - b * sn[2]; v1[1] = b * cs[2] + a * sn[2];
    a = v1[2]; b = v1[3]; v1[2] = a * cs[3] - b * sn[3]; v1[3] = b * cs[3] + a * sn[3];
}

__device__ __forceinline__ float rr_slow(const float* p, int n, float inv) { float s = 0.f;
#pragma unroll 1
    for (int i = 0; i < n; ++i) s += p[i];
    return 1.0f / sqrtf(s * inv + EPS); }
struct EpiAin {
    static constexpr bool PERM = true;
    bf16_t* proj;
    bf16_t* mkv;
    const float* cosT; const float* sinT;
    const float* rr;
    const PG8_LAS float* rrl; int pmc;
    float* part;
    __device__ __forceinline__ void operator()(const f32x4 (&acc)[2][2][4][2], const Unit& u, int wr, int wc, int fr, int fq) const {
        if (u.pn >= 27) {
            const int l = (u.pn - 27) >> 3, ct = (u.pn - 27) & 7;
            bf16_t* base = mkv + (size_t)l * M_MEM * 2048;
            int opq = 0; asm volatile("" : "+v"(opq));
            const int row0 = (u.pm - 64) * BM + wr * 64 + fr + opq, col0 = ct * BM + wc * 32 + 8 * fq;
#pragma unroll
            for (int ai = 0; ai < 2; ++ai)
#pragma unroll
                for (int m = 0; m < 4; ++m) { bf16_t* rowp = base + (size_t)(row0 + ai * HALF + m * 16) * 2048 + col0;
#pragma unroll
                    for (int bj = 0; bj < 2; ++bj) store8(rowp + bj * HALF, acc[ai][bj][m][0], acc[ai][bj][m][1]); }
            return;
        }
        int opq = 0; asm volatile("" : "+v"(opq));
        const int lrow0 = wr * 64 + fr + opq, row0 = u.pm * BM + lrow0;
#pragma unroll
        for (int bj = 0; bj < 2; ++bj) {
            const int cw = u.pn * BM + bj * HALF + wc * 32;
            if (cw >= A_IN) continue;
            const int col0 = cw + 8 * fq;
            const int cls = cw < A_OFF_KR ? 0 : (cw < A_OFF_XQ ? 1 : (cw < A_OFF_Z ? 2 : 3));
#pragma unroll
            for (int ai = 0; ai < 2; ++ai)
#pragma unroll
                for (int m = 0; m < 4; ++m) { const int row = row0 + ai * HALF + m * 16; const float r = (u.pm == pmc) ? rrl[lrow0 + ai * HALF + m * 16] : rr[row];
                    f32x4 v0 = acc[ai][bj][m][0] * r, v1 = acc[ai][bj][m][1] * r;
                    if (cls == 0) { float ss = ((v0[0] * v0[0] + v0[1] * v0[1]) + (v0[2] * v0[2] + v0[3] * v0[3])) + ((v1[0] * v1[0] + v1[1] * v1[1]) + (v1[2] * v1[2] + v1[3] * v1[3]));
                        { const int ln = fr + 16 * fq;
                          ss += __builtin_bit_cast(float, __builtin_amdgcn_ds_bpermute((ln ^ 16) << 2, __builtin_bit_cast(int, ss)));
                          ss += __builtin_bit_cast(float, __builtin_amdgcn_ds_bpermute((ln ^ 32) << 2, __builtin_bit_cast(int, ss))); }
                        if (fq == 0) part[(size_t)row * 48 + (cw >> 5)] = ss; }
                    if (cls == 1) { const int i0 = (col0 - A_OFF_KR) >> 1;
                        const f32x4 cs = *(const f32x4*)(cosT + (size_t)row * 32 + i0), sn = *(const f32x4*)(sinT + (size_t)row * 32 + i0);
                        rope8(v0, v1, cs, sn); }
                    else if (cls == 2) { v0 = v0 * C2_MEM; v1 = v1 * C2_MEM; }
                    else if (cls == 3) {
#pragma unroll
                        for (int e = 0; e < 4; ++e) { v0[e] = silu_f(v0[e]); v1[e] = silu_f(v1[e]); } }
                    store8(proj + (size_t)row * A_LDP + col0, v0, v1); }
        }
    }
};
struct EpiBin {
    static constexpr bool PERM = true;
    bf16_t* proj;
    const float* rr; const PG8_LAS float* rrl; int pmc;
    __device__ __forceinline__ void operator()(const f32x4 (&acc)[2][2][4][2], const Unit& u, int wr, int wc, int fr, int fq) const {
        int opq = 0; asm volatile("" : "+v"(opq));
        const int lrow0 = wr * 64 + fr + opq, row0 = u.pm * BM + lrow0, col0 = u.pn * BM + wc * 32 + 8 * fq;
        const int cls = u.pn < 12 ? 0 : (u.pn < 16 ? 1 : (u.pn < 20 ? 2 : 3));
#pragma unroll
        for (int ai = 0; ai < 2; ++ai)
#pragma unroll
            for (int m = 0; m < 4; ++m) { const int row = row0 + ai * HALF + m * 16; bf16_t* rowp = proj + (size_t)row * B_IN + col0;
                const float r = (u.pm == pmc) ? rrl[lrow0 + ai * HALF + m * 16] : rr[row], rs = cls == 0 ? r * C2_SWA : (cls == 2 ? r * C2_MEM : r);
#pragma unroll
                for (int bj = 0; bj < 2; ++bj) { f32x4 v0 = acc[ai][bj][m][0] * rs, v1 = acc[ai][bj][m][1] * rs;
                    if (cls == 3) {
#pragma unroll
                        for (int e = 0; e < 4; ++e) { v0[e] = silu_f(v0[e]); v1[e] = silu_f(v1[e]); } }
                    store8(rowp + bj * HALF, v0, v1); } }
    }
};
struct EpiQ {
    static constexpr bool PERM = true;
    bf16_t* q;
    const float* cosT; const float* sinT;
    const float* part; const PG8_LAS float* rrl; int pmc;
    __device__ __forceinline__ void operator()(const f32x4 (&acc)[2][2][4][2], const Unit& u, int wr, int wc, int fr, int fq) const {
        int opq = 0; asm volatile("" : "+v"(opq));
        const int lrow0 = wr * 64 + fr + opq, row0 = u.pm * BM + lrow0;
#pragma unroll
        for (int bj = 0; bj < 2; ++bj) {
            const int cw = u.pn * BM + bj * HALF + wc * 32, hc = cw % 192;
            const int col0 = cw + 8 * fq;
            const bool rope = hc >= 128;
            const int i0 = (hc - 128 + 8 * fq) >> 1;
#pragma unroll
            for (int ai = 0; ai < 2; ++ai)
#pragma unroll
                for (int m = 0; m < 4; ++m) { const int row = row0 + ai * HALF + m * 16;
                    const float r = C2_MLA * ((u.pm == pmc) ? rrl[lrow0 + ai * HALF + m * 16] : rr_slow(part + (size_t)row * 48, 32, 1.f / 1024.f));
                    f32x4 v0 = acc[ai][bj][m][0] * r, v1 = acc[ai][bj][m][1] * r;
                    if (rope) { const f32x4 cs = *(const f32x4*)(cosT + (size_t)row * 32 + i0), sn = *(const f32x4*)(sinT + (size_t)row * 32 + i0);
                        rope8(v0, v1, cs, sn); }
                    store8(q + (size_t)row * QW + col0, v0, v1); }
        }
    }
};
struct EpiPlain {
    static constexpr bool PERM = true;
    bf16_t* o; int ldc;
    __device__ __forceinline__ void operator()(const f32x4 (&acc)[2][2][4][2], const Unit& u, int wr, int wc, int fr, int fq) const {
        int opq = 0; asm volatile("" : "+v"(opq));
        const int row0 = u.pm * BM + wr * 64 + fr + opq, col0 = u.pn * BM + wc * 32 + 8 * fq;
#pragma unroll
        for (int ai = 0; ai < 2; ++ai)
#pragma unroll
            for (int m = 0; m < 4; ++m) { bf16_t* rowp = o + (size_t)(row0 + ai * HALF + m * 16) * ldc + col0;
#pragma unroll
                for (int bj = 0; bj < 2; ++bj) store8(rowp + bj * HALF, acc[ai][bj][m][0], acc[ai][bj][m][1]); }
    }
};
struct EpiKV {
    static constexpr bool PERM = true;
    bf16_t* o;
    const float* part; const PG8_LAS float* rrl; int pmc;
    __device__ __forceinline__ void operator()(const f32x4 (&acc)[2][2][4][2], const Unit& u, int wr, int wc, int fr, int fq) const {
        int opq = 0; asm volatile("" : "+v"(opq));
        const int lrow0 = wr * 64 + fr + opq, row0 = u.pm * BM + lrow0, col0 = u.pn * BM + wc * 32 + 8 * fq;
#pragma unroll
        for (int ai = 0; ai < 2; ++ai)
#pragma unroll
            for (int m = 0; m < 4; ++m) { const int row = row0 + ai * HALF + m * 16; bf16_t* rowp = o + (size_t)row * KVW + col0;
                const float r = (u.pm == pmc) ? rrl[lrow0 + ai * HALF + m * 16] : rr_slow(part + (size_t)row * 48 + 32, 16, 1.f / 512.f);
#pragma unroll
                for (int bj = 0; bj < 2; ++bj) store8(rowp + bj * HALF, acc[ai][bj][m][0] * r, acc[ai][bj][m][1] * r); }
    }
};
struct SchedKV { StaticOrder o;
    __device__ __forceinline__ bool next(int i, Unit& u) const {
        if (o.G != 256) return o.next(i, u);
        int L; if (i < 5) L = i * 256 + o.c; else if (o.c >= 128 && i < 7) L = 1280 + (i - 5) * 128 + (o.c - 128); else return false;
        o.map(L, u); return true; }
    __device__ __forceinline__ void fix(Unit&) const {} };
struct SchedRange { StaticOrder o; int i0, n;
    __device__ __forceinline__ bool next(int i, Unit& u) const { return i < n && o.next(i0 + i, u); } __device__ __forceinline__ void fix(Unit&) const {} };
struct SchedPlain { StaticOrder o; __device__ __forceinline__ bool next(int i, Unit& u) const { return o.next(i, u); } __device__ __forceinline__ void fix(Unit&) const {} };
struct SchedAin { StaticOrder o; __device__ __forceinline__ bool next(int i, Unit& u) const { return o.next(i, u); }
    __device__ __forceinline__ void fix(Unit& u) const { if (u.pm < 0) { const int e = u.pn, l = e >> 5, r = e & 31; u.pm = 64 + (r >> 3); u.pn = 27 + l * 8 + (r & 7); } } };
}
namespace att {
#define ATT_LAS __attribute__((address_space(3)))
typedef unsigned short bf16_t;
typedef short bf16x8 __attribute__((ext_vector_type(8)));
typedef short s16x4 __attribute__((ext_vector_type(4)));
typedef float f32x16 __attribute__((ext_vector_type(16)));
typedef float f32x4 __attribute__((ext_vector_type(4)));
typedef unsigned u32x4 __attribute__((ext_vector_type(4)));
#define ATT_SBAR() __builtin_amdgcn_sched_barrier(0)
constexpr float THR2 = 8.0f;

template <int DQK> __device__ __forceinline__ int kswz(int row, int chunk) {
    const int sw = (DQK == 256 || DQK == 128) ? (row & 15) : ((row >> 1) & 7);
    return row * (DQK * 2) + ((chunk ^ sw) << 4);
}
template <int DV> __device__ __forceinline__ int v_st(int k, int c) { constexpr int NCB = DV / 32; const int kk = (k & ~0xC) | ((k & 4) << 1) | ((k & 8) >> 1); return ((kk >> 3) * NCB + (c >> 5)) * 512 + ((kk & 7) * 32 + (c & 31)) * 2; }
__device__ __forceinline__ int v_rd_base(int lane) { return ((lane & 3) << 3) | (((lane >> 2) & 3) << 6) | (((lane >> 4) & 1) << 5) | (((lane >> 5) & 1) << 8); }
__device__ __forceinline__ int crow(int r, int hi) { return (r & 3) + 8 * (r >> 2) + 4 * hi; }
__device__ __forceinline__ unsigned cvtpk(float lo, float hi) { return pg8::cvt_pk_bf16(lo, hi); }
__device__ __forceinline__ const char* uptr(const char* p) { const unsigned long long v = (unsigned long long)(uintptr_t)p;
    unsigned lo = __builtin_amdgcn_readfirstlane((unsigned)v), hi = __builtin_amdgcn_readfirstlane((unsigned)(v >> 32)); asm volatile("" : "+s"(lo), "+s"(hi));
    return (const char*)(uintptr_t)(((unsigned long long)hi << 32) | lo); }
__device__ __forceinline__ float bf2f(bf16_t v) { return __uint_as_float(((unsigned)v) << 16); }

__device__ __forceinline__ void softmax_exp(f32x16& p0, f32x16& p1, float& m_reg, float& alpha) {
    float pmax = p0[0];
#pragma unroll
    for (int r = 1; r < 16; ++r) pmax = fmaxf(pmax, p0[r]);
#pragma unroll
    for (int r = 0; r < 16; ++r) pmax = fmaxf(pmax, p1[r]);
    { auto rr = __builtin_amdgcn_permlane32_swap(__float_as_uint(pmax), __float_as_uint(pmax), false, false);
      pmax = fmaxf(__uint_as_float(rr[0]), __uint_as_float(rr[1])); }
    float mn;
    if (__builtin_expect(__all(pmax - m_reg <= THR2), 1)) { mn = m_reg; alpha = 1.f; }
    else { mn = fmaxf(m_reg, pmax); alpha = __builtin_amdgcn_exp2f(m_reg - mn); m_reg = mn; }
#pragma unroll
    for (int r = 0; r < 16; ++r) p0[r] = __builtin_amdgcn_exp2f(p0[r] - mn);
#pragma unroll
    for (int r = 0; r < 16; ++r) p1[r] = __builtin_amdgcn_exp2f(p1[r] - mn);
}
__device__ __forceinline__ void softmax_pack(const f32x16& p0, const f32x16& p1, float alpha, float& l_reg, bf16x8& pa0, bf16x8& pa1, bf16x8& pa2, bf16x8& pa3) {
    float ps = 0.f;
    { float s0 = p0[0] + p0[1], s1 = p0[2] + p0[3], s2 = p1[0] + p1[1], s3 = p1[2] + p1[3];
#pragma unroll
      for (int r = 4; r < 16; r += 4) { s0 += p0[r] + p0[r + 1]; s1 += p0[r + 2] + p0[r + 3]; s2 += p1[r] + p1[r + 1]; s3 += p1[r + 2] + p1[r + 3]; }
      ps = (s0 + s1) + (s2 + s3); }
    { auto rr = __builtin_amdgcn_permlane32_swap(__float_as_uint(ps), __float_as_uint(ps), false, false);
      ps = __uint_as_float(rr[0]) + __uint_as_float(rr[1]); }
    l_reg = l_reg * alpha + ps;
#define ATT_PK4(P, B_, OUT) do { unsigned a0 = cvtpk(P[B_+0], P[B_+1]), a1 = cvtpk(P[B_+2], P[B_+3]);                          \
        unsigned b0 = cvtpk(P[B_+4], P[B_+5]), b1 = cvtpk(P[B_+6], P[B_+7]);                                             \
        auto r0 = __builtin_amdgcn_permlane32_swap(a0, b0, false, false); auto r1 = __builtin_amdgcn_permlane32_swap(a1, b1, false, false); \
        u32x4 w = {r0[0], r1[0], r0[1], r1[1]}; OUT = __builtin_bit_cast(bf16x8, w); } while (0)
    ATT_PK4(p0, 0, pa0); ATT_PK4(p0, 8, pa1); ATT_PK4(p1, 0, pa2); ATT_PK4(p1, 8, pa3);
#undef ATT_PK4
}
template <int DQK, int GD, bool ZERO = true>
__device__ __forceinline__ void qkt(f32x16& p0, f32x16& p1, const ATT_LAS char* Kb, int r32, int hi, const bf16x8* qr) {
    constexpr int ND = DQK / 16, NG = ND / GD; static_assert(ND % GD == 0, "qkt group size");
    if constexpr (ZERO) { p0 = f32x16{}; p1 = f32x16{}; }
    const ATT_LAS char* kb[4];
#pragma unroll
    for (int dd = 0; dd < 4; ++dd) kb[dd] = Kb + kswz<DQK>(r32, dd * 2 + hi);
    bf16x8 fa[2][GD], fb[2][GD];
#define ATT_KLD(G_, B_) do { _Pragma("unroll") for (int i_ = 0; i_ < GD; ++i_) { const int d0_ = (G_) * GD + i_; \
        const ATT_LAS char* a_ = (DQK >= 128) ? (const ATT_LAS char*)(((unsigned)(uintptr_t)kb[d0_ & 3] ^ (unsigned)(((d0_ >> 2) & 1) << 7))) + (d0_ >> 3) * 256 : kb[d0_ & 3] + (d0_ >> 2) * 128;     \
        fa[B_][i_] = *(const ATT_LAS bf16x8*)(a_); fb[B_][i_] = *(const ATT_LAS bf16x8*)(a_ + 32 * DQK * 2); } } while (0)
    ATT_KLD(0, 0);
#pragma unroll
    for (int g = 0; g < NG; ++g) {
        if (g + 1 < NG) { if ((g & 1) == 0) ATT_KLD(g + 1, 1); else ATT_KLD(g + 1, 0); }
        ATT_SBAR();
#pragma unroll
        for (int i = 0; i < GD; ++i) {
            p0 = __builtin_amdgcn_mfma_f32_32x32x16_bf16(fa[g & 1][i], qr[g * GD + i], p0, 0, 0, 0);
            p1 = __builtin_amdgcn_mfma_f32_32x32x16_bf16(fb[g & 1][i], qr[g * GD + i], p1, 0, 0, 0); }
        ATT_SBAR();
    }
#undef ATT_KLD
}
template <int DV, int VOFF>
__device__ __forceinline__ void pv_tile(f32x16* o, int vb0, bf16x8 pa0, bf16x8 pa1, bf16x8 pa2, bf16x8 pa3) {
    constexpr int NCB = DV / 32, KS = NCB * 1024, HF = NCB * 512;
#define ATT_TRRD(dst, off) asm volatile("ds_read_b64_tr_b16 %0, %1 offset:%2" : "=&v"(dst) : "v"(vb0), "i"(off) : "memory")
#define ATT_VLD(B_, D_) do { constexpr int b_ = VOFF + (D_) * 512; \
        ATT_TRRD(vl[B_][0], b_); ATT_TRRD(vh[B_][0], b_ + HF); ATT_TRRD(vl[B_][1], b_ + KS); ATT_TRRD(vh[B_][1], b_ + KS + HF); \
        ATT_TRRD(vl[B_][2], b_ + 2 * KS); ATT_TRRD(vh[B_][2], b_ + 2 * KS + HF); ATT_TRRD(vl[B_][3], b_ + 3 * KS); ATT_TRRD(vh[B_][3], b_ + 3 * KS + HF); } while (0)
#define ATT_VFR(B_, k_) (bf16x8){vl[B_][k_][0], vl[B_][k_][1], vl[B_][k_][2], vl[B_][k_][3], vh[B_][k_][0], vh[B_][k_][1], vh[B_][k_][2], vh[B_][k_][3]}
#define ATT_PVD(B_, D_) do { o[D_] = __builtin_amdgcn_mfma_f32_32x32x16_bf16(pa0, ATT_VFR(B_, 0), o[D_], 0, 0, 0); o[D_] = __builtin_amdgcn_mfma_f32_32x32x16_bf16(pa1, ATT_VFR(B_, 1), o[D_], 0, 0, 0); \
        o[D_] = __builtin_amdgcn_mfma_f32_32x32x16_bf16(pa2, ATT_VFR(B_, 2), o[D_], 0, 0, 0); o[D_] = __builtin_amdgcn_mfma_f32_32x32x16_bf16(pa3, ATT_VFR(B_, 3), o[D_], 0, 0, 0); } while (0)
    s16x4 vl[2][4], vh[2][4];
    ATT_VLD(0, 0);
    if constexpr (NCB == 2) {
        ATT_VLD(1, 1); asm volatile("s_waitcnt lgkmcnt(8)" ::: "memory"); ATT_SBAR(); ATT_PVD(0, 0);
        asm volatile("s_waitcnt lgkmcnt(0)" ::: "memory"); ATT_SBAR(); ATT_PVD(1, 1);
    } else {
        static_assert(NCB == 4 || NCB == 2, "pv_tile: DV is 64 or 128");
        ATT_VLD(1, 1); asm volatile("s_waitcnt lgkmcnt(8)" ::: "memory"); ATT_SBAR(); ATT_PVD(0, 0); ATT_SBAR();
        ATT_VLD(0, 2); asm volatile("s_waitcnt lgkmcnt(8)" ::: "memory"); ATT_SBAR(); ATT_PVD(1, 1); ATT_SBAR();
        ATT_VLD(1, 3); asm volatile("s_waitcnt lgkmcnt(8)" ::: "memory"); ATT_SBAR(); ATT_PVD(0, 2); ATT_SBAR();
        asm volatile("s_waitcnt lgkmcnt(0)" ::: "memory"); ATT_SBAR(); ATT_PVD(1, 3);
    }
#undef ATT_TRRD
#undef ATT_VLD
#undef ATT_VFR
#undef ATT_PVD
}

template <int DV>
__device__ __forceinline__ void epilogue_rows(const f32x16* o, float l_reg, ATT_LAS float* li_l, ATT_LAS char* stg, const bf16_t* Gw, int ldg, bf16_t* Yw, int ldy, int lane) {
    constexpr int NCB = DV / 32, RS = DV * 2 + 16, CH = DV / 8, RPP = 64 / CH, NP = 32 / RPP;
    const int r32 = lane & 31, hi = lane >> 5;
    if (hi == 0) li_l[r32] = l_reg;
    asm volatile("s_waitcnt lgkmcnt(0)" ::: "memory");
#pragma unroll
    for (int r = 0; r < 16; ++r) { const int orow = crow(r, hi); const float rl = __builtin_amdgcn_rcpf(li_l[orow]);
#pragma unroll
        for (int d0 = 0; d0 < NCB; ++d0) { const unsigned w = cvtpk(o[d0][r] * rl, 0.f); *(ATT_LAS unsigned short*)(stg + orow * RS + (d0 * 32 + r32) * 2) = (unsigned short)w; } }
    asm volatile("s_waitcnt lgkmcnt(0)" ::: "memory");
    int opq = 0; asm volatile("" : "+v"(opq));
#pragma unroll
    for (int i = 0; i < NP; ++i) { const int row = i * RPP + lane / CH + opq, ch = lane % CH;
        const u32x4 ov = *(const ATT_LAS u32x4*)(stg + row * RS + ch * 16);
        const u32x4 gv = *(const u32x4*)(Gw + (size_t)row * ldg + ch * 8);
        u32x4 yv;
#pragma unroll
        for (int e = 0; e < 4; ++e) { const float a0 = __uint_as_float(ov[e] << 16) * __uint_as_float(gv[e] << 16), a1 = __uint_as_float(ov[e] & 0xffff0000u) * __uint_as_float(gv[e] & 0xffff0000u); yv[e] = cvtpk(a0, a1); }
        *(u32x4*)(Yw + (size_t)row * ldy + ch * 8) = yv; }
}

template <int DV>
__device__ __forceinline__ void gate_prefetch(u32x4 (&gv)[32 / (64 / (DV / 8))], const bf16_t* Gw, int ldg, int lane) {
    constexpr int CH = DV / 8, RPP = 64 / CH, NP = 32 / RPP;
#pragma unroll
    for (int i = 0; i < NP; ++i) { const int row = i * RPP + lane / CH, ch = lane % CH; gv[i] = *(const u32x4*)(Gw + (size_t)row * ldg + ch * 8); }
}
template <int DV>
__device__ __forceinline__ void epilogue_rows_pre(const f32x16* o, float l_reg, ATT_LAS float* li_l, ATT_LAS char* stg, const u32x4 (&gv)[32 / (64 / (DV / 8))], bf16_t* Yw, int ldy, int lane) {
    constexpr int NCB = DV / 32, RS = DV * 2 + 16, CH = DV / 8, RPP = 64 / CH, NP = 32 / RPP;
    const int r32 = lane & 31, hi = lane >> 5;
    if (hi == 0) li_l[r32] = l_reg;
    asm volatile("s_waitcnt lgkmcnt(0)" ::: "memory");
#pragma unroll
    for (int r = 0; r < 16; ++r) { const int orow = crow(r, hi); const float rl = __builtin_amdgcn_rcpf(li_l[orow]);
#pragma unroll
        for (int d0 = 0; d0 < NCB; ++d0) { const unsigned w = cvtpk(o[d0][r] * rl, 0.f); *(ATT_LAS unsigned short*)(stg + orow * RS + (d0 * 32 + r32) * 2) = (unsigned short)w; } }
    asm volatile("s_waitcnt lgkmcnt(0)" ::: "memory");
    int opq = 0; asm volatile("" : "+v"(opq));
#pragma unroll
    for (int i = 0; i < NP; ++i) { const int row = i * RPP + lane / CH + opq, ch = lane % CH;
        const u32x4 ov = *(const ATT_LAS u32x4*)(stg + row * RS + ch * 16);
        u32x4 yv;
#pragma unroll
        for (int e = 0; e < 4; ++e) { const float a0 = __uint_as_float(ov[e] << 16) * __uint_as_float(gv[i][e] << 16), a1 = __uint_as_float(ov[e] & 0xffff0000u) * __uint_as_float(gv[i][e] & 0xffff0000u); yv[e] = cvtpk(a0, a1); }
        *(u32x4*)(Yw + (size_t)row * ldy + ch * 8) = yv; }
}

__device__ __forceinline__ void mla_core_dma(ATT_LAS char* lds, const bf16_t* Qw, int ldq, const bf16_t* K0, int ldk0, const bf16_t* K1, int ldk1, const bf16_t* V, int ldv,
        int NT, int qpos0, const bf16_t* Gw, int ldg, bf16_t* Yw, int ldy, int tid_in) {
    constexpr int DQK = 192, DV = 128, NCB = 4, VBY = 16384, KBY = 24576, K_OFF = 2 * VBY, WS_OFF = K_OFF + 2 * KBY, ROPE = 16384;
    int tid_ = tid_in; asm volatile("" : "+v"(tid_));
    const int tid = tid_, wid = __builtin_amdgcn_readfirstlane(tid >> 6), lane = tid & 63, r32 = lane & 31, hi = lane >> 5;
    ATT_LAS float* ws = (ATT_LAS float*)(lds + WS_OFF) + wid * 64; ATT_LAS float* li_l = ws; ATT_LAS float* al_l = ws + 32;
    const int vb0 = (int)(unsigned)(uintptr_t)lds + v_rd_base(lane);
    unsigned sn0, sr0, sv0;
    { const int row = 4 * wid + (lane >> 4), cp = lane & 15, ch = cp ^ (row & 15);
      sn0 = (unsigned)(row * ldk0 + ch * 8) * 2u; }
    { const int row = 8 * wid + (lane >> 3), cp = lane & 7, ch = cp ^ ((row >> 1) & 7);
      sr0 = (unsigned)(row * ldk1 + ch * 8) * 2u; }
    { const int st = 2 * wid + (lane >> 5), kkh = st >> 2, cb = st & 3, q = (lane & 31) >> 2, c = cb * 32 + (lane & 3) * 8;
      const int kk = kkh * 8 + q, k = (kk & ~0xC) | ((kk & 4) << 1) | ((kk & 8) >> 1);
      sv0 = (unsigned)(k * ldv + c) * 2u; }
    const size_t stepK0 = (size_t)64 * ldk0 * 2, stepK1 = (size_t)64 * ldk1 * 2, stepV = (size_t)64 * ldv * 2;
    const unsigned ldsw = (unsigned)wid * 1024u;
#define MLA_DMA(BUF, t_) do { const char* kb0_ = uptr((const char*)K0 + (size_t)(t_) * stepK0); const char* kb0b_ = uptr((const char*)K0 + (size_t)(t_) * stepK0 + (size_t)64 * ldk0); \
        const char* kb1_ = uptr((const char*)K1 + (size_t)(t_) * stepK1); const char* vb_ = uptr((const char*)V + (size_t)(t_) * stepV); const char* vbb_ = uptr((const char*)V + (size_t)(t_) * stepV + (size_t)64 * ldv); \
        unsigned sn0_ = sn0, sr0_ = sr0, sv0_ = sv0; asm volatile("" : "+v"(sn0_), "+v"(sr0_), "+v"(sv0_));     \
        __builtin_amdgcn_global_load_lds((const unsigned*)(kb0_ + sn0_), (ATT_LAS unsigned*)(lds + K_OFF + (BUF) * KBY + ldsw), 16, 0, 0); \
        __builtin_amdgcn_global_load_lds((const unsigned*)(kb0b_ + sn0_), (ATT_LAS unsigned*)(lds + K_OFF + (BUF) * KBY + 8192 + ldsw), 16, 0, 0); \
        __builtin_amdgcn_global_load_lds((const unsigned*)(kb1_ + sr0_), (ATT_LAS unsigned*)(lds + K_OFF + (BUF) * KBY + ROPE + ldsw), 16, 0, 0); \
        __builtin_amdgcn_global_load_lds((const unsigned*)(vb_ + sv0_), (ATT_LAS unsigned*)(lds + (BUF) * VBY + ldsw), 16, 0, 0); \
        __builtin_amdgcn_global_load_lds((const unsigned*)(vbb_ + sv0_), (ATT_LAS unsigned*)(lds + (BUF) * VBY + 8192 + ldsw), 16, 0, 0); } while (0)
    MLA_DMA(0, 0);
    bf16x8 qr[DQK / 16];
    { const char* qb_ = uptr((const char*)Qw); unsigned qo_ = (unsigned)(r32 * ldq + hi * 8) * 2u; asm volatile("" : "+v"(qo_));
#pragma unroll
      for (int d0 = 0; d0 < DQK / 16; ++d0) qr[d0] = *(const __attribute__((address_space(1))) bf16x8*)(uintptr_t)(qb_ + qo_ + d0 * 32); }
    float m_reg = -1e30f, l_reg = 0.f; f32x16 o[NCB];
    { float z_ = 0.f; asm volatile("" : "+v"(z_));
#pragma unroll
      for (int d = 0; d < NCB; ++d)
#pragma unroll
          for (int r = 0; r < 16; ++r) o[d][r] = z_; }
    asm volatile("s_waitcnt vmcnt(0)" ::: "memory");
    __syncthreads();
    const int qm = qpos0 + r32 - 4 * hi;
    const int kn0 = r32 * 256 + ((hi ^ (r32 & 15)) << 4), kr0 = ROPE + r32 * 128 + ((hi ^ ((r32 >> 1) & 7)) << 4);
#define MLA_KA(d0) ((d0) < 8 ? (kn0 ^ ((((d0) & 3) << 5) | (((d0) >> 2) << 7))) : (kr0 ^ (((d0) - 8) << 5)))
#define MLA_KH(d0) ((d0) < 8 ? 8192 : 4096)
#define MLA_KLD(G_, B_) do { _Pragma("unroll") for (int i_ = 0; i_ < 4; ++i_) { const int d0_ = (G_) * 4 + i_; \
        fa[B_][i_] = *(const ATT_LAS bf16x8*)(Kb_ + MLA_KA(d0_)); fb[B_][i_] = *(const ATT_LAS bf16x8*)(Kb_ + MLA_KA(d0_) + MLA_KH(d0_)); } } while (0)
#define MLA_QKT(BUF) do { const ATT_LAS char* Kb_ = lds + K_OFF + (BUF) * KBY; bf16x8 fa[2][4], fb[2][4]; p0 = f32x16{}; p1 = f32x16{}; \
        MLA_KLD(0, 0); \
        _Pragma("unroll") for (int g = 0; g < 3; ++g) { \
            if (g + 1 < 3) { if ((g & 1) == 0) MLA_KLD(g + 1, 1); else MLA_KLD(g + 1, 0); } \
            ATT_SBAR(); \
            _Pragma("unroll") for (int i = 0; i < 4; ++i) { p0 = __builtin_amdgcn_mfma_f32_32x32x16_bf16(fa[g & 1][i], qr[g * 4 + i], p0, 0, 0, 0); p1 = __builtin_amdgcn_mfma_f32_32x32x16_bf16(fb[g & 1][i], qr[g * 4 + i], p1, 0, 0, 0); } \
            ATT_SBAR(); } } while (0)
#define MLA_STEP(BF, t) do { \
        const int kb_ = (t) * 64; \
        if ((t) + 1 < NT) MLA_DMA(1 - (BF), (t) + 1); \
        ATT_SBAR(); \
        if (kb_ <= qpos0 + 31) {                                                 \
        f32x16 p0, p1; \
        MLA_QKT(BF); \
        if (kb_ + 63 > qpos0) { const int dq = qm - kb_; const float NEG = -__builtin_inff(); \
            _Pragma("unroll") for (int r = 0; r < 16; ++r) { const int c = (r & 3) + 8 * (r >> 2); if (dq - c < 0) p0[r] = NEG; if (dq - c - 32 < 0) p1[r] = NEG; } } \
        float alpha; softmax_exp(p0, p1, m_reg, alpha); \
        if (__any(alpha < 1.f)) { int l_; asm volatile("v_mbcnt_lo_u32_b32 %0, -1, 0\n\tv_mbcnt_hi_u32_b32 %0, -1, %0" : "=v"(l_));     \
            ATT_LAS float* al2_ = (ATT_LAS float*)(lds + WS_OFF) + wid * 64 + 32; const int hi_ = l_ >> 5; \
            if (hi_ == 0) al2_[l_] = alpha; asm volatile("s_waitcnt lgkmcnt(0)" ::: "memory"); \
            _Pragma("unroll") for (int d_ = 0; d_ < NCB; ++d_) _Pragma("unroll") for (int r = 0; r < 16; ++r) o[d_][r] *= al2_[crow(r, hi_)]; } \
        bf16x8 pa0, pa1, pa2, pa3; softmax_pack(p0, p1, alpha, l_reg, pa0, pa1, pa2, pa3); ATT_SBAR(); \
        pv_tile<DV, (BF) * VBY>(o, vb0, pa0, pa1, pa2, pa3); \
        } \
        asm volatile("s_waitcnt vmcnt(0)" ::: "memory"); \
        __syncthreads(); } while (0)
    for (int t = 0; t < NT; t += 2) { MLA_STEP(0, t); MLA_STEP(1, t + 1); }
#undef MLA_STEP
#undef MLA_QKT
#undef MLA_KLD
#undef MLA_KA
#undef MLA_KH
#undef MLA_DMA
    { int lane2; asm volatile("v_mbcnt_lo_u32_b32 %0, -1, 0\n\tv_mbcnt_hi_u32_b32 %0, -1, %0" : "=v"(lane2));
      epilogue_rows<DV>(o, l_reg, (ATT_LAS float*)(lds + WS_OFF) + wid * 64, lds + wid * (32 * (DV * 2 + 16)), Gw, ldg, Yw, ldy, lane2); }
    __syncthreads();
}

__device__ __forceinline__ void mem_core_dma(ATT_LAS char* lds, const bf16_t* Qw, int ldq, const bf16_t* K0, int ldk0, const bf16_t* V, int ldv,
        const bf16_t* Gw, int ldg, bf16_t* Yw, int ldy, int tid_in) {
    constexpr int DQK = 256, DV = 128, NCB = 4, VBY = 16384, KBY = 32768, K_OFF = 2 * VBY, WS_OFF = K_OFF + 2 * KBY, NT = 4;
    int tid_ = tid_in; asm volatile("" : "+v"(tid_));
    const int tid = tid_, wid = __builtin_amdgcn_readfirstlane(tid >> 6), lane = tid & 63, r32 = lane & 31, hi = lane >> 5;
    ATT_LAS float* ws = (ATT_LAS float*)(lds + WS_OFF) + wid * 64; ATT_LAS float* li_l = ws; ATT_LAS float* al_l = ws + 32;
    const int vb0 = (int)(unsigned)(uintptr_t)lds + v_rd_base(lane);
    const char* sk0; const char* sv0; const char* sv1;
    { const int row = 2 * wid + (lane >> 5), cp = lane & 31, ch = (cp & 16) | ((cp & 15) ^ (row & 15));
      sk0 = (const char*)(K0 + (size_t)row * ldk0 + ch * 8); }
    { const int st = 2 * wid + (lane >> 5), kkh = st >> 2, cb = st & 3, q = (lane & 31) >> 2, c = cb * 32 + (lane & 3) * 8;
      const int kk = kkh * 8 + q, k = (kk & ~0xC) | ((kk & 4) << 1) | ((kk & 8) >> 1);
      sv0 = (const char*)(V + (size_t)k * ldv + c);
      const int st1 = st + 16, kkh1 = st1 >> 2, kk1 = kkh1 * 8 + q, k1 = (kk1 & ~0xC) | ((kk1 & 4) << 1) | ((kk1 & 8) >> 1);
      sv1 = (const char*)(V + (size_t)k1 * ldv + c); }
    const size_t stepK = (size_t)64 * ldk0 * 2, stepV = (size_t)64 * ldv * 2, rows16 = (size_t)16 * ldk0 * 2;
    const unsigned ldsw = (unsigned)wid * 1024u;
#define MEM_DMA(BUF, t_) do { \
        _Pragma("unroll") for (int i_ = 0; i_ < 4; ++i_) \
            __builtin_amdgcn_global_load_lds((const unsigned*)(sk0 + (size_t)(t_) * stepK + i_ * rows16), (ATT_LAS unsigned*)(lds + K_OFF + (BUF) * KBY + i_ * 8192 + ldsw), 16, 0, 0); \
        __builtin_amdgcn_global_load_lds((const unsigned*)(sv0 + (size_t)(t_) * stepV), (ATT_LAS unsigned*)(lds + (BUF) * VBY + ldsw), 16, 0, 0); \
        __builtin_amdgcn_global_load_lds((const unsigned*)(sv1 + (size_t)(t_) * stepV), (ATT_LAS unsigned*)(lds + (BUF) * VBY + 8192 + ldsw), 16, 0, 0); } while (0)
    MEM_DMA(0, 0);
    bf16x8 qr[DQK / 16];
#pragma unroll
    for (int d0 = 0; d0 < DQK / 16; ++d0) qr[d0] = *(const bf16x8*)(Qw + (size_t)r32 * ldq + d0 * 16 + hi * 8);
    float m_reg = -1e30f, l_reg = 0.f; f32x16 o[NCB];
    { float z_ = 0.f; asm volatile("" : "+v"(z_));
#pragma unroll
      for (int d = 0; d < NCB; ++d)
#pragma unroll
          for (int r = 0; r < 16; ++r) o[d][r] = z_; }
    asm volatile("s_waitcnt vmcnt(0)" ::: "memory");
    __syncthreads();
#define MEM_STEP(BF, t) do { \
        if ((t) + 1 < NT) MEM_DMA(1 - (BF), (t) + 1); \
        ATT_SBAR(); \
        f32x16 p0, p1; \
        qkt<DQK, 2>(p0, p1, lds + K_OFF + (BF) * KBY, r32, hi, qr); \
        float alpha; softmax_exp(p0, p1, m_reg, alpha); \
        if (__any(alpha < 1.f)) { if (hi == 0) al_l[r32] = alpha; asm volatile("s_waitcnt lgkmcnt(0)" ::: "memory"); \
            _Pragma("unroll") for (int d_ = 0; d_ < NCB; ++d_) _Pragma("unroll") for (int r = 0; r < 16; ++r) o[d_][r] *= al_l[crow(r, hi)]; } \
        bf16x8 pa0, pa1, pa2, pa3; softmax_pack(p0, p1, alpha, l_reg, pa0, pa1, pa2, pa3); ATT_SBAR(); \
        pv_tile<DV, (BF) * VBY>(o, vb0, pa0, pa1, pa2, pa3); \
        asm volatile("s_waitcnt vmcnt(0)" ::: "memory"); \
        __syncthreads(); } while (0)
    MEM_STEP(0, 0); MEM_STEP(1, 1); MEM_STEP(0, 2); MEM_STEP(1, 3);
#undef MEM_STEP
#undef MEM_DMA
    epilogue_rows<DV>(o, l_reg, li_l, lds + wid * (32 * (DV * 2 + 16)), Gw, ldg, Yw, ldy, lane);
    __syncthreads();
}

__device__ __forceinline__ void mem_core2(ATT_LAS char* lds, const bf16_t* Qw, int ldq, const bf16_t* K0, int ldk0, const bf16_t* V, int ldv,
        const bf16_t* Gw, int ldg, bf16_t* Yw, int ldy, int tid_in) {
    constexpr int DQK = 256, DV = 128, NCB = 4, VBY = 16384, KBY = 32768, K_OFF = 2 * VBY, WS_OFF = 102400;
    int tid_ = tid_in; asm volatile("" : "+v"(tid_));
    const int tid = tid_, wid = __builtin_amdgcn_readfirstlane(tid >> 6), lane = tid & 63, r32 = lane & 31, hi = lane >> 5;
    ATT_LAS float* ws = (ATT_LAS float*)(lds + WS_OFF) + wid * 160; ATT_LAS float* li_l = ws; ATT_LAS float* al_l = ws + 32;
    const int vb0 = (int)(unsigned)(uintptr_t)lds + v_rd_base(lane);
    const char* sk0; const char* sv0; const char* sv1;
    { const int row = 2 * wid + (lane >> 5), cp = lane & 31, ch = (cp & 16) | ((cp & 15) ^ (row & 15));
      sk0 = (const char*)(K0 + (size_t)row * ldk0 + ch * 8); }
    { const int st = 2 * wid + (lane >> 5), kkh = st >> 2, cb = st & 3, q = (lane & 31) >> 2, c = cb * 32 + (lane & 3) * 8;
      const int kk = kkh * 8 + q, k = (kk & ~0xC) | ((kk & 4) << 1) | ((kk & 8) >> 1);
      sv0 = (const char*)(V + (size_t)k * ldv + c);
      const int st1 = st + 16, kkh1 = st1 >> 2, kk1 = kkh1 * 8 + q, k1 = (kk1 & ~0xC) | ((kk1 & 4) << 1) | ((kk1 & 8) >> 1);
      sv1 = (const char*)(V + (size_t)k1 * ldv + c); }
    const size_t stepK = (size_t)64 * ldk0 * 2, stepV = (size_t)64 * ldv * 2, rows16 = (size_t)16 * ldk0 * 2;
    const unsigned ldsw = (unsigned)wid * 1024u;
#define MEM_DMAK(BUF, t_) do { _Pragma("unroll") for (int i_ = 0; i_ < 4; ++i_) \
            __builtin_amdgcn_global_load_lds((const unsigned*)(sk0 + (size_t)(t_) * stepK + i_ * rows16), (ATT_LAS unsigned*)(lds + K_OFF + (BUF) * KBY + i_ * 8192 + ldsw), 16, 0, 0); } while (0)
#define MEM_DMAV(BUF, i_) do { \
        __builtin_amdgcn_global_load_lds((const unsigned*)(sv0 + (size_t)((i_) & 3) * stepV + ((i_) >> 2) * 256), (ATT_LAS unsigned*)(lds + (BUF) * VBY + ldsw), 16, 0, 0); \
        __builtin_amdgcn_global_load_lds((const unsigned*)(sv1 + (size_t)((i_) & 3) * stepV + ((i_) >> 2) * 256), (ATT_LAS unsigned*)(lds + (BUF) * VBY + 8192 + ldsw), 16, 0, 0); } while (0)
    MEM_DMAK(0, 0);
    bf16x8 qr[DQK / 16];
#pragma unroll
    for (int d0 = 0; d0 < DQK / 16; ++d0) qr[d0] = *(const bf16x8*)(Qw + (size_t)r32 * ldq + d0 * 16 + hi * 8);
    float m_reg = -1e30f, l_reg = 0.f;
    asm volatile("s_waitcnt vmcnt(0)" ::: "memory");
    __syncthreads();
    bf16x8 P0[4], P1[4], P2[4], P3[4]; bool fl1 = false, fl2 = false, fl3 = false;
#define MEM_QK(BF, t, PP, FL) do { \
        if ((t) + 1 < 4) MEM_DMAK(1 - (BF), (t) + 1); \
        if ((t) == 2) MEM_DMAV(0, 0); \
        if ((t) == 3) MEM_DMAV(1, 1); \
        ATT_SBAR(); \
        f32x16 p0, p1; \
        qkt<DQK, 2>(p0, p1, lds + K_OFF + (BF) * KBY, r32, hi, qr); \
        float alpha; softmax_exp(p0, p1, m_reg, alpha); \
        FL = __any(alpha < 1.f); \
        if (hi == 0) al_l[(t) * 32 + r32] = alpha; \
        softmax_pack(p0, p1, alpha, l_reg, PP[0], PP[1], PP[2], PP[3]); ATT_SBAR(); \
        asm volatile("s_waitcnt vmcnt(0) lgkmcnt(0)" ::: "memory"); \
        __syncthreads(); } while (0)
    { bool fl0; MEM_QK(0, 0, P0, fl0); (void)fl0; } MEM_QK(1, 1, P1, fl1); MEM_QK(0, 2, P2, fl2); MEM_QK(1, 3, P3, fl3);
#undef MEM_QK
#define MEM_PV(i, PP, FL) do { \
        if ((i) >= 1 && (i) + 1 < 8) MEM_DMAV(((i) + 1) & 1, (i) + 1); \
        if (((i) & 3) == 1) { asm volatile("" ::: "memory"); ATT_SBAR(); gate_prefetch<DV>(gv, Gw + ((i) >> 2) * 128, ldg, lane); }     \
        ATT_SBAR(); \
        if (((i) & 3) != 0 && (FL)) { _Pragma("unroll") for (int d_ = 0; d_ < NCB; ++d_) _Pragma("unroll") for (int r = 0; r < 16; ++r) o[d_][r] *= al_l[((i) & 3) * 32 + crow(r, hi)]; } \
        pv_tile<DV, ((i) & 1) * VBY>(o, vb0, PP[0], PP[1], PP[2], PP[3]); \
        if (((i) & 3) == 3) epilogue_rows_pre<DV>(o, l_reg, li_l, lds + K_OFF + wid * (32 * (DV * 2 + 16)), gv, Yw + ((i) >> 2) * 128, ldy, lane); \
        if (((i) & 3) == 1) asm volatile("s_waitcnt vmcnt(8)" ::: "memory");          \
        else asm volatile("s_waitcnt vmcnt(0)" ::: "memory"); \
        __builtin_amdgcn_s_barrier(); } while (0)
#pragma unroll
    for (int h = 0; h < 2; ++h) {
        f32x16 o[NCB]; u32x4 gv[8];
        { float z_ = 0.f; asm volatile("" : "+v"(z_));
#pragma unroll
          for (int d = 0; d < NCB; ++d)
#pragma unroll
              for (int r = 0; r < 16; ++r) o[d][r] = z_; }
        if (h == 0) { MEM_PV(0, P0, false); MEM_PV(1, P1, fl1); MEM_PV(2, P2, fl2); MEM_PV(3, P3, fl3); }
        else        { MEM_PV(4, P0, false); MEM_PV(5, P1, fl1); MEM_PV(6, P2, fl2); MEM_PV(7, P3, fl3); }
    }
#undef MEM_PV
#undef MEM_DMAK
#undef MEM_DMAV
}

struct SwaUnit { int b, kvh, qb; };
__device__ __forceinline__ SwaUnit swa_decode(int U) { SwaUnit u; u.qb = U & 31; u.kvh = (U >> 5) & 7; u.b = U >> 8; return u; }
struct SwaPre { bf16x8 k[4], v[4]; };
constexpr int SWA_TN = 320, SWA_TOFF = 96;
constexpr int SWA_V = 0, SWA_K = 32768, SWA_WS = 65536, SWA_BIAS = 65536 + 2048, SWA_STG = 83968, SWA_NU = 1024;
__device__ __forceinline__ void swa_prefetch(SwaPre& P, const SwaUnit& u, const bf16_t* proj, int tid) {
    const int j_lo = (2 * u.qb - 2) > 0 ? (2 * u.qb - 2) : 0, NT = 2 * u.qb + 2 - j_lo;
    const size_t kr0 = (size_t)u.b * SEQ + j_lo * 64 + (tid >> 3);
    const bf16_t* kp = proj + kr0 * B_IN + B_OFF_K + u.kvh * 64 + (tid & 7) * 8;
    const bf16_t* vp = proj + kr0 * B_IN + B_OFF_V + u.kvh * 64 + (tid & 7) * 8;
#pragma unroll
    for (int tt = 0; tt < 4; ++tt) if (tt < NT) { P.k[tt] = *(const bf16x8*)(kp + (size_t)tt * 64 * B_IN); P.v[tt] = *(const bf16x8*)(vp + (size_t)tt * 64 * B_IN); }
}
__device__ __forceinline__ void swa_bias_dma(ATT_LAS char* lds, int tb, const SwaUnit& u, const float* ebias, int wid, int lane) {
    __builtin_amdgcn_global_load_lds((const unsigned*)((const char*)(ebias + (size_t)u.kvh * 6 * SWA_TN) + (wid * 64 + lane) * 16), (ATT_LAS unsigned*)(lds + SWA_BIAS + tb * 8192 + wid * 1024), 16, 0, 0);
}
__device__ __forceinline__ void swa_prefetch_q(bf16x8 (&q)[4], const SwaUnit& u, int pass, const bf16_t* proj, int wid, int r32, int hi) {
    const int head = u.kvh * 6 + pass * 2 + (wid >> 2), pos0 = u.qb * 128 + (wid & 3) * 32;
    const bf16_t* qp = proj + ((size_t)u.b * SEQ + pos0 + r32) * B_IN + B_OFF_Q + head * 64 + hi * 8;
#pragma unroll
    for (int d0 = 0; d0 < 4; ++d0) q[d0] = *(const bf16x8*)(qp + d0 * 16);
}
__device__ __forceinline__ void swa_phase(ATT_LAS char* lds, const bf16_t* proj, bf16_t* Y, const float* ebias, const float* sinks  , int vcu, int G, int tid_in) {
    int tid_ = tid_in; asm volatile("" : "+v"(tid_));
    const int tid = tid_, wid = __builtin_amdgcn_readfirstlane(tid >> 6), lane = tid & 63, r32 = lane & 31, hi = lane >> 5;
    ATT_LAS float* ws = (ATT_LAS float*)(lds + SWA_WS) + wid * 64; ATT_LAS float* li_l = ws; ATT_LAS float* al_l = ws + 32;
    const int vb0 = (int)(unsigned)(uintptr_t)lds + SWA_V + v_rd_base(lane);
    constexpr int NU = SWA_NU;
    int U = vcu; if (U >= NU) return;
    SwaPre P; bf16x8 qn[4]; SwaUnit u = swa_decode(U); int tb = 0;
    swa_bias_dma(lds, 0, u, ebias, wid, lane);
    swa_prefetch(P, u, proj, tid);
    swa_prefetch_q(qn, u, 0, proj, wid, r32, hi);
#pragma unroll 1
    for (;;) {
        const int j_lo = (2 * u.qb - 2) > 0 ? (2 * u.qb - 2) : 0, NT = 2 * u.qb + 2 - j_lo, kbase = j_lo * 64;
        { const int rr = tid >> 3, rc = (tid & 7) * 8;
#pragma unroll
          for (int tt = 0; tt < 4; ++tt) if (tt < NT) { *(ATT_LAS bf16x8*)(lds + SWA_V + tt * 8192 + v_st<64>(rr, rc)) = P.v[tt]; *(ATT_LAS bf16x8*)(lds + SWA_K + tt * 8192 + kswz<64>(rr, tid & 7)) = P.k[tt]; }
        }
        asm volatile("s_waitcnt vmcnt(0)" ::: "memory");
        __syncthreads();
        const int Un = U + G; const bool more = Un < NU; SwaUnit un = u;
        if (more) { un = swa_decode(Un); swa_prefetch(P, un, proj, tid); }
        ATT_SBAR();
#pragma unroll 1
        for (int pass = 0; pass < 3; ++pass) {
            bf16x8 qr[4];
#pragma unroll
            for (int d0 = 0; d0 < 4; ++d0) qr[d0] = qn[d0];
            if (pass < 2) swa_prefetch_q(qn, u, pass + 1, proj, wid, r32, hi); else if (more) swa_prefetch_q(qn, un, 0, proj, wid, r32, hi);
            ATT_SBAR();
            const int hsel = pass * 2 + (wid >> 2), head = u.kvh * 6 + hsel, pos0 = u.qb * 128 + (wid & 3) * 32;
            const ATT_LAS float* biasS = (const ATT_LAS float*)(lds + SWA_BIAS + tb * 8192) + hsel * SWA_TN;
            float m_reg = sinks[head] * LOG2E, l_reg = 1.f; f32x16 o[2]; o[0] = f32x16{}; o[1] = f32x16{};
            const int qm = pos0 + r32 - 4 * hi;
            u32x4 gv[4]; gate_prefetch<64>(gv, proj + ((size_t)u.b * SEQ + pos0) * B_IN + B_OFF_Z + head * 64, B_IN, lane);
#pragma unroll 1
            for (int tt = 0; tt < NT; ++tt) {
                const int kb_ = kbase + tt * 64;
                if (!(kb_ <= pos0 + 31 && kb_ + 63 >= pos0 - 127)) continue;
                f32x16 p0, p1;
                { const ATT_LAS float* bp = biasS + (qm - kb_ + SWA_TOFF - 59);
#pragma unroll
                  for (int r = 0; r < 16; ++r) { const int c = (r & 3) + 8 * (r >> 2); p0[r] = bp[59 - c]; p1[r] = bp[59 - c - 32]; } }
                qkt<64, 4, false>(p0, p1, lds + SWA_K + tt * 8192, r32, hi, qr);
                float alpha; softmax_exp(p0, p1, m_reg, alpha);
                if (__any(alpha < 1.f)) { if (hi == 0) al_l[r32] = alpha; asm volatile("s_waitcnt lgkmcnt(0)" ::: "memory");
#pragma unroll
                    for (int d_ = 0; d_ < 2; ++d_)
#pragma unroll
                        for (int r = 0; r < 16; ++r) o[d_][r] *= al_l[crow(r, hi)]; }
                bf16x8 pa0, pa1, pa2, pa3; softmax_pack(p0, p1, alpha, l_reg, pa0, pa1, pa2, pa3); ATT_SBAR();
                pv_tile<64, 0>(o, vb0 + tt * 8192, pa0, pa1, pa2, pa3);
            }
            { const size_t rows0 = (size_t)u.b * SEQ + pos0;
              epilogue_rows_pre<64>(o, l_reg, li_l, lds + SWA_STG + wid * (32 * 144), gv, Y + rows0 * D_MODEL + head * 64, D_MODEL, lane); }
        }
        if (!more) break;
        swa_bias_dma(lds, 1 - tb, un, ebias, wid, lane);
        U = Un; u = un; tb = 1 - tb;
        __syncthreads();
    }
    __syncthreads();
}
}
constexpr int NWAVES = 8;
constexpr size_t MiB = 1u << 20;
constexpr size_t WS_CTL = 0, CTL_ZERO_BYTES = 1 * MiB;
constexpr size_t WS_COS = 1 * MiB, WS_SIN = 3 * MiB, WS_BIAS = 5 * MiB;
constexpr size_t WS_RR = 6 * MiB;
constexpr size_t WS_MKV = 8 * MiB;
constexpr size_t WS_WIN = 16 * MiB;
constexpr size_t WS_WQB = 102 * MiB;
constexpr size_t WS_WKVB = 111 * MiB;
constexpr size_t WS_WOUT = 117 * MiB;
constexpr size_t WS_HB = 150 * MiB;
constexpr size_t WS_PROJ = 286 * MiB;
constexpr size_t WS_Q = 574 * MiB;
constexpr size_t WS_HI = 718 * MiB;
constexpr size_t WS_LO = 854 * MiB;
constexpr size_t WS_WOUT2 = 982 * MiB;
constexpr size_t WS_PART = 1014 * MiB;
constexpr size_t WS_END = 1018 * MiB;
constexpr int CW_BAR = 4096;
constexpr int RING_BYTES = 131072, LDSCTL_OFF = RING_BYTES, MISC_OFF = LDSCTL_OFF + 320, LDS_BYTES = 147456;
constexpr int RRL_OFF = RING_BYTES + 2048;

#define GAS __attribute__((address_space(1)))
#define LAS __attribute__((address_space(3)))
typedef unsigned short bf16;
typedef unsigned v4u __attribute__((ext_vector_type(4)));
typedef float f32x4 __attribute__((ext_vector_type(4)));
typedef GAS unsigned gu32;
#define RLX_AGENT __ATOMIC_RELAXED, __HIP_MEMORY_SCOPE_AGENT
#define LDS_WAIT() asm volatile("s_waitcnt lgkmcnt(0)" ::: "memory")
#define VM_WAIT() asm volatile("s_waitcnt vmcnt(0)" ::: "memory")
__device__ __forceinline__ unsigned f2bf(float f) { unsigned u = __builtin_bit_cast(unsigned, f); return (u + 0x7fffu + ((u >> 16) & 1u)) >> 16; }
__device__ __forceinline__ unsigned pk2(float lo, float hi) { return f2bf(lo) | (f2bf(hi) << 16); }

#define XB_TMO      128
#define XB_XCNT(j)  (256  + 64 * (j))
#define XB_XSUB(j)  (1280 + 64 * (j))
#define XB_XGEN(j)  (2304 + 64 * (j))
#define XB_TOP      3328
#define XB_TOPGEN   3392
#define XCD_BAR_WORDS 3456
#define XB_SPIN_CAP (1u << 21)

__device__ __forceinline__ unsigned xb_ld(unsigned* p)              { return __hip_atomic_load(p, __ATOMIC_RELAXED, __HIP_MEMORY_SCOPE_AGENT); }
__device__ __forceinline__ unsigned xb_add(unsigned* p, unsigned v) { return __hip_atomic_fetch_add(p, v, __ATOMIC_RELAXED, __HIP_MEMORY_SCOPE_AGENT); }
__device__ __forceinline__ unsigned xb_xcc_id() { return (unsigned)__builtin_amdgcn_s_getreg((3 << 11) | 20) & 0xFu; }
#define XB_SPIN(cond, bar) do { unsigned _sp = 0; while (cond) { __builtin_amdgcn_s_sleep(1); \
    if ((++_sp & 255u) == 0u) { if (xb_ld(&(bar)[XB_TMO])) break; if (_sp > XB_SPIN_CAP) { atomicAdd(&(bar)[XB_TMO], 1u); break; } } } } while (0)

__device__ __forceinline__ int fresh_tid(int wave) { int l; asm volatile("v_mbcnt_lo_u32_b32 %0, -1, 0\n\tv_mbcnt_hi_u32_b32 %0, -1, %0" : "=v"(l)); return wave * 64 + l; }
struct XcdBarrier {
    unsigned* bar; unsigned x;
    volatile LAS unsigned* st;
};
__device__ __forceinline__ XcdBarrier xcd_barrier_post(unsigned* bar, volatile LAS unsigned* st) {
    XcdBarrier b; b.bar = bar; b.x = xb_xcc_id(); b.st = st;
    if (threadIdx.x == 0) (void)xb_add(&bar[XB_XCNT(b.x)], 1u);
    return b;
}
__device__ __forceinline__ void xcd_barrier_complete(unsigned* bar, unsigned x, unsigned& nloc, unsigned& nx) {
    const unsigned G = gridDim.x * gridDim.y * gridDim.z;
    unsigned sum, cnt, mine, sp = 0u;
    for (;;) {
        sum = 0u; cnt = 0u; mine = 0u;
#pragma unroll
        for (unsigned j = 0; j < 16; ++j) { const unsigned c = xb_ld(&bar[XB_XCNT(j)]); sum += c; cnt += (c > 0u) ? 1u : 0u; mine = (j == x) ? c : mine; }
        if (sum == G) break;
        __builtin_amdgcn_s_sleep(1);
        if ((++sp & 255u) == 0u) { if (xb_ld(&bar[XB_TMO])) break; if (sp > XB_SPIN_CAP) { atomicAdd(&bar[XB_TMO], 1u); break; } }
    }
    nloc = mine > 0u ? mine : 1u; nx = cnt > 0u ? cnt : 1u;
}
__device__ __forceinline__ void xcd_barrier(const XcdBarrier& b, int wave) {
    asm volatile("s_waitcnt vmcnt(0)" ::: "memory");
    __syncthreads();
    if (fresh_tid(wave) == 0) {
        unsigned* bar = b.bar;
        __builtin_amdgcn_s_waitcnt(0);
        unsigned nloc = b.st[0], nx = b.st[1];
        if (nloc == 0u) { xcd_barrier_complete(bar, b.x, nloc, nx); b.st[0] = nloc; b.st[1] = nx; }
        const unsigned old = xb_add(&bar[XB_XSUB(b.x)], 1u);
        const unsigned gen = old / nloc;
        if (old + 1u == (gen + 1u) * nloc) {
            __builtin_amdgcn_fence(__ATOMIC_RELEASE, "agent");
            asm volatile("s_waitcnt vmcnt(0)" ::: "memory");
            const unsigned og = xb_add(&bar[XB_TOP], 1u);
            const unsigned tg = og / nx;
            if (og + 1u == (tg + 1u) * nx) xb_add(&bar[XB_TOPGEN], 1u);
            else XB_SPIN(xb_ld(&bar[XB_TOPGEN]) == tg, bar);
            __builtin_amdgcn_fence(__ATOMIC_ACQUIRE, "agent");
            xb_add(&bar[XB_XGEN(b.x)], 1u);
            asm volatile("s_waitcnt vmcnt(0)" ::: "memory");
        } else {
            XB_SPIN(xb_ld(&bar[XB_XGEN(b.x)]) == gen, bar);
            __builtin_amdgcn_fence(__ATOMIC_ACQUIRE, "agent");
            asm volatile("s_waitcnt vmcnt(0)" ::: "memory");
        }
    }
    __syncthreads();
}

__device__ __forceinline__ float shx(float v, int lane, int o) { return __builtin_bit_cast(float, __builtin_amdgcn_ds_bpermute((lane ^ o) << 2, __builtin_bit_cast(int, v))); }
__device__ __forceinline__ float wave_sum(float v, int lane) {
#pragma unroll
    for (int o = 1; o < 64; o <<= 1) v += shx(v, lane, o);
    return v;
}
__device__ const unsigned char T5B[128] = {0, 1, 2, 3, 4, 5, 6, 7, 8, 9, 10, 11, 12, 13, 14, 15, 16, 16, 16, 17, 17, 18, 18, 18, 19, 19, 19, 20, 20, 20, 20, 21, 21, 21, 21, 22, 22, 22, 22, 22, 23, 23, 23, 23, 23, 23, 24, 24, 24, 24, 24, 24, 25, 25, 25, 25, 25, 25, 25, 26, 26, 26, 26, 26, 26, 26, 26, 27, 27, 27, 27, 27, 27, 27, 27, 27, 27, 28, 28, 28, 28, 28, 28, 28, 28, 28, 28, 29, 29, 29, 29, 29, 29, 29, 29, 29, 29, 29, 29, 30, 30, 30, 30, 30, 30, 30, 30, 30, 30, 30, 30, 30, 30, 31, 31, 31, 31, 31, 31, 31, 31, 31, 31, 31, 31, 31, 31, 31};

__device__ const float INVF[32] = {1.000000000e+00f, 7.498942614e-01f, 5.623413324e-01f, 4.216965139e-01f, 3.162277639e-01f, 2.371373773e-01f, 1.778279394e-01f, 1.333521307e-01f, 1.000000015e-01f, 7.498941571e-02f, 5.623413250e-02f, 4.216965288e-02f, 3.162277490e-02f, 2.371373773e-02f, 1.778279431e-02f, 1.333521493e-02f, 9.999999776e-03f, 7.498941850e-03f, 5.623413250e-03f, 4.216964822e-03f, 3.162277630e-03f, 2.371373586e-03f, 1.778279431e-03f, 1.333521446e-03f, 1.000000047e-03f, 7.498942432e-04f, 5.623413017e-04f, 4.216965172e-04f, 3.162277571e-04f, 2.371373703e-04f, 1.778279402e-04f, 1.333521504e-04f};
__device__ __forceinline__ int permrope(int i) { return i < 32 ? 2 * i : 2 * (i - 32) + 1; }
struct TrItem { const float* W; const float* gain; bf16* WT; int K, N, row_off, map, item; };
__device__ __forceinline__ void tr_load(const TrItem& d, f32x4 (&v)[16], float (&g)[16], int lane) {
    const int nblk = d.N / 64, kb = d.item / nblk, nb = d.item - kb * nblk, k0 = 64 * kb, n0 = 64 * nb, lr = lane >> 4, lc = (lane & 15) * 4;
#pragma unroll
    for (int i = 0; i < 16; ++i) v[i] = __builtin_nontemporal_load((const GAS f32x4*)(d.W + (size_t)(k0 + 4 * i + lr) * d.N + n0 + lc));
#pragma unroll
    for (int i = 0; i < 16; ++i) g[i] = d.gain ? d.gain[k0 + 4 * i + lr] : 1.0f;
}
__device__ __forceinline__ void tr_finish(const TrItem& d, const f32x4 (&v)[16], const float (&g)[16], LAS float* scr_f, int lane) {
    constexpr int ROWB = 144;
    LAS unsigned char* scr = (LAS unsigned char*)scr_f;
    const int nblk = d.N / 64, kb = d.item / nblk, nb = d.item - kb * nblk, k0 = 64 * kb, n0 = 64 * nb, lr = lane >> 4, lc = (lane & 15) * 4;
#pragma unroll
    for (int i = 0; i < 16; ++i) { const f32x4 w = v[i] * g[i];
        *(LAS unsigned long long*)(scr + (4 * i + lr) * ROWB + lc * 2) = (unsigned long long)pk2(w.x, w.y) | ((unsigned long long)pk2(w.z, w.w) << 32); }
    LDS_WAIT(); asm volatile("" ::: "memory");
    const int gq = lane >> 4, i16 = lane & 15, q = (lane >> 2) & 3, p = lane & 3;
    const int rbase = (int)(unsigned)(uintptr_t)scr + (8 * gq + q) * ROWB + 8 * p;
    typedef short s16x4 __attribute__((ext_vector_type(4)));
#pragma unroll
    for (int nb16 = 0; nb16 < 4; ++nb16)
#pragma unroll
        for (int ph = 0; ph < 2; ++ph) { s16x4 lo, hi;
            asm volatile("ds_read_b64_tr_b16 %0, %1 offset:%2" : "=&v"(lo) : "v"(rbase), "i"(ph * 32 * ROWB + nb16 * 32) : "memory");
            asm volatile("ds_read_b64_tr_b16 %0, %1 offset:%2" : "=&v"(hi) : "v"(rbase), "i"(ph * 32 * ROWB + nb16 * 32 + 4 * ROWB) : "memory");
            asm volatile("s_waitcnt lgkmcnt(0)" ::: "memory");
            int dn = n0 + 16 * nb16 + i16;
            if (d.map == 1) { if (dn >= A_OFF_KR && dn < A_OFF_XQ) dn = A_OFF_KR + permrope(dn - A_OFF_KR); }
            if (d.map == 2) { const int hc = dn % 192; if (hc >= 128) dn = dn - hc + 128 + permrope(hc - 128); }
            v4u o; o.x = (unsigned)(unsigned short)lo[0] | ((unsigned)(unsigned short)lo[1] << 16); o.y = (unsigned)(unsigned short)lo[2] | ((unsigned)(unsigned short)lo[3] << 16);
            o.z = (unsigned)(unsigned short)hi[0] | ((unsigned)(unsigned short)hi[1] << 16); o.w = (unsigned)(unsigned short)hi[2] | ((unsigned)(unsigned short)hi[3] << 16);
            *(GAS v4u*)(d.WT + (size_t)(d.row_off + dn) * d.K + k0 + 8 * (4 * ph + gq)) = o; }
    asm volatile("s_waitcnt lgkmcnt(0)" ::: "memory");
}
#define CONV_RUN(NITEMS_, DEC) do { f32x4 va_[16], vb_[16]; float ga_[16], gb_[16]; TrItem da_, db_; int it_ = gw; \
        if (it_ < (NITEMS_)) { DEC(da_, it_); tr_load(da_, va_, ga_, lane); \
            for (;;) { { const int nx_ = (it_ + NGW < (NITEMS_)) ? it_ + NGW : it_; DEC(db_, nx_); tr_load(db_, vb_, gb_, lane); }     \
                       tr_finish(da_, va_, ga_, scr, lane); it_ += NGW; if (it_ >= (NITEMS_)) break; \
                       { const int nx_ = (it_ + NGW < (NITEMS_)) ? it_ + NGW : it_; DEC(da_, nx_); tr_load(da_, va_, ga_, lane); } \
                       tr_finish(db_, vb_, gb_, scr, lane); it_ += NGW; if (it_ >= (NITEMS_)) break; } } } while (0)
__device__ __forceinline__ void rms_row_bf16(const float* xrow, const bf16* drow, float* xout, bf16* orow, int lane) {
    const GAS f32x4* xr = (const GAS f32x4*)xrow + lane;
    f32x4 v[16]; float s = 0.f;
#pragma unroll
    for (int j = 0; j < 16; ++j) v[j] = xr[64 * j];
    if (drow) { const GAS unsigned long long* dr = (const GAS unsigned long long*)drow + lane;
#pragma unroll
        for (int j = 0; j < 16; ++j) { const unsigned long long d = dr[64 * j]; const unsigned lo = (unsigned)d, hi = (unsigned)(d >> 32);
            v[j].x += __uint_as_float(lo << 16); v[j].y += __uint_as_float(lo & 0xffff0000u); v[j].z += __uint_as_float(hi << 16); v[j].w += __uint_as_float(hi & 0xffff0000u); } }
    if (xout) { GAS f32x4* xo = (GAS f32x4*)xout + lane;
#pragma unroll
        for (int j = 0; j < 16; ++j) xo[64 * j] = v[j]; }
#pragma unroll
    for (int j = 0; j < 16; ++j) s += (v[j].x * v[j].x + v[j].y * v[j].y) + (v[j].z * v[j].z + v[j].w * v[j].w);
    const float r = 1.0f / sqrtf(wave_sum(s, lane) * (1.f / D_MODEL) + EPS);
    GAS unsigned long long* o8 = (GAS unsigned long long*)orow + lane;
#pragma unroll
    for (int j = 0; j < 16; ++j) o8[64 * j] = (unsigned long long)pk2(v[j].x * r, v[j].y * r) | ((unsigned long long)pk2(v[j].z * r, v[j].w * r) << 32);
}
typedef unsigned v2u __attribute__((ext_vector_type(2)));
typedef unsigned char u8;
__device__ __forceinline__ float bf_lo(unsigned u) { return __uint_as_float(u << 16); }
__device__ __forceinline__ float bf_hi(unsigned u) { return __uint_as_float(u & 0xffff0000u); }
__device__ __forceinline__ unsigned lo_ebits(float hif) { const unsigned e = __float_as_uint(hif) & 0x7f800000u; return e > (16u << 23) ? e : (16u << 23); }
__device__ __forceinline__ float lo_dec(unsigned q, float hif) { return ((float)q - 128.f) * __uint_as_float(lo_ebits(hif) - (15u << 23)); }
__device__ __forceinline__ unsigned lo_enc(float x, float hif) { const float r = (x - hif) * __uint_as_float((269u << 23) - lo_ebits(hif)) + 128.5f;
    return (unsigned)fminf(fmaxf(r, 1.f), 255.f); }
__device__ __forceinline__ void split2(float a, float b, unsigned& h, unsigned& la, unsigned& lb) {
    const unsigned ha = f2bf(a), hb = f2bf(b); h = ha | (hb << 16); la = lo_enc(a, __uint_as_float(ha << 16)); lb = lo_enc(b, __uint_as_float(hb << 16)); }
__device__ __forceinline__ void xrow_first(const float* xrow, bf16* hrow, float* rr, int lane) {
    const GAS f32x4* xr = (const GAS f32x4*)xrow + lane; f32x4 v[16]; float s = 0.f;
#pragma unroll
    for (int j = 0; j < 16; ++j) v[j] = xr[64 * j];
    GAS unsigned long long* o8 = (GAS unsigned long long*)hrow + lane;
#pragma unroll
    for (int j = 0; j < 16; ++j) { s += (v[j].x * v[j].x + v[j].y * v[j].y) + (v[j].z * v[j].z + v[j].w * v[j].w);
        o8[64 * j] = (unsigned long long)pk2(v[j].x, v[j].y) | ((unsigned long long)pk2(v[j].z, v[j].w) << 32); }
    const float r = 1.0f / sqrtf(wave_sum(s, lane) * (1.f / D_MODEL) + EPS);
    if (lane == 0) *(GAS float*)rr = r;
}
__device__ __forceinline__ void xrow_f32(const float* xrow, const bf16* drow, bf16* hrow, u8* lrow, float* rr, int lane) {
    const GAS f32x4* xr = (const GAS f32x4*)xrow + lane; const GAS unsigned long long* dr = (const GAS unsigned long long*)drow + lane;
    f32x4 v[16]; unsigned long long d[16]; float s = 0.f;
#pragma unroll
    for (int j = 0; j < 16; ++j) v[j] = xr[64 * j];
#pragma unroll
    for (int j = 0; j < 16; ++j) d[j] = dr[64 * j];
    GAS unsigned long long* h8 = (GAS unsigned long long*)hrow + lane; GAS unsigned* l4 = (GAS unsigned*)lrow + lane;
#pragma unroll
    for (int j = 0; j < 16; ++j) { const unsigned d0 = (unsigned)d[j], d1 = (unsigned)(d[j] >> 32);
        const float a = v[j].x + bf_lo(d0), b = v[j].y + bf_hi(d0), c = v[j].z + bf_lo(d1), e = v[j].w + bf_hi(d1);
        s += (a * a + b * b) + (c * c + e * e);
        unsigned h0, h1, q0, q1, q2, q3; split2(a, b, h0, q0, q1); split2(c, e, h1, q2, q3);
        h8[64 * j] = (unsigned long long)h0 | ((unsigned long long)h1 << 32); l4[64 * j] = q0 | (q1 << 8) | (q2 << 16) | (q3 << 24); }
    const float r = 1.0f / sqrtf(wave_sum(s, lane) * (1.f / D_MODEL) + EPS);
    if (lane == 0) *(GAS float*)rr = r;
}
__device__ __forceinline__ void xrow_hl(bf16* hrow, u8* lrow, const bf16* drow, float* rr, int lane) {
    GAS v4u* hp = (GAS v4u*)hrow + lane; GAS v2u* lp = (GAS v2u*)lrow + lane; const GAS v4u* dp = (const GAS v4u*)drow + lane;
    v4u h[8], d[8]; v2u l[8]; float s = 0.f;
#pragma unroll
    for (int j = 0; j < 8; ++j) { h[j] = hp[64 * j]; l[j] = lp[64 * j]; d[j] = dp[64 * j]; }
#pragma unroll
    for (int j = 0; j < 8; ++j) { v4u ho; v2u lo = {0u, 0u};
#pragma unroll
        for (int e = 0; e < 4; ++e) { const unsigned lw = l[j][e >> 1]; const int sh = (e & 1) * 16;
            const float h0 = bf_lo(h[j][e]), h1 = bf_hi(h[j][e]);
            const float a = (h0 + lo_dec((lw >> sh) & 255u, h0)) + bf_lo(d[j][e]), b = (h1 + lo_dec((lw >> (sh + 8)) & 255u, h1)) + bf_hi(d[j][e]);
            s += a * a + b * b; unsigned hh, qa, qb; split2(a, b, hh, qa, qb); ho[e] = hh; lo[e >> 1] |= (qa << sh) | (qb << (sh + 8)); }
        hp[64 * j] = ho; lp[64 * j] = lo; }
    const float r = 1.0f / sqrtf(wave_sum(s, lane) * (1.f / D_MODEL) + EPS);
    if (lane == 0) *(GAS float*)rr = r;
}
__device__ __forceinline__ void xrow_final(float* orow, const bf16* hrow, const u8* lrow, const bf16* drow, const float* g, int lane) {
    GAS f32x4* xo = (GAS f32x4*)orow + lane; const GAS f32x4* gr = (const GAS f32x4*)g + lane;
    const GAS unsigned long long* hr = (const GAS unsigned long long*)hrow + lane; const GAS unsigned* lr = (const GAS unsigned*)lrow + lane;
    const GAS unsigned long long* dr = (const GAS unsigned long long*)drow + lane;
    unsigned long long h[16], d[16]; unsigned l[16]; f32x4 v[16]; float s = 0.f;
#pragma unroll
    for (int j = 0; j < 16; ++j) { h[j] = hr[64 * j]; l[j] = lr[64 * j]; d[j] = dr[64 * j]; }
#pragma unroll
    for (int j = 0; j < 16; ++j) { const unsigned h0 = (unsigned)h[j], h1 = (unsigned)(h[j] >> 32), d0 = (unsigned)d[j], d1 = (unsigned)(d[j] >> 32), lw = l[j];
        const float a0 = bf_lo(h0), a1 = bf_hi(h0), a2 = bf_lo(h1), a3 = bf_hi(h1);
        v[j].x = (a0 + lo_dec(lw & 255u, a0)) + bf_lo(d0); v[j].y = (a1 + lo_dec((lw >> 8) & 255u, a1)) + bf_hi(d0);
        v[j].z = (a2 + lo_dec((lw >> 16) & 255u, a2)) + bf_lo(d1); v[j].w = (a3 + lo_dec(lw >> 24, a3)) + bf_hi(d1);
        s += (v[j].x * v[j].x + v[j].y * v[j].y) + (v[j].z * v[j].z + v[j].w * v[j].w); }
    const float r = 1.0f / sqrtf(wave_sum(s, lane) * (1.f / D_MODEL) + EPS);
#pragma unroll
    for (int j = 0; j < 16; ++j) { const f32x4 gg = gr[64 * j]; xo[64 * j] = (v[j] * r) * gg; }
}
__device__ __forceinline__ float sumsq8(v4u a) {
    float s = 0.f;
#pragma unroll
    for (int i = 0; i < 4; ++i) { const float lo = __uint_as_float(a[i] << 16), hi = __uint_as_float(a[i] & 0xffff0000u); s += lo * lo + hi * hi; }
    return s;
}
__device__ __forceinline__ v4u scale8(v4u a, float r) {
    v4u o;
#pragma unroll
    for (int i = 0; i < 4; ++i) { const float lo = __uint_as_float(a[i] << 16), hi = __uint_as_float(a[i] & 0xffff0000u); o[i] = pk2(lo * r, hi * r); }
    return o;
}
__device__ __forceinline__ void cnorm_row(bf16* prow, int lane) {
    GAS v4u* p = (GAS v4u*)prow + lane;
    const v4u a = p[0], b = p[64], c = p[128];
    const float sq = wave_sum(sumsq8(a) + sumsq8(b), lane), sk = wave_sum(sumsq8(c), lane);
    const float rq = 1.0f / sqrtf(sq * (1.f / 1024.f) + EPS), rk = 1.0f / sqrtf(sk * (1.f / 512.f) + EPS);
    p[0] = scale8(a, rq); p[64] = scale8(b, rq); p[128] = scale8(c, rk);
}

#define SETI(d, W_, g_, WT_, K_, N_, ro_, map_, it_) do { d.W = (W_); d.gain = (g_); d.WT = (WT_); d.K = (K_); d.N = (N_); d.row_off = (ro_); d.map = (map_); d.item = (it_); } while (0)
#define DEC_A(d, it) do { int r_ = (it); \
        if (r_ < CA_IN) { SETI(d, a_w_in + (size_t)cj_ * D_MODEL * A_IN, norm_g + (2 * cj_) * D_MODEL, W_IN, D_MODEL, A_IN, 0, 1, r_); } \
        else if (r_ < CA_IN + CA_MKV) { SETI(d, w_mem_kv + (size_t)(2 * cj_) * D_MODEL * 2048, mem_norm_g + (2 * cj_) * D_MODEL, W_IN, D_MODEL, 2048, A_LDP, 0, r_ - CA_IN); } \
        else if (r_ < CA_IN + 2 * CA_MKV) { SETI(d, w_mem_kv + (size_t)(2 * cj_ + 1) * D_MODEL * 2048, mem_norm_g + (2 * cj_ + 1) * D_MODEL, W_IN, D_MODEL, 2048, A_LDP + 2048, 0, r_ - CA_IN - CA_MKV); } \
        else if (r_ < CA_IN + 2 * CA_MKV + CA_QB) { SETI(d, a_w_qb + (size_t)cj_ * 1024 * QW, a_q_g + cj_ * 1024, W_QB, 1024, QW, 0, 2, r_ - CA_IN - 2 * CA_MKV); } \
        else if (r_ < CA_IN + 2 * CA_MKV + CA_QB + CA_KVB) { SETI(d, a_w_kvb + (size_t)cj_ * 512 * KVW, a_kv_g + cj_ * 512, W_KVB, 512, KVW, 0, 0, r_ - CA_IN - 2 * CA_MKV - CA_QB); } \
        else { SETI(d, w_out + (size_t)(2 * cj_) * D_MODEL * D_MODEL, (const float*)nullptr, (bf16*)(ws + WS_WOUT), D_MODEL, D_MODEL, 0, 0, r_ - CA_IN - 2 * CA_MKV - CA_QB - CA_KVB); } } while (0)
#define CONV_A(jj) do { constexpr int CA_IN = 64 * (A_IN / 64), CA_MKV = 64 * 32, CA_QB = 16 * (QW / 64), CA_KVB = 8 * (KVW / 64), CA_OUT = 64 * 64; \
        constexpr int NITEMS = CA_IN + 2 * CA_MKV + CA_QB + CA_KVB + CA_OUT; const int cj_ = (jj); \
        CONV_RUN(NITEMS, DEC_A); } while (0)
#define DEC_B(d, it) do { const int r_ = (it); \
        if (r_ < CB_IN) { SETI(d, b_w_in + (size_t)cj_ * D_MODEL * B_IN, norm_g + (2 * cj_ + 1) * D_MODEL, W_IN, D_MODEL, B_IN, 0, 0, r_); } \
        else { SETI(d, w_out + (size_t)(2 * cj_ + 1) * D_MODEL * D_MODEL, (const float*)nullptr, (bf16*)(ws + WS_WOUT2), D_MODEL, D_MODEL, 0, 0, r_ - CB_IN); } } while (0)
#define CONV_B(jj) do { constexpr int CB_IN = 64 * (B_IN / 64), CB_OUT = 64 * 64, NITEMS = CB_IN + CB_OUT; const int cj_ = (jj); \
        CONV_RUN(NITEMS, DEC_B); } while (0)

struct Args { const float* in[16]; float* out; unsigned char* ws; int ph_lo, ph_hi; };

__global__ void __launch_bounds__(NWAVES * 64, 2) fwd_kernel(Args args) {
    extern __shared__ __attribute__((aligned(16))) unsigned char lds_raw[];
    LAS unsigned char* lds = (LAS unsigned char*)lds_raw;
    volatile LAS unsigned* MISC = (volatile LAS unsigned*)(lds + MISC_OFF);
    const int wave_k = __builtin_amdgcn_readfirstlane(threadIdx.x >> 6);
    const int G = gridDim.x, bx = blockIdx.x, vcu = (G % 8 == 0) ? (bx % 8) * (G / 8) + bx / 8 : bx;
#define PH_PTRS \
    const int tid = fresh_tid(wave_k), lane = tid & 63, wave = wave_k; \
    const int gw = vcu * NWAVES + wave, NGW = G * NWAVES; LAS float* scr = (LAS float*)(lds + wave * 16384); (void)lane; (void)gw; (void)NGW; (void)scr; \
    const __attribute__((address_space(4))) Args* ap_ = (const __attribute__((address_space(4))) Args*)__builtin_amdgcn_kernarg_segment_ptr(); asm volatile("" : "+s"(ap_)); \
    unsigned char* ws = ap_->ws; float* out = ap_->out; \
    const float* x_in = ap_->in[0]; const float* mem_in = ap_->in[1]; const int* pos_in = (const int*)ap_->in[2]; \
    const float* norm_g = ap_->in[3]; const float* mem_norm_g = ap_->in[4]; const float* final_g = ap_->in[5]; \
    const float* w_mem_kv = ap_->in[6]; const float* w_out = ap_->in[7]; const float* a_w_in = ap_->in[8]; \
    const float* a_q_g = ap_->in[9]; const float* a_kv_g = ap_->in[10]; const float* a_w_qb = ap_->in[11]; const float* a_w_kvb = ap_->in[12]; \
    const float* b_w_in = ap_->in[13]; const float* b_sinks = ap_->in[14]; const float* rel_bias = ap_->in[15]; \
    float* cosT = (float*)(ws + WS_COS); float* sinT = (float*)(ws + WS_SIN); float* bias2 = (float*)(ws + WS_BIAS); \
    bf16* MKV = (bf16*)(ws + WS_MKV); bf16* W_IN = (bf16*)(ws + WS_WIN); bf16* W_QB = (bf16*)(ws + WS_WQB); bf16* W_KVB = (bf16*)(ws + WS_WKVB); bf16* W_OUT = (bf16*)(ws + WS_WOUT); \
    float* PART = (float*)(ws + WS_PART); bf16* HI = (bf16*)(ws + WS_HI); u8* LO = (u8*)(ws + WS_LO); float* RR = (float*)(ws + WS_RR); bf16* Y = (bf16*)(ws + WS_HB); bf16* PROJ = (bf16*)(ws + WS_PROJ); bf16* QB = (bf16*)(ws + WS_Q); bf16* KVB = (bf16*)out; \
    (void)out; (void)x_in; (void)mem_in; (void)pos_in; (void)norm_g; (void)mem_norm_g; (void)final_g; (void)w_mem_kv; (void)w_out; (void)a_w_in; (void)a_q_g; (void)a_kv_g; (void)a_w_qb; (void)a_w_kvb; \
    (void)b_w_in; (void)b_sinks; (void)rel_bias; (void)cosT; (void)sinT; (void)bias2; (void)MKV; (void)W_IN; (void)W_QB; (void)W_KVB; (void)W_OUT; (void)PART; (void)HI; (void)LO; (void)RR; (void)Y; (void)PROJ; (void)QB; (void)KVB;
    unsigned* ctl = (unsigned*)(args.ws + WS_CTL);

    for (int u = threadIdx.x; u < (LDS_BYTES - LDSCTL_OFF) / 4; u += NWAVES * 64) ((LAS unsigned*)(lds + LDSCTL_OFF))[u] = 0u;
    __syncthreads();
    XcdBarrier bar = xcd_barrier_post(ctl + CW_BAR, MISC + 8);
    const int lo = args.ph_lo, hi = args.ph_hi;
    int pc = 0;
#define PH_RUN() (pc >= lo && pc < hi)
#define PH_END() do { if (pc >= lo && pc + 1 < hi) xcd_barrier(bar, wave_k); ++pc; } while (0)

#pragma unroll 1
    for (int j = 0; j < 2; ++j) {
        const int la = 2 * j, lb = 2 * j + 1;
        if (PH_RUN()) { PH_PTRS
            if (j == 0) CONV_A(0);
            const bf16* DL = (const bf16*)(ws + WS_Q);
            if (j == 0) { for (int m = gw; m < M_TOK; m += NGW) xrow_first(x_in + (size_t)m * D_MODEL, HI + (size_t)m * D_MODEL, RR + m, lane); }
            else { for (int m = gw; m < M_TOK; m += NGW) xrow_hl(HI + (size_t)m * D_MODEL, LO + (size_t)m * D_MODEL, DL + (size_t)m * D_MODEL, RR + m, lane); }
            if (j == 0) {
                for (int m = gw; m < M_MEM; m += NGW) rms_row_bf16(mem_in + (size_t)m * D_MODEL, nullptr, nullptr, HI + (size_t)(M_TOK + m) * D_MODEL, lane);
                for (int e = (vcu * NWAVES * 64) + tid; e < M_TOK * 32; e += G * NWAVES * 64) {
                    const int tok = e >> 5, i = e & 31;
                    const float inv = INVF[i];
                    const float ang = (float)pos_in[tok] * inv;
                    const double rev = (double)ang * 0.15915494309189535; const double fr = rev - rint(rev);
                    const float rad = (float)(fr * 6.283185307179586);
                    cosT[e] = cosf(rad); sinT[e] = sinf(rad);
                }
                for (int e = (vcu * NWAVES * 64) + tid; e < 49 * 320; e += G * NWAVES * 64) { const int h = e / 320, d = e - h * 320 - 96;
                    bias2[e] = (h < 48 && (unsigned)d < 128u) ? rel_bias[(int)T5B[d] * 48 + h] * LOG2E : -__builtin_inff(); }
            }
        }
        PH_END();
        if (PH_RUN()) { PH_PTRS
            pg8::Gemm g{HI, W_IN, D_MODEL, D_MODEL, D_MODEL}; pg8::SchedAin S; S.o.init(64, 27, 64, G, bx);
            pg8::Unit u0; u0.pm = 0; u0.pn = 0; (void)S.o.next(0, u0);
            LAS float* rrl = (LAS float*)(lds + RRL_OFF); if (tid < 256) rrl[tid] = RR[u0.pm * 256 + tid]; __syncthreads();
            pg8::EpiAin E{PROJ, MKV, cosT, sinT, RR, rrl, u0.pm, PART};
            pg8::gemm_phase<pg8::EpiAin, pg8::SchedAin, true, true>(lds, g, S, E, tid);
        }
        PH_END();
        if (PH_RUN()) { PH_PTRS
            pg8::Unit u0; u0.pm = 0; u0.pn = 0; { pg8::StaticOrder o; o.init(64, QW / 256, 0, G, bx); (void)o.next(0, u0); }
            LAS float* rrq = (LAS float*)(lds + RRL_OFF); LAS float* rrk = rrq + 256;
            { const int r = tid >> 1, hs = tid & 1; const GAS f32x4* p4 = (const GAS f32x4*)(PART + (size_t)(u0.pm * 256 + r) * 48);
              float sq = 0.f, sk = 0.f;
#pragma unroll
              for (int i = 0; i < 4; ++i) { const f32x4 a = p4[hs * 4 + i]; sq += (a.x + a.y) + (a.z + a.w); }
#pragma unroll
              for (int i = 0; i < 2; ++i) { const f32x4 a = p4[8 + hs * 2 + i]; sk += (a.x + a.y) + (a.z + a.w); }
              sq += shx(sq, lane, 1); sk += shx(sk, lane, 1);
              if (hs == 0) { rrq[r] = 1.0f / sqrtf(sq * (1.f / 1024.f) + EPS); rrk[r] = 1.0f / sqrtf(sk * (1.f / 512.f) + EPS); }
              __syncthreads(); }
            { pg8::Gemm g{PROJ + A_OFF_CQ, W_QB, A_LDP, 1024, 1024}; pg8::SchedPlain S; S.o.init(64, QW / 256, 0, G, bx);
              pg8::EpiQ E{QB, cosT, sinT, PART, rrq, u0.pm}; pg8::gemm_phase<pg8::EpiQ, pg8::SchedPlain, true, true>(lds, g, S, E, tid); }
            { pg8::Gemm g{PROJ + A_OFF_CKV, W_KVB, A_LDP, 512, 512}; pg8::SchedKV S; S.o.init(64, KVW / 256, 0, G, bx);
              pg8::EpiKV E{KVB, PART, rrk, u0.pm}; pg8::gemm_phase<pg8::EpiKV, pg8::SchedKV, true, true>(lds, g, S, E, tid); }
        }
        PH_END();
        if (PH_RUN()) { PH_PTRS
#pragma unroll 1
            for (int P = vcu; P < 768; P += G) {
                const int bh = P >> 3, xq = P & 7, b = bh / 24, h = bh % 24;
#pragma unroll 1
                for (int pass = 0; pass < 2; ++pass) {
                    const int qb = pass ? 15 - xq : xq; const size_t rows0 = (size_t)b * SEQ + qb * 256 + wave * 32, kr0 = (size_t)b * SEQ;
                    att::mla_core_dma((LAS char*)lds, QB + rows0 * QW + h * 192, QW, KVB + kr0 * KVW + h * 256, KVW, PROJ + kr0 * A_LDP + A_OFF_KR, A_LDP,
                                  KVB + kr0 * KVW + h * 256 + 128, KVW, 4 * (qb + 1), qb * 256 + wave * 32,
                                  PROJ + rows0 * A_LDP + A_OFF_Z + h * 128, A_LDP, Y + rows0 * D_MODEL + h * 128, D_MODEL, fresh_tid(wave_k));
                }
            }
#pragma unroll 1
            for (int U = vcu; U < 256; U += G) {
                const int qb = U & 15, xh = (U >> 4) & 3, b = U >> 6; const size_t rows0 = (size_t)b * SEQ + qb * 256 + wave * 32;
                const bf16* mk = MKV + (size_t)(b * N_MEM) * 2048; const int yc = 3072 + xh * 256;
                att::mem_core2((LAS char*)lds, PROJ + rows0 * A_LDP + A_OFF_XQ + xh * 256, A_LDP, mk + xh * 256, 2048, mk + 1024 + xh * 256, 2048,
                                  PROJ + rows0 * A_LDP + A_OFF_Z + yc, A_LDP, Y + rows0 * D_MODEL + yc, D_MODEL, fresh_tid(wave_k));
            }
        }
        PH_END();
        if (PH_RUN()) { PH_PTRS
            pg8::Gemm g{Y, (bf16*)(ws + WS_WOUT), D_MODEL, D_MODEL, D_MODEL};
            pg8::EpiPlain E{(bf16*)(ws + WS_Q), D_MODEL};
            const int nb = (bx & 7) & 3;
            { pg8::SchedRange S; S.o.init(64, 16, 0, G, bx); S.i0 = 0; S.n = nb; pg8::gemm_phase<pg8::EpiPlain, pg8::SchedRange, true, true>(lds, g, S, E, tid); }
            CONV_B(j); __syncthreads();
            { pg8::SchedRange S; S.o.init(64, 16, 0, G, bx); S.i0 = nb; S.n = 1 << 30; pg8::gemm_phase<pg8::EpiPlain, pg8::SchedRange, true, true>(lds, g, S, E, tid); }
        }
        PH_END();
        if (PH_RUN()) { PH_PTRS
            { const bf16* DL = (const bf16*)(ws + WS_Q);
              if (j == 0) { for (int m = gw; m < M_TOK; m += NGW) xrow_f32(x_in + (size_t)m * D_MODEL, DL + (size_t)m * D_MODEL, HI + (size_t)m * D_MODEL, LO + (size_t)m * D_MODEL, RR + m, lane); }
              else { for (int m = gw; m < M_TOK; m += NGW) xrow_hl(HI + (size_t)m * D_MODEL, LO + (size_t)m * D_MODEL, DL + (size_t)m * D_MODEL, RR + m, lane); } }
        }
        PH_END();
        if (PH_RUN()) { PH_PTRS
            pg8::Gemm g{HI, W_IN, D_MODEL, D_MODEL, D_MODEL}; pg8::SchedPlain S; S.o.init(64, B_IN / 256, 0, G, bx);
            pg8::Unit u0; u0.pm = 0; u0.pn = 0; (void)S.o.next(0, u0);
            LAS float* rrl = (LAS float*)(lds + RRL_OFF); if (tid < 256) rrl[tid] = RR[u0.pm * 256 + tid]; __syncthreads();
            pg8::EpiBin E{PROJ, RR, rrl, u0.pm};
            pg8::gemm_phase<pg8::EpiBin, pg8::SchedPlain, true, true>(lds, g, S, E, tid);
        }
        PH_END();
        if (PH_RUN()) { PH_PTRS
            { att::swa_phase((LAS char*)lds, PROJ, Y, bias2, b_sinks + j * 48, vcu, G, tid); }
#pragma unroll 1
            for (int U = vcu; U < 256; U += G) {
                const int qb = U & 15, xh = (U >> 4) & 3, b = U >> 6; const size_t rows0 = (size_t)b * SEQ + qb * 256 + wave * 32;
                const bf16* mk = MKV + (size_t)M_MEM * 2048 + (size_t)(b * N_MEM) * 2048; const int yc = 3072 + xh * 256;
                att::mem_core2((LAS char*)lds, PROJ + rows0 * B_IN + B_OFF_XQ + xh * 256, B_IN, mk + xh * 256, 2048, mk + 1024 + xh * 256, 2048,
                                  PROJ + rows0 * B_IN + B_OFF_Z + yc, B_IN, Y + rows0 * D_MODEL + yc, D_MODEL, fresh_tid(wave_k));
            }
        }
        PH_END();
        if (PH_RUN()) { PH_PTRS
            pg8::Gemm g{Y, (bf16*)(ws + WS_WOUT2), D_MODEL, D_MODEL, D_MODEL};
            pg8::EpiPlain E{(bf16*)(ws + WS_Q), D_MODEL};
            const int nb = (bx & 7) & 3;
            { pg8::SchedRange S; S.o.init(64, 16, 0, G, bx); S.i0 = 0; S.n = nb; pg8::gemm_phase<pg8::EpiPlain, pg8::SchedRange, true, true>(lds, g, S, E, tid); }
            if (j == 0) CONV_A(1);
            __syncthreads();
            { pg8::SchedRange S; S.o.init(64, 16, 0, G, bx); S.i0 = nb; S.n = 1 << 30; pg8::gemm_phase<pg8::EpiPlain, pg8::SchedRange, true, true>(lds, g, S, E, tid); }
        }
        PH_END();
    }
    if (PH_RUN()) { PH_PTRS for (int m = gw; m < M_TOK; m += NGW) xrow_final(out + (size_t)m * D_MODEL, HI + (size_t)m * D_MODEL, LO + (size_t)m * D_MODEL, (const bf16*)(ws + WS_Q) + (size_t)m * D_MODEL, final_g, lane); }
#undef PH_RUN
#undef PH_END
}

constexpr int N_PHASES = 19;
extern "C" void kernel_launch(void* const* d_in, const int* in_sizes, int n_in, void* d_out, int out_size, void* d_ws, size_t ws_size, hipStream_t stream) {
    static int grid = 0;
    if (grid == 0) {
        if (n_in != 16 || in_sizes[0] != M_TOK * D_MODEL || out_size != M_TOK * D_MODEL || ws_size < WS_END) {
            fprintf(stderr, "kernel_launch: unexpected shapes (n_in %d, in0 %d, out %d, ws %zu)\n", n_in, n_in > 0 ? in_sizes[0] : -1, out_size, ws_size); grid = -1; return; }
        int dev = 0, cus = 0, per_cu = 0;
        if (hipGetDevice(&dev) != hipSuccess || hipDeviceGetAttribute(&cus, hipDeviceAttributeMultiprocessorCount, dev) != hipSuccess) { grid = -1; return; }
        if (hipFuncSetAttribute((const void*)fwd_kernel, hipFuncAttributeMaxDynamicSharedMemorySize, LDS_BYTES) != hipSuccess) { fprintf(stderr, "kernel_launch: hipFuncSetAttribute failed\n"); grid = -1; return; }
        if (hipOccupancyMaxActiveBlocksPerMultiprocessor(&per_cu, (const void*)fwd_kernel, NWAVES * 64, LDS_BYTES) != hipSuccess || per_cu < 1)
            fprintf(stderr, "kernel_launch: note: occupancy query reports %d workgroups per CU\n", per_cu);
        (void)hipGetLastError();
        grid = cus;
    }
    if (grid < 0) return;
    if (hipMemsetAsync((char*)d_ws + WS_CTL, 0, CTL_ZERO_BYTES, stream) != hipSuccess) return;
    Args a{};
    for (int i = 0; i < 16; ++i) a.in[i] = (const float*)d_in[i];
    a.out = (float*)d_out; a.ws = (unsigned char*)d_ws;
#if defined(MK_PER_PHASE)
    for (int p = 0; p < N_PHASES; ++p) { a.ph_lo = p; a.ph_hi = p + 1; hipLaunchKernelGGL(fwd_kernel, dim3(grid), dim3(NWAVES * 64), LDS_BYTES, stream, a); }
#else
    a.ph_lo = 0; a.ph_hi = N_PHASES;
    hipLaunchKernelGGL(fwd_kernel, dim3(grid), dim3(NWAVES * 64), LDS_BYTES, stream, a);
#endif
    const hipError_t le = hipPeekAtLastError();
    if (le != hipSuccess) fprintf(stderr, "kernel_launch: launch failed: %s\n", hipGetErrorName(le));
}
```

```cpp
#include <hip/hip_runtime.h>
#include <cstdio>
#include <cstdint>
#include <cmath>
namespace pg8 {
#define PG8_LAS __attribute__((address_space(3)))
typedef unsigned short bf16_t;
typedef short bf16x8 __attribute__((ext_vector_type(8)));
typedef float f32x4 __attribute__((ext_vector_type(4)));
typedef unsigned u32x4 __attribute__((ext_vector_type(4)));
constexpr int BM = 256, BK = 64, HALF = 128, HTB = HALF * BK * 2  , STAGE_BYTES = 8 * HTB, NXCD = 8, WGM = 8;

__host__ __device__ __forceinline__ int lds_byte(int r, int c) { const int st = (r >> 4) * 2 + (c >> 5), rr = r & 15, cc = c & 31, ob = rr * 64 + cc * 2; return st * 1024 + (ob ^ (((ob >> 9) & 1) << 5)); }
__host__ __device__ __forceinline__ void stage_rc(int b, int& R, int& C) { const int st = b / 1024, sb = b % 1024, swz = sb ^ (((sb >> 9) & 1) << 5); R = (st >> 1) * 16 + swz / 64; C = (st & 1) * 32 + (swz % 64) / 2; }
__host__ __device__ __forceinline__ int perm32(int rho) { const int n = rho >> 4, i = rho & 15; return 8 * (i >> 2) + 4 * n + (i & 3); }

struct Unit { int pm, pn; };
struct Gemm { const bf16_t* A; const bf16_t* Bt; int lda, ldb, K; };

struct StaticOrder {
    int nM, nN, nwg, nX, G, c;
    __host__ __device__ void init(int nM_, int nN_, int nX_, int G_, int c_) { nM = nM_; nN = nN_; nwg = nM * nN; nX = nX_; G = G_; c = c_; }
    __host__ __device__ __forceinline__ bool next(int i, Unit& u) const {
        const long L = (long)i * G + c; if (L >= nwg + nX) return false;
        if (L >= nwg) { u.pm = -1; u.pn = (int)(L - nwg); return true; }
        map((int)L, u); return true;
    }
    __host__ __device__ __forceinline__ void map(int L, Unit& u) const {
        int wgid = L; { const int q = nwg / NXCD, r = nwg % NXCD, xcd = wgid % NXCD, off = wgid / NXCD; wgid = (xcd < r ? xcd * (q + 1) : r * (q + 1) + (xcd - r) * q) + off; }
        const int nig = WGM * nN, gid = wgid / nig, fm = gid * WGM, gsz = (nM - fm) < WGM ? (nM - fm) : WGM;
        u.pm = fm + ((wgid % nig) % gsz); u.pn = (wgid % nig) / gsz;
    }
};

typedef float f32x2_t __attribute__((ext_vector_type(2))); typedef __bf16 bf16x2_t __attribute__((ext_vector_type(2)));
__device__ __forceinline__ unsigned cvt_pk_bf16(float lo, float hi) { const f32x2_t v = {lo, hi}; const bf16x2_t b = __builtin_convertvector(v, bf16x2_t); return __builtin_bit_cast(unsigned, b); }


template <class Epi, class Sched, bool ALIGN_EPI = false, bool SP2 = false>
__device__ __forceinline__ void gemm_phase(PG8_LAS unsigned char* lds, const Gemm g, const Sched& S, const Epi& E, int tid_in) {
    int tid_ = tid_in; asm volatile("" : "+v"(tid_));
    const int tid = tid_, wid = __builtin_amdgcn_readfirstlane(tid >> 6), lane = tid & 63, wr = wid >> 2, wc = wid & 3, fr = lane & 15, fq = lane >> 4;
    const int K = g.K, nt = K / BK;
    unsigned voffA[2], voffB[2];
#pragma unroll
    for (int i = 0; i < 2; ++i) { int R, C; stage_rc(tid * 16 + i * 8192, R, C); const int Rb = Epi::PERM ? ((R & ~31) + perm32(R & 31)) : R;
        voffA[i] = (unsigned)(R * g.lda + C) * 2u; voffB[i] = (unsigned)(Rb * g.ldb + C) * 2u; }
    const size_t kstep = (size_t)(BK * 2);
    const size_t hstepA = (size_t)HALF * g.lda * 2, hstepB = (size_t)HALF * g.ldb * 2;
    const size_t tstepA = 2 * hstepA, tstepB = 2 * hstepB;
    const unsigned ldsw = (unsigned)wid * 1024u;
    const int aoff = lds_byte(wr * 64 + fr, fq * 8), boff = lds_byte(wc * 32 + fr, fq * 8);
#define PG8_SA(b, h) (((b) * 2 + (h)) * HTB)
#define PG8_SB(b, h) ((4 + (b) * 2 + (h)) * HTB)
#define PG8_STAGE(bufoff, gbase, voff) do { _Pragma("unroll") for (int _i = 0; _i < 2; ++_i) \
        __builtin_amdgcn_global_load_lds((const unsigned*)((const char*)(gbase) + (voff)[_i]), (PG8_LAS unsigned*)(lds + (bufoff) + ldsw + _i * 8192), 16, 0, 0); } while (0)
#define PG8_LDA(dst, b, h) do { _Pragma("unroll") for (int m = 0; m < 4; ++m) _Pragma("unroll") for (int k = 0; k < 2; ++k) dst[m][k] = *(const PG8_LAS bf16x8*)(lds + PG8_SA(b, h) + aoff + m * 2048 + k * 1024); } while (0)
#define PG8_LDB(dst, b, h) do { _Pragma("unroll") for (int n = 0; n < 2; ++n) _Pragma("unroll") for (int k = 0; k < 2; ++k) dst[n][k] = *(const PG8_LAS bf16x8*)(lds + PG8_SB(b, h) + boff + n * 2048 + k * 1024); } while (0)
#define PG8_MMA(ai, bj, At, Bt) do { __builtin_amdgcn_s_setprio(1); _Pragma("unroll") for (int m = 0; m < 4; ++m) _Pragma("unroll") for (int n = 0; n < 2; ++n) _Pragma("unroll") for (int k = 0; k < 2; ++k) \
        acc[ai][bj][m][n] = __builtin_amdgcn_mfma_f32_16x16x32_bf16(Bt[n][k], At[m][k], acc[ai][bj][m][n], 0, 0, 0); __builtin_amdgcn_s_setprio(0); } while (0)
#define PG8_WAIT_V(n) asm volatile("s_waitcnt vmcnt(" #n ")" ::: "memory")
#define PG8_WAIT_L(n) asm volatile("s_waitcnt lgkmcnt(" #n ")" ::: "memory")
#define PG8_BAR __builtin_amdgcn_s_barrier()
#define PG8_SCHED __builtin_amdgcn_sched_barrier(0)
    Unit cur, nxt; int ui = 0;
    if (!S.next(0, cur)) return;
    S.fix(cur);
    f32x4 acc[2][2][4][2];
#pragma unroll
    for (int a = 0; a < 2; ++a)
#pragma unroll
        for (int b = 0; b < 2; ++b)
#pragma unroll
            for (int m = 0; m < 4; ++m)
#pragma unroll
                for (int n = 0; n < 2; ++n) acc[a][b][m][n] = (f32x4){0.f, 0.f, 0.f, 0.f};
    bf16x8 At[4][2], B0[2][2], B1[2][2];
    const char* cA = (const char*)g.A + (size_t)cur.pm * tstepA; const char* cB = (const char*)g.Bt + (size_t)cur.pn * tstepB;
    if constexpr (SP2) {
        PG8_STAGE(PG8_SB(0, 0), cB, voffB); PG8_STAGE(PG8_SB(0, 1), cB + hstepB, voffB); PG8_STAGE(PG8_SA(0, 0), cA, voffA); PG8_STAGE(PG8_SA(0, 1), cA + hstepA, voffA);
        if (wr == 1) PG8_BAR;
        PG8_WAIT_V(2); PG8_BAR;
        PG8_STAGE(PG8_SB(1, 0), cB + kstep, voffB); PG8_STAGE(PG8_SA(1, 0), cA + kstep, voffA); PG8_STAGE(PG8_SB(1, 1), cB + hstepB + kstep, voffB);
        PG8_WAIT_V(6); PG8_BAR;
    } else {
        PG8_STAGE(PG8_SB(0, 0), cB, voffB); PG8_STAGE(PG8_SA(0, 0), cA, voffA); PG8_STAGE(PG8_SB(0, 1), cB + hstepB, voffB); PG8_STAGE(PG8_SA(0, 1), cA + hstepA, voffA);
        if (wr == 1) PG8_BAR;
        PG8_WAIT_V(4); PG8_BAR;
        PG8_STAGE(PG8_SB(1, 0), cB + kstep, voffB); PG8_STAGE(PG8_SA(1, 0), cA + kstep, voffA); PG8_STAGE(PG8_SB(1, 1), cB + hstepB + kstep, voffB);
        PG8_WAIT_V(6); PG8_BAR;
    }
    for (;;) {
        bool has_next = S.next(ui + 1, nxt);
        if (has_next) S.fix(nxt);
        const char* nA = has_next ? (const char*)g.A + (size_t)nxt.pm * tstepA : cA; const char* nB = has_next ? (const char*)g.Bt + (size_t)nxt.pn * tstepB : cB;
        for (int t = 0; t < nt; t += 2) {
            const bool last = (t == nt - 2);
            const char* a1 = cA + (size_t)(t + 1) * kstep;
            const char* a2 = last ? nA : cA + (size_t)(t + 2) * kstep; const char* b2 = last ? nB : cB + (size_t)(t + 2) * kstep;
            const char* a3 = a2 + kstep; const char* b3 = b2 + kstep;
            if constexpr (SP2) {
            PG8_LDB(B0, 0, 0); PG8_LDB(B1, 0, 1); PG8_SCHED; PG8_LDA(At, 0, 0); PG8_STAGE(PG8_SA(1, 1), a1 + hstepA, voffA);
            PG8_WAIT_V(8); PG8_WAIT_L(0); PG8_BAR; PG8_MMA(0, 0, At, B0); PG8_MMA(0, 1, At, B1); PG8_BAR; PG8_SCHED;
            PG8_LDA(At, 0, 1); PG8_STAGE(PG8_SB(0, 0), b2, voffB); PG8_STAGE(PG8_SB(0, 1), b2 + hstepB, voffB); PG8_STAGE(PG8_SA(0, 0), a2, voffA);
            PG8_WAIT_V(8); PG8_WAIT_L(0); PG8_BAR; PG8_MMA(1, 0, At, B0); PG8_MMA(1, 1, At, B1); PG8_BAR; PG8_SCHED;
            PG8_LDB(B0, 1, 0); PG8_LDB(B1, 1, 1); PG8_SCHED; PG8_LDA(At, 1, 0); PG8_STAGE(PG8_SA(0, 1), a2 + hstepA, voffA);
            PG8_WAIT_V(8); PG8_WAIT_L(0); PG8_BAR; PG8_MMA(0, 0, At, B0); PG8_MMA(0, 1, At, B1); PG8_BAR; PG8_SCHED;
            PG8_LDA(At, 1, 1); PG8_STAGE(PG8_SB(1, 0), b3, voffB); PG8_STAGE(PG8_SB(1, 1), b3 + hstepB, voffB); PG8_STAGE(PG8_SA(1, 0), a3, voffA);
            PG8_WAIT_V(8); PG8_WAIT_L(0); PG8_BAR; PG8_MMA(1, 0, At, B0); PG8_MMA(1, 1, At, B1); PG8_BAR; PG8_SCHED;
            } else {
            PG8_LDB(B0, 0, 0); PG8_SCHED; PG8_LDA(At, 0, 0); PG8_STAGE(PG8_SA(1, 1), a1 + hstepA, voffA);
            PG8_WAIT_L(8); PG8_BAR; PG8_WAIT_L(0); PG8_MMA(0, 0, At, B0); PG8_BAR; PG8_SCHED;
            PG8_LDB(B1, 0, 1); PG8_STAGE(PG8_SB(0, 0), b2, voffB);
            PG8_BAR; PG8_WAIT_L(0); PG8_MMA(0, 1, At, B1); PG8_BAR;
            PG8_LDA(At, 0, 1); PG8_STAGE(PG8_SA(0, 0), a2, voffA);
            PG8_BAR; PG8_WAIT_L(0); PG8_MMA(1, 0, At, B0); PG8_BAR; PG8_SCHED;
            PG8_STAGE(PG8_SB(0, 1), b2 + hstepB, voffB);
            PG8_WAIT_V(6); PG8_BAR; PG8_MMA(1, 1, At, B1); PG8_BAR;
            PG8_LDB(B0, 1, 0); PG8_SCHED; PG8_LDA(At, 1, 0); PG8_STAGE(PG8_SA(0, 1), a2 + hstepA, voffA);
            PG8_WAIT_L(8); PG8_BAR; PG8_WAIT_L(0); PG8_MMA(0, 0, At, B0); PG8_BAR; PG8_SCHED;
            PG8_LDB(B1, 1, 1); PG8_STAGE(PG8_SB(1, 0), b3, voffB);
            PG8_BAR; PG8_WAIT_L(0); PG8_MMA(0, 1, At, B1); PG8_BAR;
            PG8_LDA(At, 1, 1); PG8_STAGE(PG8_SA(1, 0), a3, voffA);
            PG8_BAR; PG8_WAIT_L(0); PG8_MMA(1, 0, At, B0); PG8_BAR; PG8_SCHED;
            PG8_STAGE(PG8_SB(1, 1), b3 + hstepB, voffB);
            PG8_WAIT_V(6); PG8_BAR; PG8_MMA(1, 1, At, B1); PG8_BAR;
            }
        }
        if constexpr (ALIGN_EPI) { if (wr == 0) PG8_BAR; }
        E(acc, cur, wr, wc, fr, fq);
        if (!has_next) break;
#pragma unroll
        for (int a = 0; a < 2; ++a)
#pragma unroll
            for (int b = 0; b < 2; ++b)
#pragma unroll
                for (int m = 0; m < 4; ++m)
#pragma unroll
                    for (int n = 0; n < 2; ++n) acc[a][b][m][n] = (f32x4){0.f, 0.f, 0.f, 0.f};
        cur = nxt; cA = nA; cB = nB; ++ui;
        if constexpr (ALIGN_EPI) { if (wr == 1) PG8_BAR; }
    }
    PG8_WAIT_V(0);
    if constexpr (!ALIGN_EPI) { if (wr == 0) PG8_BAR; }
    PG8_BAR;
#undef PG8_SA
#undef PG8_SB
#undef PG8_STAGE
#undef PG8_LDA
#undef PG8_LDB
#undef PG8_MMA
#undef PG8_WAIT_V
#undef PG8_WAIT_L
#undef PG8_BAR
#undef PG8_SCHED
}
}
constexpr int D_MODEL = 4096, BATCH = 4, SEQ = 4096, M_TOK = BATCH * SEQ, N_MEM = 256, M_MEM = BATCH * N_MEM;
constexpr int A_IN = 6720, A_LDP = 6912, B_IN = 9216;
constexpr int A_OFF_CQ = 0, A_OFF_CKV = 1024, A_OFF_KR = 1536, A_OFF_XQ = 1600, A_OFF_Z = 2624;
constexpr int B_OFF_Q = 0, B_OFF_K = 3072, B_OFF_V = 3584, B_OFF_XQ = 4096, B_OFF_Z = 5120;
constexpr int QW = 4608, KVW = 6144;
constexpr float LOG2E = 1.4426950408889634f;
constexpr float C2_MLA = 0.07216878364870322f * LOG2E;
constexpr float C2_SWA = 0.125f * LOG2E;
constexpr float C2_MEM = 0.0625f * LOG2E;
constexpr float EPS = 1e-6f;

namespace pg8 {
__device__ __forceinline__ float silu_f(float z) { return z * __builtin_amdgcn_rcpf(1.0f + __builtin_amdgcn_exp2f(-z * LOG2E)); }
__device__ __forceinline__ void store8(bf16_t* p, f32x4 v0, f32x4 v1) {
    u32x4 w; w.x = cvt_pk_bf16(v0[0], v0[1]); w.y = cvt_pk_bf16(v0[2], v0[3]); w.z = cvt_pk_bf16(v1[0], v1[1]); w.w = cvt_pk_bf16(v1[2], v1[3]); *(u32x4*)p = w;
}
__device__ __forceinline__ void rope8(f32x4& v0, f32x4& v1, const f32x4 cs, const f32x4 sn) {
    float a, b;
    a = v0[0]; b = v0[1]; v0[0] = a * cs[0] - b * sn[0]; v0[1] = b * cs[0] + a * sn[0];
    a = v0[2]; b = v0[3]; v0[2] = a * cs[1] - b * sn[1]; v0[3] = b * cs[1] + a * sn[1];
    a = v1[0]; b = v1[1]; v1[0] = a * cs[2] - b * sn[2]; v1[1] = b * cs[2] + a * sn[2];
    a = v1[2]; b = v1[3]; v1[2] = a * cs[3] - b * sn[3]; v1[3] = b * cs[3] + a * sn[3];
}

__device__ __forceinline__ float rr_slow(const float* p, int n, float inv) { float s = 0.f;
#pragma unroll 1
    for (int i = 0; i < n; ++i) s += p[i];
    return 1.0f / sqrtf(s * inv + EPS); }
struct EpiAin {
    static constexpr bool PERM = true;
    bf16_t* proj;
    bf16_t* mkv;
    const float* cosT; const float* sinT;
    const float* rr;
    const PG8_LAS float* rrl; int pmc;
    float* part;
    __device__ __forceinline__ void operator()(const f32x4 (&acc)[2][2][4][2], const Unit& u, int wr, int wc, int fr, int fq) const {
        if (u.pn >= 27) {
            const int l = (u.pn - 27) >> 3, ct = (u.pn - 27) & 7;
            bf16_t* base = mkv + (size_t)l * M_MEM * 2048;
            int opq = 0; asm volatile("" : "+v"(opq));
            const int row0 = (u.pm - 64) * BM + wr * 64 + fr + opq, col0 = ct * BM + wc * 32 + 8 * fq;
#pragma unroll
            for (int ai = 0; ai < 2; ++ai)
#pragma unroll
                for (int m = 0; m < 4; ++m) { bf16_t* rowp = base + (size_t)(row0 + ai * HALF + m * 16) * 2048 + col0;
#pragma unroll
                    for (int bj = 0; bj < 2; ++bj) store8(rowp + bj * HALF, acc[ai][bj][m][0], acc[ai][bj][m][1]); }
            return;
        }
        int opq = 0; asm volatile("" : "+v"(opq));
        const int lrow0 = wr * 64 + fr + opq, row0 = u.pm * BM + lrow0;
#pragma unroll
        for (int bj = 0; bj < 2; ++bj) {
            const int cw = u.pn * BM + bj * HALF + wc * 32;
            if (cw >= A_IN) continue;
            const int col0 = cw + 8 * fq;
            const int cls = cw < A_OFF_KR ? 0 : (cw < A_OFF_XQ ? 1 : (cw < A_OFF_Z ? 2 : 3));
#pragma unroll
            for (int ai = 0; ai < 2; ++ai)
#pragma unroll
                for (int m = 0; m < 4; ++m) { const int row = row0 + ai * HALF + m * 16; const float r = (u.pm == pmc) ? rrl[lrow0 + ai * HALF + m * 16] : rr[row];
                    f32x4 v0 = acc[ai][bj][m][0] * r, v1 = acc[ai][bj][m][1] * r;
                    if (cls == 0) { float ss = ((v0[0] * v0[0] + v0[1] * v0[1]) + (v0[2] * v0[2] + v0[3] * v0[3])) + ((v1[0] * v1[0] + v1[1] * v1[1]) + (v1[2] * v1[2] + v1[3] * v1[3]));
                        { const int ln = fr + 16 * fq;
                          ss += __builtin_bit_cast(float, __builtin_amdgcn_ds_bpermute((ln ^ 16) << 2, __builtin_bit_cast(int, ss)));
                          ss += __builtin_bit_cast(float, __builtin_amdgcn_ds_bpermute((ln ^ 32) << 2, __builtin_bit_cast(int, ss))); }
                        if (fq == 0) part[(size_t)row * 48 + (cw >> 5)] = ss; }
                    if (cls == 1) { const int i0 = (col0 - A_OFF_KR) >> 1;
                        const f32x4 cs = *(const f32x4*)(cosT + (size_t)row * 32 + i0), sn = *(const f32x4*)(sinT + (size_t)row * 32 + i0);
                        rope8(v0, v1, cs, sn); }
                    else if (cls == 2) { v0 = v0 * C2_MEM; v1 = v1 * C2_MEM; }
                    else if (cls == 3) {
#pragma unroll
                        for (int e = 0; e < 4; ++e) { v0[e] = silu_f(v0[e]); v1[e] = silu_f(v1[e]); } }
                    store8(proj + (size_t)row * A_LDP + col0, v0, v1); }
        }
    }
};
struct EpiBin {
    static constexpr bool PERM = true;
    bf16_t* proj;
    const float* rr; const PG8_LAS float* rrl; int pmc;
    __device__ __forceinline__ void operator()(const f32x4 (&acc)[2][2][4][2], const Unit& u, int wr, int wc, int fr, int fq) const {
        int opq = 0; asm volatile("" : "+v"(opq));
        const int lrow0 = wr * 64 + fr + opq, row0 = u.pm * BM + lrow0, col0 = u.pn * BM + wc * 32 + 8 * fq;
        const int cls = u.pn < 12 ? 0 : (u.pn < 16 ? 1 : (u.pn < 20 ? 2 : 3));
#pragma unroll
        for (int ai = 0; ai < 2; ++ai)
#pragma unroll
            for (int m = 0; m < 4; ++m) { const int row = row0 + ai * HALF + m * 16; bf16_t* rowp = proj + (size_t)row * B_IN + col0;
                const float r = (u.pm == pmc) ? rrl[lrow0 + ai * HALF + m * 16] : rr[row], rs = cls == 0 ? r * C2_SWA : (cls == 2 ? r * C2_MEM : r);
#pragma unroll
                for (int bj = 0; bj < 2; ++bj) { f32x4 v0 = acc[ai][bj][m][0] * rs, v1 = acc[ai][bj][m][1] * rs;
                    if (cls == 3) {
#pragma unroll
                        for (int e = 0; e < 4; ++e) { v0[e] = silu_f(v0[e]); v1[e] = silu_f(v1[e]); } }
                    store8(rowp + bj * HALF, v0, v1); } }
    }
};
struct EpiQ {
    static constexpr bool PERM = true;
    bf16_t* q;
    const float* cosT; const float* sinT;
    const float* part; const PG8_LAS float* rrl; int pmc;
    __device__ __forceinline__ void operator()(const f32x4 (&acc)[2][2][4][2], const Unit& u, int wr, int wc, int fr, int fq) const {
        int opq = 0; asm volatile("" : "+v"(opq));
        const int lrow0 = wr * 64 + fr + opq, row0 = u.pm * BM + lrow0;
#pragma unroll
        for (int bj = 0; bj < 2; ++bj) {
            const int cw = u.pn * BM + bj * HALF + wc * 32, hc = cw % 192;
            const int col0 = cw + 8 * fq;
            const bool rope = hc >= 128;
            const int i0 = (hc - 128 + 8 * fq) >> 1;
#pragma unroll
            for (int ai = 0; ai < 2; ++ai)
#pragma unroll
                for (int m = 0; m < 4; ++m) { const int row = row0 + ai * HALF + m * 16;
                    const float r = C2_MLA * ((u.pm == pmc) ? rrl[lrow0 + ai * HALF + m * 16] : rr_slow(part + (size_t)row * 48, 32, 1.f / 1024.f));
                    f32x4 v0 = acc[ai][bj][m][0] * r, v1 = acc[ai][bj][m][1] * r;
                    if (rope) { const f32x4 cs = *(const f32x4*)(cosT + (size_t)row * 32 + i0), sn = *(const f32x4*)(sinT + (size_t)row * 32 + i0);
                        rope8(v0, v1, cs, sn); }
                    store8(q + (size_t)row * QW + col0, v0, v1); }
        }
    }
};
struct EpiPlain {
    static constexpr bool PERM = true;
    bf16_t* o; int ldc;
    __device__ __forceinline__ void operator()(const f32x4 (&acc)[2][2][4][2], const Unit& u, int wr, int wc, int fr, int fq) const {
        int opq = 0; asm volatile("" : "+v"(opq));
        const int row0 = u.pm * BM + wr * 64 + fr + opq, col0 = u.pn * BM + wc * 32 + 8 * fq;
#pragma unroll
        for (int ai = 0; ai < 2; ++ai)
#pragma unroll
            for (int m = 0; m < 4; ++m) { bf16_t* rowp = o + (size_t)(row0 + ai * HALF + m * 16) * ldc + col0;
#pragma unroll
                for (int bj = 0; bj < 2; ++bj) store8(rowp + bj * HALF, acc[ai][bj][m][0], acc[ai][bj][m][1]); }
    }
};
struct EpiKV {
    static constexpr bool PERM = true;
    bf16_t* o;
    const float* part; const PG8_LAS float* rrl; int pmc;
    __device__ __forceinline__ void operator()(const f32x4 (&acc)[2][2][4][2], const Unit& u, int wr, int wc, int fr, int fq) const {
        int opq = 0; asm volatile("" : "+v"(opq));
        const int lrow0 = wr * 64 + fr + opq, row0 = u.pm * BM + lrow0, col0 = u.pn * BM + wc * 32 + 8 * fq;
#pragma unroll
        for (int ai = 0; ai < 2; ++ai)
#pragma unroll
            for (int m = 0; m < 4; ++m) { const int row = row0 + ai * HALF + m * 16; bf16_t* rowp = o + (size_t)row * KVW + col0;
                const float r = (u.pm == pmc) ? rrl[lrow0 + ai * HALF + m * 16] : rr_slow(part + (size_t)row * 48 + 32, 16, 1.f / 512.f);
#pragma unroll
                for (int bj = 0; bj < 2; ++bj) store8(rowp + bj * HALF, acc[ai][bj][m][0] * r, acc[ai][bj][m][1] * r); }
    }
};
struct SchedKV { StaticOrder o;
    __device__ __forceinline__ bool next(int i, Unit& u) const {
        if (o.G != 256) return o.next(i, u);
        int L; if (i < 5) L = i * 256 + o.c; else if (o.c >= 128 && i < 7) L = 1280 + (i - 5) * 128 + (o.c - 128); else return false;
        o.map(L, u); return true; }
    __device__ __forceinline__ void fix(Unit&) const {} };
struct SchedRange { StaticOrder o; int i0, n;
    __device__ __forceinline__ bool next(int i, Unit& u) const { return i < n && o.next(i0 + i, u); } __device__ __forceinline__ void fix(Unit&) const {} };
struct SchedPlain { StaticOrder o; __device__ __forceinline__ bool next(int i, Unit& u) const { return o.next(i, u); } __device__ __forceinline__ void fix(Unit&) const {} };
struct SchedAin { StaticOrder o; __device__ __forceinline__ bool next(int i, Unit& u) const { return o.next(i, u); }
    __device__ __forceinline__ void fix(Unit& u) const { if (u.pm < 0) { const int e = u.pn, l = e >> 5, r = e & 31; u.pm = 64 + (r >> 3); u.pn = 27 + l * 8 + (r & 7); } } };
}
namespace att {
#define ATT_LAS __attribute__((address_space(3)))
typedef unsigned short bf16_t;
typedef short bf16x8 __attribute__((ext_vector_type(8)));
typedef short s16x4 __attribute__((ext_vector_type(4)));
typedef float f32x16 __attribute__((ext_vector_type(16)));
typedef float f32x4 __attribute__((ext_vector_type(4)));
typedef unsigned u32x4 __attribute__((ext_vector_type(4)));
#define ATT_SBAR() __builtin_amdgcn_sched_barrier(0)
constexpr float THR2 = 8.0f;

template <int DQK> __device__ __forceinline__ int kswz(int row, int chunk) {
    const int sw = (DQK == 256 || DQK == 128) ? (row & 15) : ((row >> 1) & 7);
    return row * (DQK * 2) + ((chunk ^ sw) << 4);
}
template <int DV> __device__ __forceinline__ int v_st(int k, int c) { constexpr int NCB = DV / 32; const int kk = (k & ~0xC) | ((k & 4) << 1) | ((k & 8) >> 1); return ((kk >> 3) * NCB + (c >> 5)) * 512 + ((kk & 7) * 32 + (c & 31)) * 2; }
__device__ __forceinline__ int v_rd_base(int lane) { return ((lane & 3) << 3) | (((lane >> 2) & 3) << 6) | (((lane >> 4) & 1) << 5) | (((lane >> 5) & 1) << 8); }
__device__ __forceinline__ int crow(int r, int hi) { return (r & 3) + 8 * (r >> 2) + 4 * hi; }
__device__ __forceinline__ unsigned cvtpk(float lo, float hi) { return pg8::cvt_pk_bf16(lo, hi); }
__device__ __forceinline__ const char* uptr(const char* p) { const unsigned long long v = (unsigned long long)(uintptr_t)p;
    unsigned lo = __builtin_amdgcn_readfirstlane((unsigned)v), hi = __builtin_amdgcn_readfirstlane((unsigned)(v >> 32)); asm volatile("" : "+s"(lo), "+s"(hi));
    return (const char*)(uintptr_t)(((unsigned long long)hi << 32) | lo); }
__device__ __forceinline__ float bf2f(bf16_t v) { return __uint_as_float(((unsigned)v) << 16); }

__device__ __forceinline__ void softmax_exp(f32x16& p0, f32x16& p1, float& m_reg, float& alpha) {
    float pmax = p0[0];
#pragma unroll
    for (int r = 1; r < 16; ++r) pmax = fmaxf(pmax, p0[r]);
#pragma unroll
    for (int r = 0; r < 16; ++r) pmax = fmaxf(pmax, p1[r]);
    { auto rr = __builtin_amdgcn_permlane32_swap(__float_as_uint(pmax), __float_as_uint(pmax), false, false);
      pmax = fmaxf(__uint_as_float(rr[0]), __uint_as_float(rr[1])); }
    float mn;
    if (__builtin_expect(__all(pmax - m_reg <= THR2), 1)) { mn = m_reg; alpha = 1.f; }
    else { mn = fmaxf(m_reg, pmax); alpha = __builtin_amdgcn_exp2f(m_reg - mn); m_reg = mn; }
#pragma unroll
    for (int r = 0; r < 16; ++r) p0[r] = __builtin_amdgcn_exp2f(p0[r] - mn);
#pragma unroll
    for (int r = 0; r < 16; ++r) p1[r] = __builtin_amdgcn_exp2f(p1[r] - mn);
}
__device__ __forceinline__ void softmax_pack(const f32x16& p0, const f32x16& p1, float alpha, float& l_reg, bf16x8& pa0, bf16x8& pa1, bf16x8& pa2, bf16x8& pa3) {
    float ps = 0.f;
    { float s0 = p0[0] + p0[1], s1 = p0[2] + p0[3], s2 = p1[0] + p1[1], s3 = p1[2] + p1[3];
#pragma unroll
      for (int r = 4; r < 16; r += 4) { s0 += p0[r] + p0[r + 1]; s1 += p0[r + 2] + p0[r + 3]; s2 += p1[r] + p1[r + 1]; s3 += p1[r + 2] + p1[r + 3]; }
      ps = (s0 + s1) + (s2 + s3); }
    { auto rr = __builtin_amdgcn_permlane32_swap(__float_as_uint(ps), __float_as_uint(ps), false, false);
      ps = __uint_as_float(rr[0]) + __uint_as_float(rr[1]); }
    l_reg = l_reg * alpha + ps;
#define ATT_PK4(P, B_, OUT) do { unsigned a0 = cvtpk(P[B_+0], P[B_+1]), a1 = cvtpk(P[B_+2], P[B_+3]);                          \
        unsigned b0 = cvtpk(P[B_+4], P[B_+5]), b1 = cvtpk(P[B_+6], P[B_+7]);                                             \
        auto r0 = __builtin_amdgcn_permlane32_swap(a0, b0, false, false); auto r1 = __builtin_amdgcn_permlane32_swap(a1, b1, false, false); \
        u32x4 w = {r0[0], r1[0], r0[1], r1[1]}; OUT = __builtin_bit_cast(bf16x8, w); } while (0)
    ATT_PK4(p0, 0, pa0); ATT_PK4(p0, 8, pa1); ATT_PK4(p1, 0, pa2); ATT_PK4(p1, 8, pa3);
#undef ATT_PK4
}
template <int DQK, int GD, bool ZERO = true>
__device__ __forceinline__ void qkt(f32x16& p0, f32x16& p1, const ATT_LAS char* Kb, int r32, int hi, const bf16x8* qr) {
    constexpr int ND = DQK / 16, NG = ND / GD; static_assert(ND % GD == 0, "qkt group size");
    if constexpr (ZERO) { p0 = f32x16{}; p1 = f32x16{}; }
    const ATT_LAS char* kb[4];
#pragma unroll
    for (int dd = 0; dd < 4; ++dd) kb[dd] = Kb + kswz<DQK>(r32, dd * 2 + hi);
    bf16x8 fa[2][GD], fb[2][GD];
#define ATT_KLD(G_, B_) do { _Pragma("unroll") for (int i_ = 0; i_ < GD; ++i_) { const int d0_ = (G_) * GD + i_; \
        const ATT_LAS char* a_ = (DQK >= 128) ? (const ATT_LAS char*)(((unsigned)(uintptr_t)kb[d0_ & 3] ^ (unsigned)(((d0_ >> 2) & 1) << 7))) + (d0_ >> 3) * 256 : kb[d0_ & 3] + (d0_ >> 2) * 128;     \
        fa[B_][i_] = *(const ATT_LAS bf16x8*)(a_); fb[B_][i_] = *(const ATT_LAS bf16x8*)(a_ + 32 * DQK * 2); } } while (0)
    ATT_KLD(0, 0);
#pragma unroll
    for (int g = 0; g < NG; ++g) {
        if (g + 1 < NG) { if ((g & 1) == 0) ATT_KLD(g + 1, 1); else ATT_KLD(g + 1, 0); }
        ATT_SBAR();
#pragma unroll
        for (int i = 0; i < GD; ++i) {
            p0 = __builtin_amdgcn_mfma_f32_32x32x16_bf16(fa[g & 1][i], qr[g * GD + i], p0, 0, 0, 0);
            p1 = __builtin_amdgcn_mfma_f32_32x32x16_bf16(fb[g & 1][i], qr[g * GD + i], p1, 0, 0, 0); }
        ATT_SBAR();
    }
#undef ATT_KLD
}
template <int DV, int VOFF>
__device__ __forceinline__ void pv_tile(f32x16* o, int vb0, bf16x8 pa0, bf16x8 pa1, bf16x8 pa2, bf16x8 pa3) {
    constexpr int NCB = DV / 32, KS = NCB * 1024, HF = NCB * 512;
#define ATT_TRRD(dst, off) asm volatile("ds_read_b64_tr_b16 %0, %1 offset:%2" : "=&v"(dst) : "v"(vb0), "i"(off) : "memory")
#define ATT_VLD(B_, D_) do { constexpr int b_ = VOFF + (D_) * 512; \
        ATT_TRRD(vl[B_][0], b_); ATT_TRRD(vh[B_][0], b_ + HF); ATT_TRRD(vl[B_][1], b_ + KS); ATT_TRRD(vh[B_][1], b_ + KS + HF); \
        ATT_TRRD(vl[B_][2], b_ + 2 * KS); ATT_TRRD(vh[B_][2], b_ + 2 * KS + HF); ATT_TRRD(vl[B_][3], b_ + 3 * KS); ATT_TRRD(vh[B_][3], b_ + 3 * KS + HF); } while (0)
#define ATT_VFR(B_, k_) (bf16x8){vl[B_][k_][0], vl[B_][k_][1], vl[B_][k_][2], vl[B_][k_][3], vh[B_][k_][0], vh[B_][k_][1], vh[B_][k_][2], vh[B_][k_][3]}
#define ATT_PVD(B_, D_) do { o[D_] = __builtin_amdgcn_mfma_f32_32x32x16_bf16(pa0, ATT_VFR(B_, 0), o[D_], 0, 0, 0); o[D_] = __builtin_amdgcn_mfma_f32_32x32x16_bf16(pa1, ATT_VFR(B_, 1), o[D_], 0, 0, 0); \
        o[D_] = __builtin_amdgcn_mfma_f32_32x32x16_bf16(pa2, ATT_VFR(B_, 2), o[D_], 0, 0, 0); o[D_] = __builtin_amdgcn_mfma_f32_32x32x16_bf16(pa3, ATT_VFR(B_, 3), o[D_], 0, 0, 0); } while (0)
    s16x4 vl[2][4], vh[2][4];
    ATT_VLD(0, 0);
    if constexpr (NCB == 2) {
        ATT_VLD(1, 1); asm volatile("s_waitcnt lgkmcnt(8)" ::: "memory"); ATT_SBAR(); ATT_PVD(0, 0);
        asm volatile("s_waitcnt lgkmcnt(0)" ::: "memory"); ATT_SBAR(); ATT_PVD(1, 1);
    } else {
        static_assert(NCB == 4 || NCB == 2, "pv_tile: DV is 64 or 128");
        ATT_VLD(1, 1); asm volatile("s_waitcnt lgkmcnt(8)" ::: "memory"); ATT_SBAR(); ATT_PVD(0, 0); ATT_SBAR();
        ATT_VLD(0, 2); asm volatile("s_waitcnt lgkmcnt(8)" ::: "memory"); ATT_SBAR(); ATT_PVD(1, 1); ATT_SBAR();
        ATT_VLD(1, 3); asm volatile("s_waitcnt lgkmcnt(8)" ::: "memory"); ATT_SBAR(); ATT_PVD(0, 2); ATT_SBAR();
        asm volatile("s_waitcnt lgkmcnt(0)" ::: "memory"); ATT_SBAR(); ATT_PVD(1, 3);
    }
#undef ATT_TRRD
#undef ATT_VLD
#undef ATT_VFR
#undef ATT_PVD
}

template <int DV>
__device__ __forceinline__ void epilogue_rows(const f32x16* o, float l_reg, ATT_LAS float* li_l, ATT_LAS char* stg, const bf16_t* Gw, int ldg, bf16_t* Yw, int ldy, int lane) {
    constexpr int NCB = DV / 32, RS = DV * 2 + 16, CH = DV / 8, RPP = 64 / CH, NP = 32 / RPP;
    const int r32 = lane & 31, hi = lane >> 5;
    if (hi == 0) li_l[r32] = l_reg;
    asm volatile("s_waitcnt lgkmcnt(0)" ::: "memory");
#pragma unroll
    for (int r = 0; r < 16; ++r) { const int orow = crow(r, hi); const float rl = __builtin_amdgcn_rcpf(li_l[orow]);
#pragma unroll
        for (int d0 = 0; d0 < NCB; ++d0) { const unsigned w = cvtpk(o[d0][r] * rl, 0.f); *(ATT_LAS unsigned short*)(stg + orow * RS + (d0 * 32 + r32) * 2) = (unsigned short)w; } }
    asm volatile("s_waitcnt lgkmcnt(0)" ::: "memory");
    int opq = 0; asm volatile("" : "+v"(opq));
#pragma unroll
    for (int i = 0; i < NP; ++i) { const int row = i * RPP + lane / CH + opq, ch = lane % CH;
        const u32x4 ov = *(const ATT_LAS u32x4*)(stg + row * RS + ch * 16);
        const u32x4 gv = *(const u32x4*)(Gw + (size_t)row * ldg + ch * 8);
        u32x4 yv;
#pragma unroll
        for (int e = 0; e < 4; ++e) { const float a0 = __uint_as_float(ov[e] << 16) * __uint_as_float(gv[e] << 16), a1 = __uint_as_float(ov[e] & 0xffff0000u) * __uint_as_float(gv[e] & 0xffff0000u); yv[e] = cvtpk(a0, a1); }
        *(u32x4*)(Yw + (size_t)row * ldy + ch * 8) = yv; }
}

template <int DV>
__device__ __forceinline__ void gate_prefetch(u32x4 (&gv)[32 / (64 / (DV / 8))], const bf16_t* Gw, int ldg, int lane) {
    constexpr int CH = DV / 8, RPP = 64 / CH, NP = 32 / RPP;
#pragma unroll
    for (int i = 0; i < NP; ++i) { const int row = i * RPP + lane / CH, ch = lane % CH; gv[i] = *(const u32x4*)(Gw + (size_t)row * ldg + ch * 8); }
}
template <int DV>
__device__ __forceinline__ void epilogue_rows_pre(const f32x16* o, float l_reg, ATT_LAS float* li_l, ATT_LAS char* stg, const u32x4 (&gv)[32 / (64 / (DV / 8))], bf16_t* Yw, int ldy, int lane) {
    constexpr int NCB = DV / 32, RS = DV * 2 + 16, CH = DV / 8, RPP = 64 / CH, NP = 32 / RPP;
    const int r32 = lane & 31, hi = lane >> 5;
    if (hi == 0) li_l[r32] = l_reg;
    asm volatile("s_waitcnt lgkmcnt(0)" ::: "memory");
#pragma unroll
    for (int r = 0; r < 16; ++r) { const int orow = crow(r, hi); const float rl = __builtin_amdgcn_rcpf(li_l[orow]);
#pragma unroll
        for (int d0 = 0; d0 < NCB; ++d0) { const unsigned w = cvtpk(o[d0][r] * rl, 0.f); *(ATT_LAS unsigned short*)(stg + orow * RS + (d0 * 32 + r32) * 2) = (unsigned short)w; } }
    asm volatile("s_waitcnt lgkmcnt(0)" ::: "memory");
    int opq = 0; asm volatile("" : "+v"(opq));
#pragma unroll
    for (int i = 0; i < NP; ++i) { const int row = i * RPP + lane / CH + opq, ch = lane % CH;
        const u32x4 ov = *(const ATT_LAS u32x4*)(stg + row * RS + ch * 16);
        u32x4 yv;
#pragma unroll
        for (int e = 0; e < 4; ++e) { const float a0 = __uint_as_float(ov[e] << 16) * __uint_as_float(gv[i][e] << 16), a1 = __uint_as_float(ov[e] & 0xffff0000u) * __uint_as_float(gv[i][e] & 0xffff0000u); yv[e] = cvtpk(a0, a1); }
        *(u32x4*)(Yw + (size_t)row * ldy + ch * 8) = yv; }
}

__device__ __forceinline__ void mla_core_dma(ATT_LAS char* lds, const bf16_t* Qw, int ldq, const bf16_t* K0, int ldk0, const bf16_t* K1, int ldk1, const bf16_t* V, int ldv,
        int NT, int qpos0, const bf16_t* Gw, int ldg, bf16_t* Yw, int ldy, int tid_in) {
    constexpr int DQK = 192, DV = 128, NCB = 4, VBY = 16384, KBY = 24576, K_OFF = 2 * VBY, WS_OFF = K_OFF + 2 * KBY, ROPE = 16384;
    int tid_ = tid_in; asm volatile("" : "+v"(tid_));
    const int tid = tid_, wid = __builtin_amdgcn_readfirstlane(tid >> 6), lane = tid & 63, r32 = lane & 31, hi = lane >> 5;
    ATT_LAS float* ws = (ATT_LAS float*)(lds + WS_OFF) + wid * 64; ATT_LAS float* li_l = ws; ATT_LAS float* al_l = ws + 32;
    const int vb0 = (int)(unsigned)(uintptr_t)lds + v_rd_base(lane);
    unsigned sn0, sr0, sv0;
    { const int row = 4 * wid + (lane >> 4), cp = lane & 15, ch = cp ^ (row & 15);
      sn0 = (unsigned)(row * ldk0 + ch * 8) * 2u; }
    { const int row = 8 * wid + (lane >> 3), cp = lane & 7, ch = cp ^ ((row >> 1) & 7);
      sr0 = (unsigned)(row * ldk1 + ch * 8) * 2u; }
    { const int st = 2 * wid + (lane >> 5), kkh = st >> 2, cb = st & 3, q = (lane & 31) >> 2, c = cb * 32 + (lane & 3) * 8;
      const int kk = kkh * 8 + q, k = (kk & ~0xC) | ((kk & 4) << 1) | ((kk & 8) >> 1);
      sv0 = (unsigned)(k * ldv + c) * 2u; }
    const size_t stepK0 = (size_t)64 * ldk0 * 2, stepK1 = (size_t)64 * ldk1 * 2, stepV = (size_t)64 * ldv * 2;
    const unsigned ldsw = (unsigned)wid * 1024u;
#define MLA_DMA(BUF, t_) do { const char* kb0_ = uptr((const char*)K0 + (size_t)(t_) * stepK0); const char* kb0b_ = uptr((const char*)K0 + (size_t)(t_) * stepK0 + (size_t)64 * ldk0); \
        const char* kb1_ = uptr((const char*)K1 + (size_t)(t_) * stepK1); const char* vb_ = uptr((const char*)V + (size_t)(t_) * stepV); const char* vbb_ = uptr((const char*)V + (size_t)(t_) * stepV + (size_t)64 * ldv); \
        unsigned sn0_ = sn0, sr0_ = sr0, sv0_ = sv0; asm volatile("" : "+v"(sn0_), "+v"(sr0_), "+v"(sv0_));     \
        __builtin_amdgcn_global_load_lds((const unsigned*)(kb0_ + sn0_), (ATT_LAS unsigned*)(lds + K_OFF + (BUF) * KBY + ldsw), 16, 0, 0); \
        __builtin_amdgcn_global_load_lds((const unsigned*)(kb0b_ + sn0_), (ATT_LAS unsigned*)(lds + K_OFF + (BUF) * KBY + 8192 + ldsw), 16, 0, 0); \
        __builtin_amdgcn_global_load_lds((const unsigned*)(kb1_ + sr0_), (ATT_LAS unsigned*)(lds + K_OFF + (BUF) * KBY + ROPE + ldsw), 16, 0, 0); \
        __builtin_amdgcn_global_load_lds((const unsigned*)(vb_ + sv0_), (ATT_LAS unsigned*)(lds + (BUF) * VBY + ldsw), 16, 0, 0); \
        __builtin_amdgcn_global_load_lds((const unsigned*)(vbb_ + sv0_), (ATT_LAS unsigned*)(lds + (BUF) * VBY + 8192 + ldsw), 16, 0, 0); } while (0)
    MLA_DMA(0, 0);
    bf16x8 qr[DQK / 16];
    { const char* qb_ = uptr((const char*)Qw); unsigned qo_ = (unsigned)(r32 * ldq + hi * 8) * 2u; asm volatile("" : "+v"(qo_));
#pragma unroll
      for (int d0 = 0; d0 < DQK / 16; ++d0) qr[d0] = *(const __attribute__((address_space(1))) bf16x8*)(uintptr_t)(qb_ + qo_ + d0 * 32); }
    float m_reg = -1e30f, l_reg = 0.f; f32x16 o[NCB];
    { float z_ = 0.f; asm volatile("" : "+v"(z_));
#pragma unroll
      for (int d = 0; d < NCB; ++d)
#pragma unroll
          for (int r = 0; r < 16; ++r) o[d][r] = z_; }
    asm volatile("s_waitcnt vmcnt(0)" ::: "memory");
    __syncthreads();
    const int qm = qpos0 + r32 - 4 * hi;
    const int kn0 = r32 * 256 + ((hi ^ (r32 & 15)) << 4), kr0 = ROPE + r32 * 128 + ((hi ^ ((r32 >> 1) & 7)) << 4);
#define MLA_KA(d0) ((d0) < 8 ? (kn0 ^ ((((d0) & 3) << 5) | (((d0) >> 2) << 7))) : (kr0 ^ (((d0) - 8) << 5)))
#define MLA_KH(d0) ((d0) < 8 ? 8192 : 4096)
#define MLA_KLD(G_, B_) do { _Pragma("unroll") for (int i_ = 0; i_ < 4; ++i_) { const int d0_ = (G_) * 4 + i_; \
        fa[B_][i_] = *(const ATT_LAS bf16x8*)(Kb_ + MLA_KA(d0_)); fb[B_][i_] = *(const ATT_LAS bf16x8*)(Kb_ + MLA_KA(d0_) + MLA_KH(d0_)); } } while (0)
#define MLA_QKT(BUF) do { const ATT_LAS char* Kb_ = lds + K_OFF + (BUF) * KBY; bf16x8 fa[2][4], fb[2][4]; p0 = f32x16{}; p1 = f32x16{}; \
        MLA_KLD(0, 0); \
        _Pragma("unroll") for (int g = 0; g < 3; ++g) { \
            if (g + 1 < 3) { if ((g & 1) == 0) MLA_KLD(g + 1, 1); else MLA_KLD(g + 1, 0); } \
            ATT_SBAR(); \
            _Pragma("unroll") for (int i = 0; i < 4; ++i) { p0 = __builtin_amdgcn_mfma_f32_32x32x16_bf16(fa[g & 1][i], qr[g * 4 + i], p0, 0, 0, 0); p1 = __builtin_amdgcn_mfma_f32_32x32x16_bf16(fb[g & 1][i], qr[g * 4 + i], p1, 0, 0, 0); } \
            ATT_SBAR(); } } while (0)
#define MLA_STEP(BF, t, GATE) do { \
        const int kb_ = (t) * 64; \
        if ((t) + 1 < NT) MLA_DMA(1 - (BF), (t) + 1); \
        ATT_SBAR(); \
        if (kb_ <= qpos0 + 31) {                                                 \
        f32x16 p0, p1; \
        MLA_QKT(BF); \
        GATE; \
        if (kb_ + 63 > qpos0) { const int dq = qm - kb_; const float NEG = -__builtin_inff(); \
            _Pragma("unroll") for (int r = 0; r < 16; ++r) { const int c = (r & 3) + 8 * (r >> 2); if (dq - c < 0) p0[r] = NEG; if (dq - c - 32 < 0) p1[r] = NEG; } } \
        float alpha; softmax_exp(p0, p1, m_reg, alpha); \
        if (__any(alpha < 1.f)) { int l_; asm volatile("v_mbcnt_lo_u32_b32 %0, -1, 0\n\tv_mbcnt_hi_u32_b32 %0, -1, %0" : "=v"(l_));     \
            ATT_LAS float* al2_ = (ATT_LAS float*)(lds + WS_OFF) + wid * 64 + 32; const int hi_ = l_ >> 5; \
            if (hi_ == 0) al2_[l_] = alpha; asm volatile("s_waitcnt lgkmcnt(0)" ::: "memory"); \
            _Pragma("unroll") for (int d_ = 0; d_ < NCB; ++d_) _Pragma("unroll") for (int r = 0; r < 16; ++r) o[d_][r] *= al2_[crow(r, hi_)]; } \
        bf16x8 pa0, pa1, pa2, pa3; softmax_pack(p0, p1, alpha, l_reg, pa0, pa1, pa2, pa3); ATT_SBAR(); \
        pv_tile<DV, (BF) * VBY>(o, vb0, pa0, pa1, pa2, pa3); \
        } else { GATE; } \
        asm volatile("s_waitcnt vmcnt(0)" ::: "memory"); \
        __syncthreads(); } while (0)
    for (int t = 0; t + 2 < NT; t += 2) { MLA_STEP(0, t, (void)0); MLA_STEP(1, t + 1, (void)0); }
    u32x4 gv[8];
    MLA_STEP(0, NT - 2, (void)0); MLA_STEP(1, NT - 1, gate_prefetch<DV>(gv, Gw, ldg, lane));
#undef MLA_STEP
#undef MLA_QKT
#undef MLA_KLD
#undef MLA_KA
#undef MLA_KH
#undef MLA_DMA
    { int lane2; asm volatile("v_mbcnt_lo_u32_b32 %0, -1, 0\n\tv_mbcnt_hi_u32_b32 %0, -1, %0" : "=v"(lane2));
      epilogue_rows_pre<DV>(o, l_reg, (ATT_LAS float*)(lds + WS_OFF) + wid * 64, lds + wid * (32 * (DV * 2 + 16)), gv, Yw, ldy, lane2); }
    __syncthreads();
}

__device__ __forceinline__ void mem_core_dma(ATT_LAS char* lds, const bf16_t* Qw, int ldq, const bf16_t* K0, int ldk0, const bf16_t* V, int ldv,
        const bf16_t* Gw, int ldg, bf16_t* Yw, int ldy, int tid_in) {
    constexpr int DQK = 256, DV = 128, NCB = 4, VBY = 16384, KBY = 32768, K_OFF = 2 * VBY, WS_OFF = K_OFF + 2 * KBY, NT = 4;
    int tid_ = tid_in; asm volatile("" : "+v"(tid_));
    const int tid = tid_, wid = __builtin_amdgcn_readfirstlane(tid >> 6), lane = tid & 63, r32 = lane & 31, hi = lane >> 5;
    ATT_LAS float* ws = (ATT_LAS float*)(lds + WS_OFF) + wid * 64; ATT_LAS float* li_l = ws; ATT_LAS float* al_l = ws + 32;
    const int vb0 = (int)(unsigned)(uintptr_t)lds + v_rd_base(lane);
    const char* sk0; const char* sv0; const char* sv1;
    { const int row = 2 * wid + (lane >> 5), cp = lane & 31, ch = (cp & 16) | ((cp & 15) ^ (row & 15));
      sk0 = (const char*)(K0 + (size_t)row * ldk0 + ch * 8); }
    { const int st = 2 * wid + (lane >> 5), kkh = st >> 2, cb = st & 3, q = (lane & 31) >> 2, c = cb * 32 + (lane & 3) * 8;
      const int kk = kkh * 8 + q, k = (kk & ~0xC) | ((kk & 4) << 1) | ((kk & 8) >> 1);
      sv0 = (const char*)(V + (size_t)k * ldv + c);
      const int st1 = st + 16, kkh1 = st1 >> 2, kk1 = kkh1 * 8 + q, k1 = (kk1 & ~0xC) | ((kk1 & 4) << 1) | ((kk1 & 8) >> 1);
      sv1 = (const char*)(V + (size_t)k1 * ldv + c); }
    const size_t stepK = (size_t)64 * ldk0 * 2, stepV = (size_t)64 * ldv * 2, rows16 = (size_t)16 * ldk0 * 2;
    const unsigned ldsw = (unsigned)wid * 1024u;
#define MEM_DMA(BUF, t_) do { \
        _Pragma("unroll") for (int i_ = 0; i_ < 4; ++i_) \
            __builtin_amdgcn_global_load_lds((const unsigned*)(sk0 + (size_t)(t_) * stepK + i_ * rows16), (ATT_LAS unsigned*)(lds + K_OFF + (BUF) * KBY + i_ * 8192 + ldsw), 16, 0, 0); \
        __builtin_amdgcn_global_load_lds((const unsigned*)(sv0 + (size_t)(t_) * stepV), (ATT_LAS unsigned*)(lds + (BUF) * VBY + ldsw), 16, 0, 0); \
        __builtin_amdgcn_global_load_lds((const unsigned*)(sv1 + (size_t)(t_) * stepV), (ATT_LAS unsigned*)(lds + (BUF) * VBY + 8192 + ldsw), 16, 0, 0); } while (0)
    MEM_DMA(0, 0);
    bf16x8 qr[DQK / 16];
#pragma unroll
    for (int d0 = 0; d0 < DQK / 16; ++d0) qr[d0] = *(const bf16x8*)(Qw + (size_t)r32 * ldq + d0 * 16 + hi * 8);
    float m_reg = -1e30f, l_reg = 0.f; f32x16 o[NCB];
    { float z_ = 0.f; asm volatile("" : "+v"(z_));
#pragma unroll
      for (int d = 0; d < NCB; ++d)
#pragma unroll
          for (int r = 0; r < 16; ++r) o[d][r] = z_; }
    asm volatile("s_waitcnt vmcnt(0)" ::: "memory");
    __syncthreads();
#define MEM_STEP(BF, t) do { \
        if ((t) + 1 < NT) MEM_DMA(1 - (BF), (t) + 1); \
        ATT_SBAR(); \
        f32x16 p0, p1; \
        qkt<DQK, 2>(p0, p1, lds + K_OFF + (BF) * KBY, r32, hi, qr); \
        float alpha; softmax_exp(p0, p1, m_reg, alpha); \
        if (__any(alpha < 1.f)) { if (hi == 0) al_l[r32] = alpha; asm volatile("s_waitcnt lgkmcnt(0)" ::: "memory"); \
            _Pragma("unroll") for (int d_ = 0; d_ < NCB; ++d_) _Pragma("unroll") for (int r = 0; r < 16; ++r) o[d_][r] *= al_l[crow(r, hi)]; } \
        bf16x8 pa0, pa1, pa2, pa3; softmax_pack(p0, p1, alpha, l_reg, pa0, pa1, pa2, pa3); ATT_SBAR(); \
        pv_tile<DV, (BF) * VBY>(o, vb0, pa0, pa1, pa2, pa3); \
        asm volatile("s_waitcnt vmcnt(0)" ::: "memory"); \
        __syncthreads(); } while (0)
    MEM_STEP(0, 0); MEM_STEP(1, 1); MEM_STEP(0, 2); MEM_STEP(1, 3);
#undef MEM_STEP
#undef MEM_DMA
    epilogue_rows<DV>(o, l_reg, li_l, lds + wid * (32 * (DV * 2 + 16)), Gw, ldg, Yw, ldy, lane);
    __syncthreads();
}

__device__ __forceinline__ void mem_core2(ATT_LAS char* lds, const bf16_t* Qw, int ldq, const bf16_t* K0, int ldk0, const bf16_t* V, int ldv,
        const bf16_t* Gw, int ldg, bf16_t* Yw, int ldy, int tid_in) {
    constexpr int DQK = 256, DV = 128, NCB = 4, VBY = 16384, KBY = 32768, K_OFF = 2 * VBY, WS_OFF = 102400;
    int tid_ = tid_in; asm volatile("" : "+v"(tid_));
    const int tid = tid_, wid = __builtin_amdgcn_readfirstlane(tid >> 6), lane = tid & 63, r32 = lane & 31, hi = lane >> 5;
    ATT_LAS float* ws = (ATT_LAS float*)(lds + WS_OFF) + wid * 160; ATT_LAS float* li_l = ws; ATT_LAS float* al_l = ws + 32;
    const int vb0 = (int)(unsigned)(uintptr_t)lds + v_rd_base(lane);
    const char* sk0; const char* sv0; const char* sv1;
    { const int row = 2 * wid + (lane >> 5), cp = lane & 31, ch = (cp & 16) | ((cp & 15) ^ (row & 15));
      sk0 = (const char*)(K0 + (size_t)row * ldk0 + ch * 8); }
    { const int st = 2 * wid + (lane >> 5), kkh = st >> 2, cb = st & 3, q = (lane & 31) >> 2, c = cb * 32 + (lane & 3) * 8;
      const int kk = kkh * 8 + q, k = (kk & ~0xC) | ((kk & 4) << 1) | ((kk & 8) >> 1);
      sv0 = (const char*)(V + (size_t)k * ldv + c);
      const int st1 = st + 16, kkh1 = st1 >> 2, kk1 = kkh1 * 8 + q, k1 = (kk1 & ~0xC) | ((kk1 & 4) << 1) | ((kk1 & 8) >> 1);
      sv1 = (const char*)(V + (size_t)k1 * ldv + c); }
    const size_t stepK = (size_t)64 * ldk0 * 2, stepV = (size_t)64 * ldv * 2, rows16 = (size_t)16 * ldk0 * 2;
    const unsigned ldsw = (unsigned)wid * 1024u;
#define MEM_DMAK(BUF, t_) do { _Pragma("unroll") for (int i_ = 0; i_ < 4; ++i_) \
            __builtin_amdgcn_global_load_lds((const unsigned*)(sk0 + (size_t)(t_) * stepK + i_ * rows16), (ATT_LAS unsigned*)(lds + K_OFF + (BUF) * KBY + i_ * 8192 + ldsw), 16, 0, 0); } while (0)
#define MEM_DMAV(BUF, i_) do { \
        __builtin_amdgcn_global_load_lds((const unsigned*)(sv0 + (size_t)((i_) & 3) * stepV + ((i_) >> 2) * 256), (ATT_LAS unsigned*)(lds + (BUF) * VBY + ldsw), 16, 0, 0); \
        __builtin_amdgcn_global_load_lds((const unsigned*)(sv1 + (size_t)((i_) & 3) * stepV + ((i_) >> 2) * 256), (ATT_LAS unsigned*)(lds + (BUF) * VBY + 8192 + ldsw), 16, 0, 0); } while (0)
    MEM_DMAK(0, 0);
    bf16x8 qr[DQK / 16];
#pragma unroll
    for (int d0 = 0; d0 < DQK / 16; ++d0) qr[d0] = *(const bf16x8*)(Qw + (size_t)r32 * ldq + d0 * 16 + hi * 8);
    float m_reg = -1e30f, l_reg = 0.f;
    asm volatile("s_waitcnt vmcnt(0)" ::: "memory");
    __syncthreads();
    bf16x8 P0[4], P1[4], P2[4], P3[4]; bool fl1 = false, fl2 = false, fl3 = false;
#define MEM_QK(BF, t, PP, FL) do { \
        if ((t) + 1 < 4) MEM_DMAK(1 - (BF), (t) + 1); \
        if ((t) == 2) MEM_DMAV(0, 0); \
        if ((t) == 3) MEM_DMAV(1, 1); \
        ATT_SBAR(); \
        f32x16 p0, p1; \
        qkt<DQK, 2>(p0, p1, lds + K_OFF + (BF) * KBY, r32, hi, qr); \
        float alpha; softmax_exp(p0, p1, m_reg, alpha); \
        FL = __any(alpha < 1.f); \
        if (hi == 0) al_l[(t) * 32 + r32] = alpha; \
        softmax_pack(p0, p1, alpha, l_reg, PP[0], PP[1], PP[2], PP[3]); ATT_SBAR(); \
        asm volatile("s_waitcnt vmcnt(0) lgkmcnt(0)" ::: "memory"); \
        __syncthreads(); } while (0)
    { bool fl0; MEM_QK(0, 0, P0, fl0); (void)fl0; } MEM_QK(1, 1, P1, fl1); MEM_QK(0, 2, P2, fl2); MEM_QK(1, 3, P3, fl3);
#undef MEM_QK
#define MEM_PV(i, PP, FL) do { \
        if ((i) >= 1 && (i) + 1 < 8) MEM_DMAV(((i) + 1) & 1, (i) + 1); \
        if (((i) & 3) == 1) { asm volatile("" ::: "memory"); ATT_SBAR(); gate_prefetch<DV>(gv, Gw + ((i) >> 2) * 128, ldg, lane); }     \
        ATT_SBAR(); \
        if (((i) & 3) != 0 && (FL)) { _Pragma("unroll") for (int d_ = 0; d_ < NCB; ++d_) _Pragma("unroll") for (int r = 0; r < 16; ++r) o[d_][r] *= al_l[((i) & 3) * 32 + crow(r, hi)]; } \
        pv_tile<DV, ((i) & 1) * VBY>(o, vb0, PP[0], PP[1], PP[2], PP[3]); \
        if (((i) & 3) == 3) epilogue_rows_pre<DV>(o, l_reg, li_l, lds + K_OFF + wid * (32 * (DV * 2 + 16)), gv, Yw + ((i) >> 2) * 128, ldy, lane); \
        if (((i) & 3) == 1) asm volatile("s_waitcnt vmcnt(8)" ::: "memory");          \
        else asm volatile("s_waitcnt vmcnt(0)" ::: "memory"); \
        __builtin_amdgcn_s_barrier(); } while (0)
#pragma unroll
    for (int h = 0; h < 2; ++h) {
        f32x16 o[NCB]; u32x4 gv[8];
        { float z_ = 0.f; asm volatile("" : "+v"(z_));
#pragma unroll
          for (int d = 0; d < NCB; ++d)
#pragma unroll
              for (int r = 0; r < 16; ++r) o[d][r] = z_; }
        if (h == 0) { MEM_PV(0, P0, false); MEM_PV(1, P1, fl1); MEM_PV(2, P2, fl2); MEM_PV(3, P3, fl3); }
        else        { MEM_PV(4, P0, false); MEM_PV(5, P1, fl1); MEM_PV(6, P2, fl2); MEM_PV(7, P3, fl3); }
    }
#undef MEM_PV
#undef MEM_DMAK
#undef MEM_DMAV
}

struct SwaUnit { int b, kvh, qb; };
__device__ __forceinline__ SwaUnit swa_decode(int U) { SwaUnit u; u.qb = U & 31; u.kvh = (U >> 5) & 7; u.b = U >> 8; return u; }
struct SwaPre { bf16x8 k[4], v[4]; };
constexpr int SWA_TN = 320, SWA_TOFF = 96;
constexpr int SWA_V = 0, SWA_K = 32768, SWA_WS = 65536, SWA_BIAS = 65536 + 2048, SWA_STG = 83968, SWA_NU = 1024;
__device__ __forceinline__ void swa_prefetch(SwaPre& P, const SwaUnit& u, const bf16_t* proj, int tid) {
    const int j_lo = (2 * u.qb - 2) > 0 ? (2 * u.qb - 2) : 0, NT = 2 * u.qb + 2 - j_lo;
    const size_t kr0 = (size_t)u.b * SEQ + j_lo * 64 + (tid >> 3);
    const bf16_t* kp = proj + kr0 * B_IN + B_OFF_K + u.kvh * 64 + (tid & 7) * 8;
    const bf16_t* vp = proj + kr0 * B_IN + B_OFF_V + u.kvh * 64 + (tid & 7) * 8;
#pragma unroll
    for (int tt = 0; tt < 4; ++tt) if (tt < NT) { P.k[tt] = *(const bf16x8*)(kp + (size_t)tt * 64 * B_IN); P.v[tt] = *(const bf16x8*)(vp + (size_t)tt * 64 * B_IN); }
}
__device__ __forceinline__ void swa_bias_dma(ATT_LAS char* lds, int tb, const SwaUnit& u, const float* ebias, int wid, int lane) {
    __builtin_amdgcn_global_load_lds((const unsigned*)((const char*)(ebias + (size_t)u.kvh * 6 * SWA_TN) + (wid * 64 + lane) * 16), (ATT_LAS unsigned*)(lds + SWA_BIAS + tb * 8192 + wid * 1024), 16, 0, 0);
}
__device__ __forceinline__ void swa_prefetch_q(bf16x8 (&q)[4], const SwaUnit& u, int pass, const bf16_t* proj, int wid, int r32, int hi) {
    const int head = u.kvh * 6 + pass * 2 + (wid >> 2), pos0 = u.qb * 128 + (wid & 3) * 32;
    const bf16_t* qp = proj + ((size_t)u.b * SEQ + pos0 + r32) * B_IN + B_OFF_Q + head * 64 + hi * 8;
#pragma unroll
    for (int d0 = 0; d0 < 4; ++d0) q[d0] = *(const bf16x8*)(qp + d0 * 16);
}
__device__ __forceinline__ void swa_phase(ATT_LAS char* lds, const bf16_t* proj, bf16_t* Y, const float* ebias, const float* sinks  , int vcu, int G, int tid_in) {
    int tid_ = tid_in; asm volatile("" : "+v"(tid_));
    const int tid = tid_, wid = __builtin_amdgcn_readfirstlane(tid >> 6), lane = tid & 63, r32 = lane & 31, hi = lane >> 5;
    ATT_LAS float* ws = (ATT_LAS float*)(lds + SWA_WS) + wid * 64; ATT_LAS float* li_l = ws; ATT_LAS float* al_l = ws + 32;
    const int vb0 = (int)(unsigned)(uintptr_t)lds + SWA_V + v_rd_base(lane);
    constexpr int NU = SWA_NU;
    int U = vcu; if (U >= NU) return;
    SwaPre P; bf16x8 qn[4]; SwaUnit u = swa_decode(U); int tb = 0;
    swa_bias_dma(lds, 0, u, ebias, wid, lane);
    swa_prefetch(P, u, proj, tid);
    swa_prefetch_q(qn, u, 0, proj, wid, r32, hi);
#pragma unroll 1
    for (;;) {
        const int j_lo = (2 * u.qb - 2) > 0 ? (2 * u.qb - 2) : 0, NT = 2 * u.qb + 2 - j_lo, kbase = j_lo * 64;
        { const int rr = tid >> 3, rc = (tid & 7) * 8;
#pragma unroll
          for (int tt = 0; tt < 4; ++tt) if (tt < NT) { *(ATT_LAS bf16x8*)(lds + SWA_V + tt * 8192 + v_st<64>(rr, rc)) = P.v[tt]; *(ATT_LAS bf16x8*)(lds + SWA_K + tt * 8192 + kswz<64>(rr, tid & 7)) = P.k[tt]; }
        }
        asm volatile("s_waitcnt vmcnt(0)" ::: "memory");
        __syncthreads();
        const int Un = U + G; const bool more = Un < NU; SwaUnit un = u;
        if (more) { un = swa_decode(Un); swa_prefetch(P, un, proj, tid); }
        ATT_SBAR();
#pragma unroll 1
        for (int pass = 0; pass < 3; ++pass) {
            bf16x8 qr[4];
#pragma unroll
            for (int d0 = 0; d0 < 4; ++d0) qr[d0] = qn[d0];
            if (pass < 2) swa_prefetch_q(qn, u, pass + 1, proj, wid, r32, hi); else if (more) swa_prefetch_q(qn, un, 0, proj, wid, r32, hi);
            ATT_SBAR();
            const int hsel = pass * 2 + (wid >> 2), head = u.kvh * 6 + hsel, pos0 = u.qb * 128 + (wid & 3) * 32;
            const ATT_LAS float* biasS = (const ATT_LAS float*)(lds + SWA_BIAS + tb * 8192) + hsel * SWA_TN;
            float m_reg = sinks[head] * LOG2E, l_reg = 1.f; f32x16 o[2]; o[0] = f32x16{}; o[1] = f32x16{};
            const int qm = pos0 + r32 - 4 * hi;
            u32x4 gv[4]; gate_prefetch<64>(gv, proj + ((size_t)u.b * SEQ + pos0) * B_IN + B_OFF_Z + head * 64, B_IN, lane);
#pragma unroll 1
            for (int tt = 0; tt < NT; ++tt) {
                const int kb_ = kbase + tt * 64;
                if (!(kb_ <= pos0 + 31 && kb_ + 63 >= pos0 - 127)) continue;
                f32x16 p0, p1;
                { const ATT_LAS float* bp = biasS + (qm - kb_ + SWA_TOFF - 59);
#pragma unroll
                  for (int r = 0; r < 16; ++r) { const int c = (r & 3) + 8 * (r >> 2); p0[r] = bp[59 - c]; p1[r] = bp[59 - c - 32]; } }
                qkt<64, 4, false>(p0, p1, lds + SWA_K + tt * 8192, r32, hi, qr);
                float alpha; softmax_exp(p0, p1, m_reg, alpha);
                if (__any(alpha < 1.f)) { if (hi == 0) al_l[r32] = alpha; asm volatile("s_waitcnt lgkmcnt(0)" ::: "memory");
#pragma unroll
                    for (int d_ = 0; d_ < 2; ++d_)
#pragma unroll
                        for (int r = 0; r < 16; ++r) o[d_][r] *= al_l[crow(r, hi)]; }
                bf16x8 pa0, pa1, pa2, pa3; softmax_pack(p0, p1, alpha, l_reg, pa0, pa1, pa2, pa3); ATT_SBAR();
                pv_tile<64, 0>(o, vb0 + tt * 8192, pa0, pa1, pa2, pa3);
            }
            { const size_t rows0 = (size_t)u.b * SEQ + pos0;
              epilogue_rows_pre<64>(o, l_reg, li_l, lds + SWA_STG + wid * (32 * 144), gv, Y + rows0 * D_MODEL + head * 64, D_MODEL, lane); }
        }
        if (!more) break;
        swa_bias_dma(lds, 1 - tb, un, ebias, wid, lane);
        U = Un; u = un; tb = 1 - tb;
        __syncthreads();
    }
    __syncthreads();
}
}
constexpr int NWAVES = 8;
constexpr size_t MiB = 1u << 20;
constexpr size_t WS_CTL = 0, CTL_ZERO_BYTES = 1 * MiB;
constexpr size_t WS_COS = 1 * MiB, WS_SIN = 3 * MiB, WS_BIAS = 5 * MiB;
constexpr size_t WS_RR = 6 * MiB;
constexpr size_t WS_MKV = 8 * MiB;
constexpr size_t WS_WIN = 16 * MiB;
constexpr size_t WS_WQB = 102 * MiB;
constexpr size_t WS_WKVB = 111 * MiB;
constexpr size_t WS_WOUT = 117 * MiB;
constexpr size_t WS_HB = 150 * MiB;
constexpr size_t WS_PROJ = 286 * MiB;
constexpr size_t WS_Q = 574 * MiB;
constexpr size_t WS_HI = 718 * MiB;
constexpr size_t WS_LO = 854 * MiB;
constexpr size_t WS_WOUT2 = 982 * MiB;
constexpr size_t WS_PART = 1014 * MiB;
constexpr size_t WS_END = 1018 * MiB;
constexpr int CW_BAR = 4096;
constexpr int RING_BYTES = 131072, LDSCTL_OFF = RING_BYTES, MISC_OFF = LDSCTL_OFF + 320, LDS_BYTES = 147456;
constexpr int RRL_OFF = RING_BYTES + 2048;

#define GAS __attribute__((address_space(1)))
#define LAS __attribute__((address_space(3)))
typedef unsigned short bf16;
typedef unsigned v4u __attribute__((ext_vector_type(4)));
typedef float f32x4 __attribute__((ext_vector_type(4)));
typedef GAS unsigned gu32;
#define RLX_AGENT __ATOMIC_RELAXED, __HIP_MEMORY_SCOPE_AGENT
#define LDS_WAIT() asm volatile("s_waitcnt lgkmcnt(0)" ::: "memory")
#define VM_WAIT() asm volatile("s_waitcnt vmcnt(0)" ::: "memory")
__device__ __forceinline__ unsigned f2bf(float f) { unsigned u = __builtin_bit_cast(unsigned, f); return (u + 0x7fffu + ((u >> 16) & 1u)) >> 16; }
__device__ __forceinline__ unsigned pk2(float lo, float hi) { return f2bf(lo) | (f2bf(hi) << 16); }

#define XB_TMO      128
#define XB_XCNT(j)  (256  + 64 * (j))
#define XB_XSUB(j)  (1280 + 64 * (j))
#define XB_XGEN(j)  (2304 + 64 * (j))
#define XB_TOP      3328
#define XB_TOPGEN   3392
#define XCD_BAR_WORDS 3456
#define XB_SPIN_CAP (1u << 21)

__device__ __forceinline__ unsigned xb_ld(unsigned* p)              { return __hip_atomic_load(p, __ATOMIC_RELAXED, __HIP_MEMORY_SCOPE_AGENT); }
__device__ __forceinline__ unsigned xb_add(unsigned* p, unsigned v) { return __hip_atomic_fetch_add(p, v, __ATOMIC_RELAXED, __HIP_MEMORY_SCOPE_AGENT); }
__device__ __forceinline__ unsigned xb_xcc_id() { return (unsigned)__builtin_amdgcn_s_getreg((3 << 11) | 20) & 0xFu; }
#define XB_SPIN(cond, bar) do { unsigned _sp = 0; while (cond) { __builtin_amdgcn_s_sleep(1); \
    if ((++_sp & 255u) == 0u) { if (xb_ld(&(bar)[XB_TMO])) break; if (_sp > XB_SPIN_CAP) { atomicAdd(&(bar)[XB_TMO], 1u); break; } } } } while (0)

__device__ __forceinline__ int fresh_tid(int wave) { int l; asm volatile("v_mbcnt_lo_u32_b32 %0, -1, 0\n\tv_mbcnt_hi_u32_b32 %0, -1, %0" : "=v"(l)); return wave * 64 + l; }
struct XcdBarrier {
    unsigned* bar; unsigned x;
    volatile LAS unsigned* st;
};
__device__ __forceinline__ XcdBarrier xcd_barrier_post(unsigned* bar, volatile LAS unsigned* st) {
    XcdBarrier b; b.bar = bar; b.x = xb_xcc_id(); b.st = st;
    if (threadIdx.x == 0) (void)xb_add(&bar[XB_XCNT(b.x)], 1u);
    return b;
}
__device__ __forceinline__ void xcd_barrier_complete(unsigned* bar, unsigned x, unsigned& nloc, unsigned& nx) {
    const unsigned G = gridDim.x * gridDim.y * gridDim.z;
    unsigned sum, cnt, mine, sp = 0u;
    for (;;) {
        sum = 0u; cnt = 0u; mine = 0u;
#pragma unroll
        for (unsigned j = 0; j < 16; ++j) { const unsigned c = xb_ld(&bar[XB_XCNT(j)]); sum += c; cnt += (c > 0u) ? 1u : 0u; mine = (j == x) ? c : mine; }
        if (sum == G) break;
        __builtin_amdgcn_s_sleep(1);
        if ((++sp & 255u) == 0u) { if (xb_ld(&bar[XB_TMO])) break; if (sp > XB_SPIN_CAP) { atomicAdd(&bar[XB_TMO], 1u); break; } }
    }
    nloc = mine > 0u ? mine : 1u; nx = cnt > 0u ? cnt : 1u;
}
__device__ __forceinline__ void xcd_barrier(const XcdBarrier& b, int wave) {
    asm volatile("s_waitcnt vmcnt(0)" ::: "memory");
    __syncthreads();
    if (fresh_tid(wave) == 0) {
        unsigned* bar = b.bar;
        __builtin_amdgcn_s_waitcnt(0);
        unsigned nloc = b.st[0], nx = b.st[1];
        if (nloc == 0u) { xcd_barrier_complete(bar, b.x, nloc, nx); b.st[0] = nloc; b.st[1] = nx; }
        const unsigned old = xb_add(&bar[XB_XSUB(b.x)], 1u);
        const unsigned gen = old / nloc;
        if (old + 1u == (gen + 1u) * nloc) {
            __builtin_amdgcn_fence(__ATOMIC_RELEASE, "agent");
            asm volatile("s_waitcnt vmcnt(0)" ::: "memory");
            const unsigned og = xb_add(&bar[XB_TOP], 1u);
            const unsigned tg = og / nx;
            if (og + 1u == (tg + 1u) * nx) xb_add(&bar[XB_TOPGEN], 1u);
            else XB_SPIN(xb_ld(&bar[XB_TOPGEN]) == tg, bar);
            __builtin_amdgcn_fence(__ATOMIC_ACQUIRE, "agent");
            xb_add(&bar[XB_XGEN(b.x)], 1u);
            asm volatile("s_waitcnt vmcnt(0)" ::: "memory");
        } else {
            XB_SPIN(xb_ld(&bar[XB_XGEN(b.x)]) == gen, bar);
            __builtin_amdgcn_fence(__ATOMIC_ACQUIRE, "agent");
            asm volatile("s_waitcnt vmcnt(0)" ::: "memory");
        }
    }
    __syncthreads();
}

__device__ __forceinline__ float shx(float v, int lane, int o) { return __builtin_bit_cast(float, __builtin_amdgcn_ds_bpermute((lane ^ o) << 2, __builtin_bit_cast(int, v))); }
__device__ __forceinline__ float wave_sum(float v, int lane) {
#pragma unroll
    for (int o = 1; o < 64; o <<= 1) v += shx(v, lane, o);
    return v;
}
__device__ const unsigned char T5B[128] = {0, 1, 2, 3, 4, 5, 6, 7, 8, 9, 10, 11, 12, 13, 14, 15, 16, 16, 16, 17, 17, 18, 18, 18, 19, 19, 19, 20, 20, 20, 20, 21, 21, 21, 21, 22, 22, 22, 22, 22, 23, 23, 23, 23, 23, 23, 24, 24, 24, 24, 24, 24, 25, 25, 25, 25, 25, 25, 25, 26, 26, 26, 26, 26, 26, 26, 26, 27, 27, 27, 27, 27, 27, 27, 27, 27, 27, 28, 28, 28, 28, 28, 28, 28, 28, 28, 28, 29, 29, 29, 29, 29, 29, 29, 29, 29, 29, 29, 29, 30, 30, 30, 30, 30, 30, 30, 30, 30, 30, 30, 30, 30, 30, 31, 31, 31, 31, 31, 31, 31, 31, 31, 31, 31, 31, 31, 31, 31};

__device__ const float INVF[32] = {1.000000000e+00f, 7.498942614e-01f, 5.623413324e-01f, 4.216965139e-01f, 3.162277639e-01f, 2.371373773e-01f, 1.778279394e-01f, 1.333521307e-01f, 1.000000015e-01f, 7.498941571e-02f, 5.623413250e-02f, 4.216965288e-02f, 3.162277490e-02f, 2.371373773e-02f, 1.778279431e-02f, 1.333521493e-02f, 9.999999776e-03f, 7.498941850e-03f, 5.623413250e-03f, 4.216964822e-03f, 3.162277630e-03f, 2.371373586e-03f, 1.778279431e-03f, 1.333521446e-03f, 1.000000047e-03f, 7.498942432e-04f, 5.623413017e-04f, 4.216965172e-04f, 3.162277571e-04f, 2.371373703e-04f, 1.778279402e-04f, 1.333521504e-04f};
__device__ __forceinline__ int permrope(int i) { return i < 32 ? 2 * i : 2 * (i - 32) + 1; }
struct TrItem { const float* W; const float* gain; bf16* WT; int K, N, row_off, map, item; };
__device__ __forceinline__ void tr_load(const TrItem& d, f32x4 (&v)[16], float (&g)[16], int lane) {
    const int nblk = d.N / 64, kb = d.item / nblk, nb = d.item - kb * nblk, k0 = 64 * kb, n0 = 64 * nb, lr = lane >> 4, lc = (lane & 15) * 4;
#pragma unroll
    for (int i = 0; i < 16; ++i) v[i] = __builtin_nontemporal_load((const GAS f32x4*)(d.W + (size_t)(k0 + 4 * i + lr) * d.N + n0 + lc));
#pragma unroll
    for (int i = 0; i < 16; ++i) g[i] = d.gain ? d.gain[k0 + 4 * i + lr] : 1.0f;
}
__device__ __forceinline__ void tr_finish(const TrItem& d, const f32x4 (&v)[16], const float (&g)[16], LAS float* scr_f, int lane) {
    constexpr int ROWB = 144;
    LAS unsigned char* scr = (LAS unsigned char*)scr_f;
    const int nblk = d.N / 64, kb = d.item / nblk, nb = d.item - kb * nblk, k0 = 64 * kb, n0 = 64 * nb, lr = lane >> 4, lc = (lane & 15) * 4;
#pragma unroll
    for (int i = 0; i < 16; ++i) { const f32x4 w = v[i] * g[i];
        *(LAS unsigned long long*)(scr + (4 * i + lr) * ROWB + lc * 2) = (unsigned long long)pk2(w.x, w.y) | ((unsigned long long)pk2(w.z, w.w) << 32); }
    LDS_WAIT(); asm volatile("" ::: "memory");
    const int gq = lane >> 4, i16 = lane & 15, q = (lane >> 2) & 3, p = lane & 3;
    const int rbase = (int)(unsigned)(uintptr_t)scr + (8 * gq + q) * ROWB + 8 * p;
    typedef short s16x4 __attribute__((ext_vector_type(4)));
#pragma unroll
    for (int nb16 = 0; nb16 < 4; ++nb16)
#pragma unroll
        for (int ph = 0; ph < 2; ++ph) { s16x4 lo, hi;
            asm volatile("ds_read_b64_tr_b16 %0, %1 offset:%2" : "=&v"(lo) : "v"(rbase), "i"(ph * 32 * ROWB + nb16 * 32) : "memory");
            asm volatile("ds_read_b64_tr_b16 %0, %1 offset:%2" : "=&v"(hi) : "v"(rbase), "i"(ph * 32 * ROWB + nb16 * 32 + 4 * ROWB) : "memory");
            asm volatile("s_waitcnt lgkmcnt(0)" ::: "memory");
            int dn = n0 + 16 * nb16 + i16;
            if (d.map == 1) { if (dn >= A_OFF_KR && dn < A_OFF_XQ) dn = A_OFF_KR + permrope(dn - A_OFF_KR); }
            if (d.map == 2) { const int hc = dn % 192; if (hc >= 128) dn = dn - hc + 128 + permrope(hc - 128); }
            v4u o; o.x = (unsigned)(unsigned short)lo[0] | ((unsigned)(unsigned short)lo[1] << 16); o.y = (unsigned)(unsigned short)lo[2] | ((unsigned)(unsigned short)lo[3] << 16);
            o.z = (unsigned)(unsigned short)hi[0] | ((unsigned)(unsigned short)hi[1] << 16); o.w = (unsigned)(unsigned short)hi[2] | ((unsigned)(unsigned short)hi[3] << 16);
            *(GAS v4u*)(d.WT + (size_t)(d.row_off + dn) * d.K + k0 + 8 * (4 * ph + gq)) = o; }
    asm volatile("s_waitcnt lgkmcnt(0)" ::: "memory");
}
#define CONV_RUN(NITEMS_, DEC) do { f32x4 va_[16], vb_[16]; float ga_[16], gb_[16]; TrItem da_, db_; int it_ = gw; \
        if (it_ < (NITEMS_)) { DEC(da_, it_); tr_load(da_, va_, ga_, lane); \
            for (;;) { { const int nx_ = (it_ + NGW < (NITEMS_)) ? it_ + NGW : it_; DEC(db_, nx_); tr_load(db_, vb_, gb_, lane); }     \
                       tr_finish(da_, va_, ga_, scr, lane); it_ += NGW; if (it_ >= (NITEMS_)) break; \
                       { const int nx_ = (it_ + NGW < (NITEMS_)) ? it_ + NGW : it_; DEC(da_, nx_); tr_load(da_, va_, ga_, lane); } \
                       tr_finish(db_, vb_, gb_, scr, lane); it_ += NGW; if (it_ >= (NITEMS_)) break; } } } while (0)
__device__ __forceinline__ void rms_row_bf16(const float* xrow, const bf16* drow, float* xout, bf16* orow, int lane) {
    const GAS f32x4* xr = (const GAS f32x4*)xrow + lane;
    f32x4 v[16]; float s = 0.f;
#pragma unroll
    for (int j = 0; j < 16; ++j) v[j] = xr[64 * j];
    if (drow) { const GAS unsigned long long* dr = (const GAS unsigned long long*)drow + lane;
#pragma unroll
        for (int j = 0; j < 16; ++j) { const unsigned long long d = dr[64 * j]; const unsigned lo = (unsigned)d, hi = (unsigned)(d >> 32);
            v[j].x += __uint_as_float(lo << 16); v[j].y += __uint_as_float(lo & 0xffff0000u); v[j].z += __uint_as_float(hi << 16); v[j].w += __uint_as_float(hi & 0xffff0000u); } }
    if (xout) { GAS f32x4* xo = (GAS f32x4*)xout + lane;
#pragma unroll
        for (int j = 0; j < 16; ++j) xo[64 * j] = v[j]; }
#pragma unroll
    for (int j = 0; j < 16; ++j) s += (v[j].x * v[j].x + v[j].y * v[j].y) + (v[j].z * v[j].z + v[j].w * v[j].w);
    const float r = 1.0f / sqrtf(wave_sum(s, lane) * (1.f / D_MODEL) + EPS);
    GAS unsigned long long* o8 = (GAS unsigned long long*)orow + lane;
#pragma unroll
    for (int j = 0; j < 16; ++j) o8[64 * j] = (unsigned long long)pk2(v[j].x * r, v[j].y * r) | ((unsigned long long)pk2(v[j].z * r, v[j].w * r) << 32);
}
typedef unsigned v2u __attribute__((ext_vector_type(2)));
typedef unsigned char u8;
__device__ __forceinline__ float bf_lo(unsigned u) { return __uint_as_float(u << 16); }
__device__ __forceinline__ float bf_hi(unsigned u) { return __uint_as_float(u & 0xffff0000u); }
__device__ __forceinline__ unsigned lo_ebits(float hif) { const unsigned e = __float_as_uint(hif) & 0x7f800000u; return e > (16u << 23) ? e : (16u << 23); }
__device__ __forceinline__ float lo_dec(unsigned q, float hif) { return ((float)q - 128.f) * __uint_as_float(lo_ebits(hif) - (15u << 23)); }
__device__ __forceinline__ unsigned lo_enc(float x, float hif) { const float r = (x - hif) * __uint_as_float((269u << 23) - lo_ebits(hif)) + 128.5f;
    return (unsigned)fminf(fmaxf(r, 1.f), 255.f); }
__device__ __forceinline__ void split2(float a, float b, unsigned& h, unsigned& la, unsigned& lb) {
    const unsigned ha = f2bf(a), hb = f2bf(b); h = ha | (hb << 16); la = lo_enc(a, __uint_as_float(ha << 16)); lb = lo_enc(b, __uint_as_float(hb << 16)); }
__device__ __forceinline__ void xrow_first(const float* xrow, bf16* hrow, float* rr, int lane) {
    const GAS f32x4* xr = (const GAS f32x4*)xrow + lane; f32x4 v[16]; float s = 0.f;
#pragma unroll
    for (int j = 0; j < 16; ++j) v[j] = xr[64 * j];
    GAS unsigned long long* o8 = (GAS unsigned long long*)hrow + lane;
#pragma unroll
    for (int j = 0; j < 16; ++j) { s += (v[j].x * v[j].x + v[j].y * v[j].y) + (v[j].z * v[j].z + v[j].w * v[j].w);
        o8[64 * j] = (unsigned long long)pk2(v[j].x, v[j].y) | ((unsigned long long)pk2(v[j].z, v[j].w) << 32); }
    const float r = 1.0f / sqrtf(wave_sum(s, lane) * (1.f / D_MODEL) + EPS);
    if (lane == 0) *(GAS float*)rr = r;
}
__device__ __forceinline__ void xrow_f32(const float* xrow, const bf16* drow, bf16* hrow, u8* lrow, float* rr, int lane) {
    const GAS f32x4* xr = (const GAS f32x4*)xrow + lane; const GAS unsigned long long* dr = (const GAS unsigned long long*)drow + lane;
    f32x4 v[16]; unsigned long long d[16]; float s = 0.f;
#pragma unroll
    for (int j = 0; j < 16; ++j) v[j] = xr[64 * j];
#pragma unroll
    for (int j = 0; j < 16; ++j) d[j] = dr[64 * j];
    GAS unsigned long long* h8 = (GAS unsigned long long*)hrow + lane; GAS unsigned* l4 = (GAS unsigned*)lrow + lane;
#pragma unroll
    for (int j = 0; j < 16; ++j) { const unsigned d0 = (unsigned)d[j], d1 = (unsigned)(d[j] >> 32);
        const float a = v[j].x + bf_lo(d0), b = v[j].y + bf_hi(d0), c = v[j].z + bf_lo(d1), e = v[j].w + bf_hi(d1);
        s += (a * a + b * b) + (c * c + e * e);
        unsigned h0, h1, q0, q1, q2, q3; split2(a, b, h0, q0, q1); split2(c, e, h1, q2, q3);
        h8[64 * j] = (unsigned long long)h0 | ((unsigned long long)h1 << 32); l4[64 * j] = q0 | (q1 << 8) | (q2 << 16) | (q3 << 24); }
    const float r = 1.0f / sqrtf(wave_sum(s, lane) * (1.f / D_MODEL) + EPS);
    if (lane == 0) *(GAS float*)rr = r;
}
__device__ __forceinline__ void xrow_hl(bf16* hrow, u8* lrow, const bf16* drow, float* rr, int lane) {
    GAS v4u* hp = (GAS v4u*)hrow + lane; GAS v2u* lp = (GAS v2u*)lrow + lane; const GAS v4u* dp = (const GAS v4u*)drow + lane;
    v4u h[8], d[8]; v2u l[8]; float s = 0.f;
#pragma unroll
    for (int j = 0; j < 8; ++j) { h[j] = hp[64 * j]; l[j] = lp[64 * j]; d[j] = dp[64 * j]; }
#pragma unroll
    for (int j = 0; j < 8; ++j) { v4u ho; v2u lo = {0u, 0u};
#pragma unroll
        for (int e = 0; e < 4; ++e) { const unsigned lw = l[j][e >> 1]; const int sh = (e & 1) * 16;
            const float h0 = bf_lo(h[j][e]), h1 = bf_hi(h[j][e]);
            const float a = (h0 + lo_dec((lw >> sh) & 255u, h0)) + bf_lo(d[j][e]), b = (h1 + lo_dec((lw >> (sh + 8)) & 255u, h1)) + bf_hi(d[j][e]);
            s += a * a + b * b; unsigned hh, qa, qb; split2(a, b, hh, qa, qb); ho[e] = hh; lo[e >> 1] |= (qa << sh) | (qb << (sh + 8)); }
        hp[64 * j] = ho; lp[64 * j] = lo; }
    const float r = 1.0f / sqrtf(wave_sum(s, lane) * (1.f / D_MODEL) + EPS);
    if (lane == 0) *(GAS float*)rr = r;
}
__device__ __forceinline__ void xrow_final(float* orow, const bf16* hrow, const u8* lrow, const bf16* drow, const float* g, int lane) {
    GAS f32x4* xo = (GAS f32x4*)orow + lane; const GAS f32x4* gr = (const GAS f32x4*)g + lane;
    const GAS unsigned long long* hr = (const GAS unsigned long long*)hrow + lane; const GAS unsigned* lr = (const GAS unsigned*)lrow + lane;
    const GAS unsigned long long* dr = (const GAS unsigned long long*)drow + lane;
    unsigned long long h[16], d[16]; unsigned l[16]; f32x4 v[16]; float s = 0.f;
#pragma unroll
    for (int j = 0; j < 16; ++j) { h[j] = hr[64 * j]; l[j] = lr[64 * j]; d[j] = dr[64 * j]; }
#pragma unroll
    for (int j = 0; j < 16; ++j) { const unsigned h0 = (unsigned)h[j], h1 = (unsigned)(h[j] >> 32), d0 = (unsigned)d[j], d1 = (unsigned)(d[j] >> 32), lw = l[j];
        const float a0 = bf_lo(h0), a1 = bf_hi(h0), a2 = bf_lo(h1), a3 = bf_hi(h1);
        v[j].x = (a0 + lo_dec(lw & 255u, a0)) + bf_lo(d0); v[j].y = (a1 + lo_dec((lw >> 8) & 255u, a1)) + bf_hi(d0);
        v[j].z = (a2 + lo_dec((lw >> 16) & 255u, a2)) + bf_lo(d1); v[j].w = (a3 + lo_dec(lw >> 24, a3)) + bf_hi(d1);
        s += (v[j].x * v[j].x + v[j].y * v[j].y) + (v[j].z * v[j].z + v[j].w * v[j].w); }
    const float r = 1.0f / sqrtf(wave_sum(s, lane) * (1.f / D_MODEL) + EPS);
#pragma unroll
    for (int j = 0; j < 16; ++j) { const f32x4 gg = gr[64 * j]; xo[64 * j] = (v[j] * r) * gg; }
}
__device__ __forceinline__ float sumsq8(v4u a) {
    float s = 0.f;
#pragma unroll
    for (int i = 0; i < 4; ++i) { const float lo = __uint_as_float(a[i] << 16), hi = __uint_as_float(a[i] & 0xffff0000u); s += lo * lo + hi * hi; }
    return s;
}
__device__ __forceinline__ v4u scale8(v4u a, float r) {
    v4u o;
#pragma unroll
    for (int i = 0; i < 4; ++i) { const float lo = __uint_as_float(a[i] << 16), hi = __uint_as_float(a[i] & 0xffff0000u); o[i] = pk2(lo * r, hi * r); }
    return o;
}
__device__ __forceinline__ void cnorm_row(bf16* prow, int lane) {
    GAS v4u* p = (GAS v4u*)prow + lane;
    const v4u a = p[0], b = p[64], c = p[128];
    const float sq = wave_sum(sumsq8(a) + sumsq8(b), lane), sk = wave_sum(sumsq8(c), lane);
    const float rq = 1.0f / sqrtf(sq * (1.f / 1024.f) + EPS), rk = 1.0f / sqrtf(sk * (1.f / 512.f) + EPS);
    p[0] = scale8(a, rq); p[64] = scale8(b, rq); p[128] = scale8(c, rk);
}

#define SETI(d, W_, g_, WT_, K_, N_, ro_, map_, it_) do { d.W = (W_); d.gain = (g_); d.WT = (WT_); d.K = (K_); d.N = (N_); d.row_off = (ro_); d.map = (map_); d.item = (it_); } while (0)
#define DEC_A(d, it) do { int r_ = (it); \
        if (r_ < CA_IN) { SETI(d, a_w_in + (size_t)cj_ * D_MODEL * A_IN, norm_g + (2 * cj_) * D_MODEL, W_IN, D_MODEL, A_IN, 0, 1, r_); } \
        else if (r_ < CA_IN + CA_MKV) { SETI(d, w_mem_kv + (size_t)(2 * cj_) * D_MODEL * 2048, mem_norm_g + (2 * cj_) * D_MODEL, W_IN, D_MODEL, 2048, A_LDP, 0, r_ - CA_IN); } \
        else if (r_ < CA_IN + 2 * CA_MKV) { SETI(d, w_mem_kv + (size_t)(2 * cj_ + 1) * D_MODEL * 2048, mem_norm_g + (2 * cj_ + 1) * D_MODEL, W_IN, D_MODEL, 2048, A_LDP + 2048, 0, r_ - CA_IN - CA_MKV); } \
        else if (r_ < CA_IN + 2 * CA_MKV + CA_QB) { SETI(d, a_w_qb + (size_t)cj_ * 1024 * QW, a_q_g + cj_ * 1024, W_QB, 1024, QW, 0, 2, r_ - CA_IN - 2 * CA_MKV); } \
        else if (r_ < CA_IN + 2 * CA_MKV + CA_QB + CA_KVB) { SETI(d, a_w_kvb + (size_t)cj_ * 512 * KVW, a_kv_g + cj_ * 512, W_KVB, 512, KVW, 0, 0, r_ - CA_IN - 2 * CA_MKV - CA_QB); } \
        else { SETI(d, w_out + (size_t)(2 * cj_) * D_MODEL * D_MODEL, (const float*)nullptr, (bf16*)(ws + WS_WOUT), D_MODEL, D_MODEL, 0, 0, r_ - CA_IN - 2 * CA_MKV - CA_QB - CA_KVB); } } while (0)
#define CONV_A(jj) do { constexpr int CA_IN = 64 * (A_IN / 64), CA_MKV = 64 * 32, CA_QB = 16 * (QW / 64), CA_KVB = 8 * (KVW / 64), CA_OUT = 64 * 64; \
        constexpr int NITEMS = CA_IN + 2 * CA_MKV + CA_QB + CA_KVB + CA_OUT; const int cj_ = (jj); \
        CONV_RUN(NITEMS, DEC_A); } while (0)
#define DEC_B(d, it) do { const int r_ = (it); \
        if (r_ < CB_IN) { SETI(d, b_w_in + (size_t)cj_ * D_MODEL * B_IN, norm_g + (2 * cj_ + 1) * D_MODEL, W_IN, D_MODEL, B_IN, 0, 0, r_); } \
        else { SETI(d, w_out + (size_t)(2 * cj_ + 1) * D_MODEL * D_MODEL, (const float*)nullptr, (bf16*)(ws + WS_WOUT2), D_MODEL, D_MODEL, 0, 0, r_ - CB_IN); } } while (0)
#define CONV_B(jj) do { constexpr int CB_IN = 64 * (B_IN / 64), CB_OUT = 64 * 64, NITEMS = CB_IN + CB_OUT; const int cj_ = (jj); \
        CONV_RUN(NITEMS, DEC_B); } while (0)

struct Args { const float* in[16]; float* out; unsigned char* ws; int ph_lo, ph_hi; };

__global__ void __launch_bounds__(NWAVES * 64, 2) fwd_kernel(Args args) {
    extern __shared__ __attribute__((aligned(16))) unsigned char lds_raw[];
    LAS unsigned char* lds = (LAS unsigned char*)lds_raw;
    volatile LAS unsigned* MISC = (volatile LAS unsigned*)(lds + MISC_OFF);
    const int wave_k = __builtin_amdgcn_readfirstlane(threadIdx.x >> 6);
    const int G = gridDim.x, bx = blockIdx.x, vcu = (G % 8 == 0) ? (bx % 8) * (G / 8) + bx / 8 : bx;
#define PH_PTRS \
    const int tid = fresh_tid(wave_k), lane = tid & 63, wave = wave_k; \
    const int gw = vcu * NWAVES + wave, NGW = G * NWAVES; LAS float* scr = (LAS float*)(lds + wave * 16384); (void)lane; (void)gw; (void)NGW; (void)scr; \
    const __attribute__((address_space(4))) Args* ap_ = (const __attribute__((address_space(4))) Args*)__builtin_amdgcn_kernarg_segment_ptr(); asm volatile("" : "+s"(ap_)); \
    unsigned char* ws = ap_->ws; float* out = ap_->out; \
    const float* x_in = ap_->in[0]; const float* mem_in = ap_->in[1]; const int* pos_in = (const int*)ap_->in[2]; \
    const float* norm_g = ap_->in[3]; const float* mem_norm_g = ap_->in[4]; const float* final_g = ap_->in[5]; \
    const float* w_mem_kv = ap_->in[6]; const float* w_out = ap_->in[7]; const float* a_w_in = ap_->in[8]; \
    const float* a_q_g = ap_->in[9]; const float* a_kv_g = ap_->in[10]; const float* a_w_qb = ap_->in[11]; const float* a_w_kvb = ap_->in[12]; \
    const float* b_w_in = ap_->in[13]; const float* b_sinks = ap_->in[14]; const float* rel_bias = ap_->in[15]; \
    float* cosT = (float*)(ws + WS_COS); float* sinT = (float*)(ws + WS_SIN); float* bias2 = (float*)(ws + WS_BIAS); \
    bf16* MKV = (bf16*)(ws + WS_MKV); bf16* W_IN = (bf16*)(ws + WS_WIN); bf16* W_QB = (bf16*)(ws + WS_WQB); bf16* W_KVB = (bf16*)(ws + WS_WKVB); bf16* W_OUT = (bf16*)(ws + WS_WOUT); \
    float* PART = (float*)(ws + WS_PART); bf16* HI = (bf16*)(ws + WS_HI); u8* LO = (u8*)(ws + WS_LO); float* RR = (float*)(ws + WS_RR); bf16* Y = (bf16*)(ws + WS_HB); bf16* PROJ = (bf16*)(ws + WS_PROJ); bf16* QB = (bf16*)(ws + WS_Q); bf16* KVB = (bf16*)out; \
    (void)out; (void)x_in; (void)mem_in; (void)pos_in; (void)norm_g; (void)mem_norm_g; (void)final_g; (void)w_mem_kv; (void)w_out; (void)a_w_in; (void)a_q_g; (void)a_kv_g; (void)a_w_qb; (void)a_w_kvb; \
    (void)b_w_in; (void)b_sinks; (void)rel_bias; (void)cosT; (void)sinT; (void)bias2; (void)MKV; (void)W_IN; (void)W_QB; (void)W_KVB; (void)W_OUT; (void)PART; (void)HI; (void)LO; (void)RR; (void)Y; (void)PROJ; (void)QB; (void)KVB;
    unsigned* ctl = (unsigned*)(args.ws + WS_CTL);

    for (int u = threadIdx.x; u < (LDS_BYTES - LDSCTL_OFF) / 4; u += NWAVES * 64) ((LAS unsigned*)(lds + LDSCTL_OFF))[u] = 0u;
    __syncthreads();
    XcdBarrier bar = xcd_barrier_post(ctl + CW_BAR, MISC + 8);
    const int lo = args.ph_lo, hi = args.ph_hi;
    int pc = 0;
#define PH_RUN() (pc >= lo && pc < hi)
#define PH_END() do { if (pc >= lo && pc + 1 < hi) xcd_barrier(bar, wave_k); ++pc; } while (0)

#pragma unroll 1
    for (int j = 0; j < 2; ++j) {
        const int la = 2 * j, lb = 2 * j + 1;
        if (PH_RUN()) { PH_PTRS
            if (j == 0) CONV_A(0);
            const bf16* DL = (const bf16*)(ws + WS_Q);
            if (j == 0) { for (int m = gw; m < M_TOK; m += NGW) xrow_first(x_in + (size_t)m * D_MODEL, HI + (size_t)m * D_MODEL, RR + m, lane); }
            else { for (int m = gw; m < M_TOK; m += NGW) xrow_hl(HI + (size_t)m * D_MODEL, LO + (size_t)m * D_MODEL, DL + (size_t)m * D_MODEL, RR + m, lane); }
            if (j == 0) {
                for (int m = gw; m < M_MEM; m += NGW) rms_row_bf16(mem_in + (size_t)m * D_MODEL, nullptr, nullptr, HI + (size_t)(M_TOK + m) * D_MODEL, lane);
                for (int e = (vcu * NWAVES * 64) + tid; e < M_TOK * 32; e += G * NWAVES * 64) {
                    const int tok = e >> 5, i = e & 31;
                    const float inv = INVF[i];
                    const float ang = (float)pos_in[tok] * inv;
                    const double rev = (double)ang * 0.15915494309189535; const double fr = rev - rint(rev);
                    const float rad = (float)(fr * 6.283185307179586);
                    cosT[e] = cosf(rad); sinT[e] = sinf(rad);
                }
                for (int e = (vcu * NWAVES * 64) + tid; e < 49 * 320; e += G * NWAVES * 64) { const int h = e / 320, d = e - h * 320 - 96;
                    bias2[e] = (h < 48 && (unsigned)d < 128u) ? rel_bias[(int)T5B[d] * 48 + h] * LOG2E : -__builtin_inff(); }
            }
        }
        PH_END();
        if (PH_RUN()) { PH_PTRS
            pg8::Gemm g{HI, W_IN, D_MODEL, D_MODEL, D_MODEL}; pg8::SchedAin S; S.o.init(64, 27, 64, G, bx);
            pg8::Unit u0; u0.pm = 0; u0.pn = 0; (void)S.o.next(0, u0);
            LAS float* rrl = (LAS float*)(lds + RRL_OFF); if (tid < 256) rrl[tid] = RR[u0.pm * 256 + tid]; __syncthreads();
            pg8::EpiAin E{PROJ, MKV, cosT, sinT, RR, rrl, u0.pm, PART};
            pg8::gemm_phase<pg8::EpiAin, pg8::SchedAin, true, true>(lds, g, S, E, tid);
        }
        PH_END();
        if (PH_RUN()) { PH_PTRS
            pg8::Unit u0; u0.pm = 0; u0.pn = 0; { pg8::StaticOrder o; o.init(64, QW / 256, 0, G, bx); (void)o.next(0, u0); }
            LAS float* rrq = (LAS float*)(lds + RRL_OFF); LAS float* rrk = rrq + 256;
            { const int r = tid >> 1, hs = tid & 1; const GAS f32x4* p4 = (const GAS f32x4*)(PART + (size_t)(u0.pm * 256 + r) * 48);
              float sq = 0.f, sk = 0.f;
#pragma unroll
              for (int i = 0; i < 4; ++i) { const f32x4 a = p4[hs * 4 + i]; sq += (a.x + a.y) + (a.z + a.w); }
#pragma unroll
              for (int i = 0; i < 2; ++i) { const f32x4 a = p4[8 + hs * 2 + i]; sk += (a.x + a.y) + (a.z + a.w); }
              sq += shx(sq, lane, 1); sk += shx(sk, lane, 1);
              if (hs == 0) { rrq[r] = 1.0f / sqrtf(sq * (1.f / 1024.f) + EPS); rrk[r] = 1.0f / sqrtf(sk * (1.f / 512.f) + EPS); }
              __syncthreads(); }
            { pg8::Gemm g{PROJ + A_OFF_CQ, W_QB, A_LDP, 1024, 1024}; pg8::SchedPlain S; S.o.init(64, QW / 256, 0, G, bx);
              pg8::EpiQ E{QB, cosT, sinT, PART, rrq, u0.pm}; pg8::gemm_phase<pg8::EpiQ, pg8::SchedPlain, true, true>(lds, g, S, E, tid); }
            { pg8::Gemm g{PROJ + A_OFF_CKV, W_KVB, A_LDP, 512, 512}; pg8::SchedKV S; S.o.init(64, KVW / 256, 0, G, bx);
              pg8::EpiKV E{KVB, PART, rrk, u0.pm}; pg8::gemm_phase<pg8::EpiKV, pg8::SchedKV, true, true>(lds, g, S, E, tid); }
        }
        PH_END();
        if (PH_RUN()) { PH_PTRS
#pragma unroll 1
            for (int P = vcu; P < 768; P += G) {
                const int bh = P >> 3, xq = P & 7, b = bh / 24, h = bh % 24;
#pragma unroll 1
                for (int pass = 0; pass < 2; ++pass) {
                    const int qb = pass ? 15 - xq : xq; const size_t rows0 = (size_t)b * SEQ + qb * 256 + wave * 32, kr0 = (size_t)b * SEQ;
                    att::mla_core_dma((LAS char*)lds, QB + rows0 * QW + h * 192, QW, KVB + kr0 * KVW + h * 256, KVW, PROJ + kr0 * A_LDP + A_OFF_KR, A_LDP,
                                  KVB + kr0 * KVW + h * 256 + 128, KVW, 4 * (qb + 1), qb * 256 + wave * 32,
                                  PROJ + rows0 * A_LDP + A_OFF_Z + h * 128, A_LDP, Y + rows0 * D_MODEL + h * 128, D_MODEL, fresh_tid(wave_k));
                }
            }
#pragma unroll 1
            for (int U = vcu; U < 256; U += G) {
                const int qb = U & 15, xh = (U >> 4) & 3, b = U >> 6; const size_t rows0 = (size_t)b * SEQ + qb * 256 + wave * 32;
                const bf16* mk = MKV + (size_t)(b * N_MEM) * 2048; const int yc = 3072 + xh * 256;
                att::mem_core2((LAS char*)lds, PROJ + rows0 * A_LDP + A_OFF_XQ + xh * 256, A_LDP, mk + xh * 256, 2048, mk + 1024 + xh * 256, 2048,
                                  PROJ + rows0 * A_LDP + A_OFF_Z + yc, A_LDP, Y + rows0 * D_MODEL + yc, D_MODEL, fresh_tid(wave_k));
            }
        }
        PH_END();
        if (PH_RUN()) { PH_PTRS
            pg8::Gemm g{Y, (bf16*)(ws + WS_WOUT), D_MODEL, D_MODEL, D_MODEL};
            pg8::EpiPlain E{(bf16*)(ws + WS_Q), D_MODEL};
            const int nb = (bx & 7) & 3;
            { pg8::SchedRange S; S.o.init(64, 16, 0, G, bx); S.i0 = 0; S.n = nb; pg8::gemm_phase<pg8::EpiPlain, pg8::SchedRange, true, true>(lds, g, S, E, tid); }
            CONV_B(j); __syncthreads();
            { pg8::SchedRange S; S.o.init(64, 16, 0, G, bx); S.i0 = nb; S.n = 1 << 30; pg8::gemm_phase<pg8::EpiPlain, pg8::SchedRange, true, true>(lds, g, S, E, tid); }
        }
        PH_END();
        if (PH_RUN()) { PH_PTRS
            { const bf16* DL = (const bf16*)(ws + WS_Q);
              if (j == 0) { for (int m = gw; m < M_TOK; m += NGW) xrow_f32(x_in + (size_t)m * D_MODEL, DL + (size_t)m * D_MODEL, HI + (size_t)m * D_MODEL, LO + (size_t)m * D_MODEL, RR + m, lane); }
              else { for (int m = gw; m < M_TOK; m += NGW) xrow_hl(HI + (size_t)m * D_MODEL, LO + (size_t)m * D_MODEL, DL + (size_t)m * D_MODEL, RR + m, lane); } }
        }
        PH_END();
        if (PH_RUN()) { PH_PTRS
            pg8::Gemm g{HI, W_IN, D_MODEL, D_MODEL, D_MODEL}; pg8::SchedPlain S; S.o.init(64, B_IN / 256, 0, G, bx);
            pg8::Unit u0; u0.pm = 0; u0.pn = 0; (void)S.o.next(0, u0);
            LAS float* rrl = (LAS float*)(lds + RRL_OFF); if (tid < 256) rrl[tid] = RR[u0.pm * 256 + tid]; __syncthreads();
            pg8::EpiBin E{PROJ, RR, rrl, u0.pm};
            pg8::gemm_phase<pg8::EpiBin, pg8::SchedPlain, true, true>(lds, g, S, E, tid);
        }
        PH_END();
        if (PH_RUN()) { PH_PTRS
            { att::swa_phase((LAS char*)lds, PROJ, Y, bias2, b_sinks + j * 48, vcu, G, tid); }
#pragma unroll 1
            for (int U = vcu; U < 256; U += G) {
                const int qb = U & 15, xh = (U >> 4) & 3, b = U >> 6; const size_t rows0 = (size_t)b * SEQ + qb * 256 + wave * 32;
                const bf16* mk = MKV + (size_t)M_MEM * 2048 + (size_t)(b * N_MEM) * 2048; const int yc = 3072 + xh * 256;
                att::mem_core2((LAS char*)lds, PROJ + rows0 * B_IN + B_OFF_XQ + xh * 256, B_IN, mk + xh * 256, 2048, mk + 1024 + xh * 256, 2048,
                                  PROJ + rows0 * B_IN + B_OFF_Z + yc, B_IN, Y + rows0 * D_MODEL + yc, D_MODEL, fresh_tid(wave_k));
            }
        }
        PH_END();
        if (PH_RUN()) { PH_PTRS
            pg8::Gemm g{Y, (bf16*)(ws + WS_WOUT2), D_MODEL, D_MODEL, D_MODEL};
            pg8::EpiPlain E{(bf16*)(ws + WS_Q), D_MODEL};
            const int nb = (bx & 7) & 3;
            { pg8::SchedRange S; S.o.init(64, 16, 0, G, bx); S.i0 = 0; S.n = nb; pg8::gemm_phase<pg8::EpiPlain, pg8::SchedRange, true, true>(lds, g, S, E, tid); }
            if (j == 0) CONV_A(1);
            __syncthreads();
            { pg8::SchedRange S; S.o.init(64, 16, 0, G, bx); S.i0 = nb; S.n = 1 << 30; pg8::gemm_phase<pg8::EpiPlain, pg8::SchedRange, true, true>(lds, g, S, E, tid); }
        }
        PH_END();
    }
    if (PH_RUN()) { PH_PTRS for (int m = gw; m < M_TOK; m += NGW) xrow_final(out + (size_t)m * D_MODEL, HI + (size_t)m * D_MODEL, LO + (size_t)m * D_MODEL, (const bf16*)(ws + WS_Q) + (size_t)m * D_MODEL, final_g, lane); }
#undef PH_RUN
#undef PH_END
}

constexpr int N_PHASES = 19;
extern "C" void kernel_launch(void* const* d_in, const int* in_sizes, int n_in, void* d_out, int out_size, void* d_ws, size_t ws_size, hipStream_t stream) {
    static int grid = 0;
    if (grid == 0) {
        if (n_in != 16 || in_sizes[0] != M_TOK * D_MODEL || out_size != M_TOK * D_MODEL || ws_size < WS_END) {
            fprintf(stderr, "kernel_launch: unexpected shapes (n_in %d, in0 %d, out %d, ws %zu)\n", n_in, n_in > 0 ? in_sizes[0] : -1, out_size, ws_size); grid = -1; return; }
        int dev = 0, cus = 0, per_cu = 0;
        if (hipGetDevice(&dev) != hipSuccess || hipDeviceGetAttribute(&cus, hipDeviceAttributeMultiprocessorCount, dev) != hipSuccess) { grid = -1; return; }
        if (hipFuncSetAttribute((const void*)fwd_kernel, hipFuncAttributeMaxDynamicSharedMemorySize, LDS_BYTES) != hipSuccess) { fprintf(stderr, "kernel_launch: hipFuncSetAttribute failed\n"); grid = -1; return; }
        if (hipOccupancyMaxActiveBlocksPerMultiprocessor(&per_cu, (const void*)fwd_kernel, NWAVES * 64, LDS_BYTES) != hipSuccess || per_cu < 1)
            fprintf(stderr, "kernel_launch: note: occupancy query reports %d workgroups per CU\n", per_cu);
        (void)hipGetLastError();
        grid = cus;
    }
    if (grid < 0) return;
    if (hipMemsetAsync((char*)d_ws + WS_CTL, 0, CTL_ZERO_BYTES, stream) != hipSuccess) return;
    Args a{};
    for (int i = 0; i < 16; ++i) a.in[i] = (const float*)d_in[i];
    a.out = (float*)d_out; a.ws = (unsigned char*)d_ws;
#if defined(MK_PER_PHASE)
    for (int p = 0; p < N_PHASES; ++p) { a.ph_lo = p; a.ph_hi = p + 1; hipLaunchKernelGGL(fwd_kernel, dim3(grid), dim3(NWAVES * 64), LDS_BYTES, stream, a); }
#else
    a.ph_lo = 0; a.ph_hi = N_PHASES;
    hipLaunchKernelGGL(fwd_kernel, dim3(grid), dim3(NWAVES * 64), LDS_BYTES, stream, a);
#endif
    const hipError_t le = hipPeekAtLastError();
    if (le != hipSuccess) fprintf(stderr, "kernel_launch: launch failed: %s\n", hipGetErrorName(le));
}
```

```cpp
#include <hip/hip_runtime.h>
#include <cstdio>
#include <cstdint>
#include <cmath>
namespace pg8 {
#define PG8_LAS __attribute__((address_space(3)))
typedef unsigned short bf16_t;
typedef short bf16x8 __attribute__((ext_vector_type(8)));
typedef float f32x4 __attribute__((ext_vector_type(4)));
typedef unsigned u32x4 __attribute__((ext_vector_type(4)));
constexpr int BM = 256, BK = 64, HALF = 128, HTB = HALF * BK * 2  , STAGE_BYTES = 8 * HTB, NXCD = 8, WGM = 8;

__host__ __device__ __forceinline__ int lds_byte(int r, int c) { const int st = (r >> 4) * 2 + (c >> 5), rr = r & 15, cc = c & 31, ob = rr * 64 + cc * 2; return st * 1024 + (ob ^ (((ob >> 9) & 1) << 5)); }
__host__ __device__ __forceinline__ void stage_rc(int b, int& R, int& C) { const int st = b / 1024, sb = b % 1024, swz = sb ^ (((sb >> 9) & 1) << 5); R = (st >> 1) * 16 + swz / 64; C = (st & 1) * 32 + (swz % 64) / 2; }
__host__ __device__ __forceinline__ int perm32(int rho) { const int n = rho >> 4, i = rho & 15; return 8 * (i >> 2) + 4 * n + (i & 3); }

struct Unit { int pm, pn; };
struct Gemm { const bf16_t* A; const bf16_t* Bt; int lda, ldb, K; };

struct StaticOrder {
    int nM, nN, nwg, nX, G, c;
    __host__ __device__ void init(int nM_, int nN_, int nX_, int G_, int c_) { nM = nM_; nN = nN_; nwg = nM * nN; nX = nX_; G = G_; c = c_; }
    __host__ __device__ __forceinline__ bool next(int i, Unit& u) const {
        const long L = (long)i * G + c; if (L >= nwg + nX) return false;
        if (L >= nwg) { u.pm = -1; u.pn = (int)(L - nwg); return true; }
        map((int)L, u); return true;
    }
    __host__ __device__ __forceinline__ void map(int L, Unit& u) const {
        int wgid = L; { const int q = nwg / NXCD, r = nwg % NXCD, xcd = wgid % NXCD, off = wgid / NXCD; wgid = (xcd < r ? xcd * (q + 1) : r * (q + 1) + (xcd - r) * q) + off; }
        const int nig = WGM * nN, gid = wgid / nig, fm = gid * WGM, gsz = (nM - fm) < WGM ? (nM - fm) : WGM;
        u.pm = fm + ((wgid % nig) % gsz); u.pn = (wgid % nig) / gsz;
    }
};

typedef float f32x2_t __attribute__((ext_vector_type(2))); typedef __bf16 bf16x2_t __attribute__((ext_vector_type(2)));
__device__ __forceinline__ unsigned cvt_pk_bf16(float lo, float hi) { const f32x2_t v = {lo, hi}; const bf16x2_t b = __builtin_convertvector(v, bf16x2_t); return __builtin_bit_cast(unsigned, b); }


template <class Epi, class Sched, bool ALIGN_EPI = false, bool SP2 = false>
__device__ __forceinline__ void gemm_phase(PG8_LAS unsigned char* lds, const Gemm g, const Sched& S, const Epi& E, int tid_in) {
    int tid_ = tid_in; asm volatile("" : "+v"(tid_));
    const int tid = tid_, wid = __builtin_amdgcn_readfirstlane(tid >> 6), lane = tid & 63, wr = wid >> 2, wc = wid & 3, fr = lane & 15, fq = lane >> 4;
    const int K = g.K, nt = K / BK;
    unsigned voffA[2], voffB[2];
#pragma unroll
    for (int i = 0; i < 2; ++i) { int R, C; stage_rc(tid * 16 + i * 8192, R, C); const int Rb = Epi::PERM ? ((R & ~31) + perm32(R & 31)) : R;
        voffA[i] = (unsigned)(R * g.lda + C) * 2u; voffB[i] = (unsigned)(Rb * g.ldb + C) * 2u; }
    const size_t kstep = (size_t)(BK * 2);
    const size_t hstepA = (size_t)HALF * g.lda * 2, hstepB = (size_t)HALF * g.ldb * 2;
    const size_t tstepA = 2 * hstepA, tstepB = 2 * hstepB;
    const unsigned ldsw = (unsigned)wid * 1024u;
    const int aoff = lds_byte(wr * 64 + fr, fq * 8), boff = lds_byte(wc * 32 + fr, fq * 8);
#define PG8_SA(b, h) (((b) * 2 + (h)) * HTB)
#define PG8_SB(b, h) ((4 + (b) * 2 + (h)) * HTB)
#define PG8_STAGE(bufoff, gbase, voff) do { _Pragma("unroll") for (int _i = 0; _i < 2; ++_i) \
        __builtin_amdgcn_global_load_lds((const unsigned*)((const char*)(gbase) + (voff)[_i]), (PG8_LAS unsigned*)(lds + (bufoff) + ldsw + _i * 8192), 16, 0, 0); } while (0)
#define PG8_LDA(dst, b, h) do { _Pragma("unroll") for (int m = 0; m < 4; ++m) _Pragma("unroll") for (int k = 0; k < 2; ++k) dst[m][k] = *(const PG8_LAS bf16x8*)(lds + PG8_SA(b, h) + aoff + m * 2048 + k * 1024); } while (0)
#define PG8_LDB(dst, b, h) do { _Pragma("unroll") for (int n = 0; n < 2; ++n) _Pragma("unroll") for (int k = 0; k < 2; ++k) dst[n][k] = *(const PG8_LAS bf16x8*)(lds + PG8_SB(b, h) + boff + n * 2048 + k * 1024); } while (0)
#define PG8_MMA(ai, bj, At, Bt) do { __builtin_amdgcn_s_setprio(1); _Pragma("unroll") for (int m = 0; m < 4; ++m) _Pragma("unroll") for (int n = 0; n < 2; ++n) _Pragma("unroll") for (int k = 0; k < 2; ++k) \
        acc[ai][bj][m][n] = __builtin_amdgcn_mfma_f32_16x16x32_bf16(Bt[n][k], At[m][k], acc[ai][bj][m][n], 0, 0, 0); __builtin_amdgcn_s_setprio(0); } while (0)
#define PG8_WAIT_V(n) asm volatile("s_waitcnt vmcnt(" #n ")" ::: "memory")
#define PG8_WAIT_L(n) asm volatile("s_waitcnt lgkmcnt(" #n ")" ::: "memory")
#define PG8_BAR __builtin_amdgcn_s_barrier()
#define PG8_SCHED __builtin_amdgcn_sched_barrier(0)
    Unit cur, nxt; int ui = 0;
    if (!S.next(0, cur)) return;
    S.fix(cur);
    f32x4 acc[2][2][4][2];
#pragma unroll
    for (int a = 0; a < 2; ++a)
#pragma unroll
        for (int b = 0; b < 2; ++b)
#pragma unroll
            for (int m = 0; m < 4; ++m)
#pragma unroll
                for (int n = 0; n < 2; ++n) acc[a][b][m][n] = (f32x4){0.f, 0.f, 0.f, 0.f};
    bf16x8 At[4][2], B0[2][2], B1[2][2];
    const char* cA = (const char*)g.A + (size_t)cur.pm * tstepA; const char* cB = (const char*)g.Bt + (size_t)cur.pn * tstepB;
    if constexpr (SP2) {
        PG8_STAGE(PG8_SB(0, 0), cB, voffB); PG8_STAGE(PG8_SB(0, 1), cB + hstepB, voffB); PG8_STAGE(PG8_SA(0, 0), cA, voffA); PG8_STAGE(PG8_SA(0, 1), cA + hstepA, voffA);
        if (wr == 1) PG8_BAR;
        PG8_WAIT_V(2); PG8_BAR;
        PG8_STAGE(PG8_SB(1, 0), cB + kstep, voffB); PG8_STAGE(PG8_SA(1, 0), cA + kstep, voffA); PG8_STAGE(PG8_SB(1, 1), cB + hstepB + kstep, voffB);
        PG8_WAIT_V(6); PG8_BAR;
    } else {
        PG8_STAGE(PG8_SB(0, 0), cB, voffB); PG8_STAGE(PG8_SA(0, 0), cA, voffA); PG8_STAGE(PG8_SB(0, 1), cB + hstepB, voffB); PG8_STAGE(PG8_SA(0, 1), cA + hstepA, voffA);
        if (wr == 1) PG8_BAR;
        PG8_WAIT_V(4); PG8_BAR;
        PG8_STAGE(PG8_SB(1, 0), cB + kstep, voffB); PG8_STAGE(PG8_SA(1, 0), cA + kstep, voffA); PG8_STAGE(PG8_SB(1, 1), cB + hstepB + kstep, voffB);
        PG8_WAIT_V(6); PG8_BAR;
    }
    for (;;) {
        bool has_next = S.next(ui + 1, nxt);
        if (has_next) S.fix(nxt);
        const char* nA = has_next ? (const char*)g.A + (size_t)nxt.pm * tstepA : cA; const char* nB = has_next ? (const char*)g.Bt + (size_t)nxt.pn * tstepB : cB;
        for (int t = 0; t < nt; t += 2) {
            const bool last = (t == nt - 2);
            const char* a1 = cA + (size_t)(t + 1) * kstep;
            const char* a2 = last ? nA : cA + (size_t)(t + 2) * kstep; const char* b2 = last ? nB : cB + (size_t)(t + 2) * kstep;
            const char* a3 = a2 + kstep; const char* b3 = b2 + kstep;
            if constexpr (SP2) {
            PG8_LDB(B0, 0, 0); PG8_LDB(B1, 0, 1); PG8_SCHED; PG8_LDA(At, 0, 0); PG8_STAGE(PG8_SA(1, 1), a1 + hstepA, voffA);
            PG8_WAIT_V(8); PG8_WAIT_L(0); PG8_BAR; PG8_MMA(0, 0, At, B0); PG8_MMA(0, 1, At, B1); PG8_BAR; PG8_SCHED;
            PG8_LDA(At, 0, 1); PG8_STAGE(PG8_SB(0, 0), b2, voffB); PG8_STAGE(PG8_SB(0, 1), b2 + hstepB, voffB); PG8_STAGE(PG8_SA(0, 0), a2, voffA);
            PG8_WAIT_V(8); PG8_WAIT_L(0); PG8_BAR; PG8_MMA(1, 0, At, B0); PG8_MMA(1, 1, At, B1); PG8_BAR; PG8_SCHED;
            PG8_LDB(B0, 1, 0); PG8_LDB(B1, 1, 1); PG8_SCHED; PG8_LDA(At, 1, 0); PG8_STAGE(PG8_SA(0, 1), a2 + hstepA, voffA);
            PG8_WAIT_V(8); PG8_WAIT_L(0); PG8_BAR; PG8_MMA(0, 0, At, B0); PG8_MMA(0, 1, At, B1); PG8_BAR; PG8_SCHED;
            PG8_LDA(At, 1, 1); PG8_STAGE(PG8_SB(1, 0), b3, voffB); PG8_STAGE(PG8_SB(1, 1), b3 + hstepB, voffB); PG8_STAGE(PG8_SA(1, 0), a3, voffA);
            PG8_WAIT_V(8); PG8_WAIT_L(0); PG8_BAR; PG8_MMA(1, 0, At, B0); PG8_MMA(1, 1, At, B1); PG8_BAR; PG8_SCHED;
            } else {
            PG8_LDB(B0, 0, 0); PG8_SCHED; PG8_LDA(At, 0, 0); PG8_STAGE(PG8_SA(1, 1), a1 + hstepA, voffA);
            PG8_WAIT_L(8); PG8_BAR; PG8_WAIT_L(0); PG8_MMA(0, 0, At, B0); PG8_BAR; PG8_SCHED;
            PG8_LDB(B1, 0, 1); PG8_STAGE(PG8_SB(0, 0), b2, voffB);
            PG8_BAR; PG8_WAIT_L(0); PG8_MMA(0, 1, At, B1); PG8_BAR;
            PG8_LDA(At, 0, 1); PG8_STAGE(PG8_SA(0, 0), a2, voffA);
            PG8_BAR; PG8_WAIT_L(0); PG8_MMA(1, 0, At, B0); PG8_BAR; PG8_SCHED;
            PG8_STAGE(PG8_SB(0, 1), b2 + hstepB, voffB);
            PG8_WAIT_V(6); PG8_BAR; PG8_MMA(1, 1, At, B1); PG8_BAR;
            PG8_LDB(B0, 1, 0); PG8_SCHED; PG8_LDA(At, 1, 0); PG8_STAGE(PG8_SA(0, 1), a2 + hstepA, voffA);
            PG8_WAIT_L(8); PG8_BAR; PG8_WAIT_L(0); PG8_MMA(0, 0, At, B0); PG8_BAR; PG8_SCHED;
            PG8_LDB(B1, 1, 1); PG8_STAGE(PG8_SB(1, 0), b3, voffB);
            PG8_BAR; PG8_WAIT_L(0); PG8_MMA(0, 1, At, B1); PG8_BAR;
            PG8_LDA(At, 1, 1); PG8_STAGE(PG8_SA(1, 0), a3, voffA);
            PG8_BAR; PG8_WAIT_L(0); PG8_MMA(1, 0, At, B0); PG8_BAR; PG8_SCHED;
            PG8_STAGE(PG8_SB(1, 1), b3 + hstepB, voffB);
            PG8_WAIT_V(6); PG8_BAR; PG8_MMA(1, 1, At, B1); PG8_BAR;
            }
        }
        if constexpr (ALIGN_EPI) { if (wr == 0) PG8_BAR; }
        E(acc, cur, wr, wc, fr, fq);
        if (!has_next) break;
#pragma unroll
        for (int a = 0; a < 2; ++a)
#pragma unroll
            for (int b = 0; b < 2; ++b)
#pragma unroll
                for (int m = 0; m < 4; ++m)
#pragma unroll
                    for (int n = 0; n < 2; ++n) acc[a][b][m][n] = (f32x4){0.f, 0.f, 0.f, 0.f};
        cur = nxt; cA = nA; cB = nB; ++ui;
        if constexpr (ALIGN_EPI) { if (wr == 1) PG8_BAR; }
    }
    PG8_WAIT_V(0);
    if constexpr (!ALIGN_EPI) { if (wr == 0) PG8_BAR; }
    PG8_BAR;
#undef PG8_SA
#undef PG8_SB
#undef PG8_STAGE
#undef PG8_LDA
#undef PG8_LDB
#undef PG8_MMA
#undef PG8_WAIT_V
#undef PG8_WAIT_L
#undef PG8_BAR
#undef PG8_SCHED
}
}
constexpr int D_MODEL = 4096, BATCH = 4, SEQ = 4096, M_TOK = BATCH * SEQ, N_MEM = 256, M_MEM = BATCH * N_MEM;
constexpr int A_IN = 6720, A_LDP = 6912, B_IN = 9216;
constexpr int A_OFF_CQ = 0, A_OFF_CKV = 1024, A_OFF_KR = 1536, A_OFF_XQ = 1600, A_OFF_Z = 2624;
constexpr int B_OFF_Q = 0, B_OFF_K = 3072, B_OFF_V = 3584, B_OFF_XQ = 4096, B_OFF_Z = 5120;
constexpr int QW = 4608, KVW = 6144;
constexpr float LOG2E = 1.4426950408889634f;
constexpr float C2_MLA = 0.07216878364870322f * LOG2E;
constexpr float C2_SWA = 0.125f * LOG2E;
constexpr float C2_MEM = 0.0625f * LOG2E;
constexpr float EPS = 1e-6f;

namespace pg8 {
__device__ __forceinline__ float silu_f(float z) { return z * __builtin_amdgcn_rcpf(1.0f + __builtin_amdgcn_exp2f(-z * LOG2E)); }
__device__ __forceinline__ void store8(bf16_t* p, f32x4 v0, f32x4 v1) {
    u32x4 w; w.x = cvt_pk_bf16(v0[0], v0[1]); w.y = cvt_pk_bf16(v0[2], v0[3]); w.z = cvt_pk_bf16(v1[0], v1[1]); w.w = cvt_pk_bf16(v1[2], v1[3]); *(u32x4*)p = w;
}
__device__ __forceinline__ void rope8(f32x4& v0, f32x4& v1, const f32x4 cs, const f32x4 sn) {
    float a, b;
    a = v0[0]; b = v0[1]; v0[0] = a * cs[0] - b * sn[0]; v0[1] = b * cs[0] + a * sn[0];
    a = v0[2]; b = v0[3]; v0[2] = a * cs[1] - b * sn[1]; v0[3] = b * cs[1] + a * sn[1];
    a = v1[0]; b = v1[1]; v1[0] = a * cs[2] - b * sn[2]; v1[1] = b * cs[2] + a * sn[2];
    a = v1[2]; b = v1[3]; v1[2] = a * cs[3] - b * sn[3]; v1[3] = b * cs[3] + a * sn[3];
}

__device__ __forceinline__ float rr_slow(const float* p, int n, float inv) { float s = 0.f;
#pragma unroll 1
    for (int i = 0; i < n; ++i) s += p[i];
    return 1.0f / sqrtf(s * inv + EPS); }
struct EpiAin {
    static constexpr bool PERM = true;
    bf16_t* proj;
    bf16_t* mkv;
    const float* cosT; const float* sinT;
    const float* rr;
    const PG8_LAS float* rrl; int pmc;
    float* part;
    __device__ __forceinline__ void operator()(const f32x4 (&acc)[2][2][4][2], const Unit& u, int wr, int wc, int fr, int fq) const {
        if (u.pn >= 27) {
            const int l = (u.pn - 27) >> 3, ct = (u.pn - 27) & 7;
            bf16_t* base = mkv + (size_t)l * M_MEM * 2048;
            int opq = 0; asm volatile("" : "+v"(opq));
            const int row0 = (u.pm - 64) * BM + wr * 64 + fr + opq, col0 = ct * BM + wc * 32 + 8 * fq;
#pragma unroll
            for (int ai = 0; ai < 2; ++ai)
#pragma unroll
                for (int m = 0; m < 4; ++m) { bf16_t* rowp = base + (size_t)(row0 + ai * HALF + m * 16) * 2048 + col0;
#pragma unroll
                    for (int bj = 0; bj < 2; ++bj) store8(rowp + bj * HALF, acc[ai][bj][m][0], acc[ai][bj][m][1]); }
            return;
        }
        int opq = 0; asm volatile("" : "+v"(opq));
        const int lrow0 = wr * 64 + fr + opq, row0 = u.pm * BM + lrow0;
#pragma unroll
        for (int bj = 0; bj < 2; ++bj) {
            const int cw = u.pn * BM + bj * HALF + wc * 32;
            if (cw >= A_IN) continue;
            const int col0 = cw + 8 * fq;
            const int cls = cw < A_OFF_KR ? 0 : (cw < A_OFF_XQ ? 1 : (cw < A_OFF_Z ? 2 : 3));
#pragma unroll
            for (int ai = 0; ai < 2; ++ai)
#pragma unroll
                for (int m = 0; m < 4; ++m) { const int row = row0 + ai * HALF + m * 16; const float r = (u.pm == pmc) ? rrl[lrow0 + ai * HALF + m * 16] : rr[row];
                    f32x4 v0 = acc[ai][bj][m][0] * r, v1 = acc[ai][bj][m][1] * r;
                    if (cls == 0) { float ss = ((v0[0] * v0[0] + v0[1] * v0[1]) + (v0[2] * v0[2] + v0[3] * v0[3])) + ((v1[0] * v1[0] + v1[1] * v1[1]) + (v1[2] * v1[2] + v1[3] * v1[3]));
                        { const int ln = fr + 16 * fq;
                          ss += __builtin_bit_cast(float, __builtin_amdgcn_ds_bpermute((ln ^ 16) << 2, __builtin_bit_cast(int, ss)));
                          ss += __builtin_bit_cast(float, __builtin_amdgcn_ds_bpermute((ln ^ 32) << 2, __builtin_bit_cast(int, ss))); }
                        if (fq == 0) part[(size_t)row * 48 + (cw >> 5)] = ss; }
                    if (cls == 1) { const int i0 = (col0 - A_OFF_KR) >> 1;
                        const f32x4 cs = *(const f32x4*)(cosT + (size_t)row * 32 + i0), sn = *(const f32x4*)(sinT + (size_t)row * 32 + i0);
                        rope8(v0, v1, cs, sn); }
                    else if (cls == 2) { v0 = v0 * C2_MEM; v1 = v1 * C2_MEM; }
                    else if (cls == 3) {
#pragma unroll
                        for (int e = 0; e < 4; ++e) { v0[e] = silu_f(v0[e]); v1[e] = silu_f(v1[e]); } }
                    store8(proj + (size_t)row * A_LDP + col0, v0, v1); }
        }
    }
};
struct EpiBin {
    static constexpr bool PERM = true;
    bf16_t* proj;
    const float* rr; const PG8_LAS float* rrl; int pmc;
    __device__ __forceinline__ void operator()(const f32x4 (&acc)[2][2][4][2], const Unit& u, int wr, int wc, int fr, int fq) const {
        int opq = 0; asm volatile("" : "+v"(opq));
        const int lrow0 = wr * 64 + fr + opq, row0 = u.pm * BM + lrow0, col0 = u.pn * BM + wc * 32 + 8 * fq;
        const int cls = u.pn < 12 ? 0 : (u.pn < 16 ? 1 : (u.pn < 20 ? 2 : 3));
#pragma unroll
        for (int ai = 0; ai < 2; ++ai)
#pragma unroll
            for (int m = 0; m < 4; ++m) { const int row = row0 + ai * HALF + m * 16; bf16_t* rowp = proj + (size_t)row * B_IN + col0;
                const float r = (u.pm == pmc) ? rrl[lrow0 + ai * HALF + m * 16] : rr[row], rs = cls == 0 ? r * C2_SWA : (cls == 2 ? r * C2_MEM : r);
#pragma unroll
                for (int bj = 0; bj < 2; ++bj) { f32x4 v0 = acc[ai][bj][m][0] * rs, v1 = acc[ai][bj][m][1] * rs;
                    if (cls == 3) {
#pragma unroll
                        for (int e = 0; e < 4; ++e) { v0[e] = silu_f(v0[e]); v1[e] = silu_f(v1[e]); } }
                    store8(rowp + bj * HALF, v0, v1); } }
    }
};
struct EpiQ {
    static constexpr bool PERM = true;
    bf16_t* q;
    const float* cosT; const float* sinT;
    const float* part; const PG8_LAS float* rrl; int pmc;
    __device__ __forceinline__ void operator()(const f32x4 (&acc)[2][2][4][2], const Unit& u, int wr, int wc, int fr, int fq) const {
        int opq = 0; asm volatile("" : "+v"(opq));
        const int lrow0 = wr * 64 + fr + opq, row0 = u.pm * BM + lrow0;
#pragma unroll
        for (int bj = 0; bj < 2; ++bj) {
            const int cw = u.pn * BM + bj * HALF + wc * 32, hc = cw % 192;
            const int col0 = cw + 8 * fq;
            const bool rope = hc >= 128;
            const int i0 = (hc - 128 + 8 * fq) >> 1;
#pragma unroll
            for (int ai = 0; ai < 2; ++ai)
#pragma unroll
                for (int m = 0; m < 4; ++m) { const int row = row0 + ai * HALF + m * 16;
                    const float r = C2_MLA * ((u.pm == pmc) ? rrl[lrow0 + ai * HALF + m * 16] : rr_slow(part + (size_t)row * 48, 32, 1.f / 1024.f));
                    f32x4 v0 = acc[ai][bj][m][0] * r, v1 = acc[ai][bj][m][1] * r;
                    if (rope) { const f32x4 cs = *(const f32x4*)(cosT + (size_t)row * 32 + i0), sn = *(const f32x4*)(sinT + (size_t)row * 32 + i0);
                        rope8(v0, v1, cs, sn); }
                    store8(q + (size_t)row * QW + col0, v0, v1); }
        }
    }
};
struct EpiPlain {
    static constexpr bool PERM = true;
    bf16_t* o; int ldc;
    __device__ __forceinline__ void operator()(const f32x4 (&acc)[2][2][4][2], const Unit& u, int wr, int wc, int fr, int fq) const {
        int opq = 0; asm volatile("" : "+v"(opq));
        const int row0 = u.pm * BM + wr * 64 + fr + opq, col0 = u.pn * BM + wc * 32 + 8 * fq;
#pragma unroll
        for (int ai = 0; ai < 2; ++ai)
#pragma unroll
            for (int m = 0; m < 4; ++m) { bf16_t* rowp = o + (size_t)(row0 + ai * HALF + m * 16) * ldc + col0;
#pragma unroll
                for (int bj = 0; bj < 2; ++bj) store8(rowp + bj * HALF, acc[ai][bj][m][0], acc[ai][bj][m][1]); }
    }
};
struct EpiKV {
    static constexpr bool PERM = true;
    bf16_t* o;
    const float* part; const PG8_LAS float* rrl; int pmc;
    __device__ __forceinline__ void operator()(const f32x4 (&acc)[2][2][4][2], const Unit& u, int wr, int wc, int fr, int fq) const {
        int opq = 0; asm volatile("" : "+v"(opq));
        const int lrow0 = wr * 64 + fr + opq, row0 = u.pm * BM + lrow0, col0 = u.pn * BM + wc * 32 + 8 * fq;
#pragma unroll
        for (int ai = 0; ai < 2; ++ai)
#pragma unroll
            for (int m = 0; m < 4; ++m) { const int row = row0 + ai * HALF + m * 16; bf16_t* rowp = o + (size_t)row * KVW + col0;
                const float r = (u.pm == pmc) ? rrl[lrow0 + ai * HALF + m * 16] : rr_slow(part + (size_t)row * 48 + 32, 16, 1.f / 512.f);
#pragma unroll
                for (int bj = 0; bj < 2; ++bj) store8(rowp + bj * HALF, acc[ai][bj][m][0] * r, acc[ai][bj][m][1] * r); }
    }
};
struct SchedKV { StaticOrder o;
    __device__ __forceinline__ bool next(int i, Unit& u) const {
        if (o.G != 256) return o.next(i, u);
        int L; if (i < 5) L = i * 256 + o.c; else if (o.c >= 128 && i < 7) L = 1280 + (i - 5) * 128 + (o.c - 128); else return false;
        o.map(L, u); return true; }
    __device__ __forceinline__ void fix(Unit&) const {} };
struct SchedRange { StaticOrder o; int i0, n;
    __device__ __forceinline__ bool next(int i, Unit& u) const { return i < n && o.next(i0 + i, u); } __device__ __forceinline__ void fix(Unit&) const {} };
struct SchedPlain { StaticOrder o; __device__ __forceinline__ bool next(int i, Unit& u) const { return o.next(i, u); } __device__ __forceinline__ void fix(Unit&) const {} };
struct SchedAin { StaticOrder o; __device__ __forceinline__ bool next(int i, Unit& u) const { return o.next(i, u); }
    __device__ __forceinline__ void fix(Unit& u) const { if (u.pm < 0) { const int e = u.pn, l = e >> 5, r = e & 31; u.pm = 64 + (r >> 3); u.pn = 27 + l * 8 + (r & 7); } } };
}
namespace att {
#define ATT_LAS __attribute__((address_space(3)))
typedef unsigned short bf16_t;
typedef short bf16x8 __attribute__((ext_vector_type(8)));
typedef short s16x4 __attribute__((ext_vector_type(4)));
typedef float f32x16 __attribute__((ext_vector_type(16)));
typedef float f32x4 __attribute__((ext_vector_type(4)));
typedef unsigned u32x4 __attribute__((ext_vector_type(4)));
#define ATT_SBAR() __builtin_amdgcn_sched_barrier(0)
constexpr float THR2 = 8.0f;

template <int DQK> __device__ __forceinline__ int kswz(int row, int chunk) {
    const int sw = (DQK == 256 || DQK == 128) ? (row & 15) : ((row >> 1) & 7);
    return row * (DQK * 2) + ((chunk ^ sw) << 4);
}
template <int DV> __device__ __forceinline__ int v_st(int k, int c) { constexpr int NCB = DV / 32; const int kk = (k & ~0xC) | ((k & 4) << 1) | ((k & 8) >> 1); return ((kk >> 3) * NCB + (c >> 5)) * 512 + ((kk & 7) * 32 + (c & 31)) * 2; }
__device__ __forceinline__ int v_rd_base(int lane) { return ((lane & 3) << 3) | (((lane >> 2) & 3) << 6) | (((lane >> 4) & 1) << 5) | (((lane >> 5) & 1) << 8); }
__device__ __forceinline__ int crow(int r, int hi) { return (r & 3) + 8 * (r >> 2) + 4 * hi; }
__device__ __forceinline__ unsigned cvtpk(float lo, float hi) { return pg8::cvt_pk_bf16(lo, hi); }
__device__ __forceinline__ const char* uptr(const char* p) { const unsigned long long v = (unsigned long long)(uintptr_t)p;
    unsigned lo = __builtin_amdgcn_readfirstlane((unsigned)v), hi = __builtin_amdgcn_readfirstlane((unsigned)(v >> 32)); asm volatile("" : "+s"(lo), "+s"(hi));
    return (const char*)(uintptr_t)(((unsigned long long)hi << 32) | lo); }
__device__ __forceinline__ float bf2f(bf16_t v) { return __uint_as_float(((unsigned)v) << 16); }

__device__ __forceinline__ void softmax_exp(f32x16& p0, f32x16& p1, float& m_reg, float& alpha) {
    float pmax = p0[0];
#pragma unroll
    for (int r = 1; r < 16; ++r) pmax = fmaxf(pmax, p0[r]);
#pragma unroll
    for (int r = 0; r < 16; ++r) pmax = fmaxf(pmax, p1[r]);
    { auto rr = __builtin_amdgcn_permlane32_swap(__float_as_uint(pmax), __float_as_uint(pmax), false, false);
      pmax = fmaxf(__uint_as_float(rr[0]), __uint_as_float(rr[1])); }
    float mn;
    if (__builtin_expect(__all(pmax - m_reg <= THR2), 1)) { mn = m_reg; alpha = 1.f; }
    else { mn = fmaxf(m_reg, pmax); alpha = __builtin_amdgcn_exp2f(m_reg - mn); m_reg = mn; }
#pragma unroll
    for (int r = 0; r < 16; ++r) p0[r] = __builtin_amdgcn_exp2f(p0[r] - mn);
#pragma unroll
    for (int r = 0; r < 16; ++r) p1[r] = __builtin_amdgcn_exp2f(p1[r] - mn);
}
__device__ __forceinline__ void softmax_pack(const f32x16& p0, const f32x16& p1, float alpha, float& l_reg, bf16x8& pa0, bf16x8& pa1, bf16x8& pa2, bf16x8& pa3) {
    float ps = 0.f;
    { float s0 = p0[0] + p0[1], s1 = p0[2] + p0[3], s2 = p1[0] + p1[1], s3 = p1[2] + p1[3];
#pragma unroll
      for (int r = 4; r < 16; r += 4) { s0 += p0[r] + p0[r + 1]; s1 += p0[r + 2] + p0[r + 3]; s2 += p1[r] + p1[r + 1]; s3 += p1[r + 2] + p1[r + 3]; }
      ps = (s0 + s1) + (s2 + s3); }
    { auto rr = __builtin_amdgcn_permlane32_swap(__float_as_uint(ps), __float_as_uint(ps), false, false);
      ps = __uint_as_float(rr[0]) + __uint_as_float(rr[1]); }
    l_reg = l_reg * alpha + ps;
#define ATT_PK4(P, B_, OUT) do { unsigned a0 = cvtpk(P[B_+0], P[B_+1]), a1 = cvtpk(P[B_+2], P[B_+3]);                          \
        unsigned b0 = cvtpk(P[B_+4], P[B_+5]), b1 = cvtpk(P[B_+6], P[B_+7]);                                             \
        auto r0 = __builtin_amdgcn_permlane32_swap(a0, b0, false, false); auto r1 = __builtin_amdgcn_permlane32_swap(a1, b1, false, false); \
        u32x4 w = {r0[0], r1[0], r0[1], r1[1]}; OUT = __builtin_bit_cast(bf16x8, w); } while (0)
    ATT_PK4(p0, 0, pa0); ATT_PK4(p0, 8, pa1); ATT_PK4(p1, 0, pa2); ATT_PK4(p1, 8, pa3);
#undef ATT_PK4
}
template <int DQK, int GD, bool ZERO = true>
__device__ __forceinline__ void qkt(f32x16& p0, f32x16& p1, const ATT_LAS char* Kb, int r32, int hi, const bf16x8* qr) {
    constexpr int ND = DQK / 16, NG = ND / GD; static_assert(ND % GD == 0, "qkt group size");
    if constexpr (ZERO) { p0 = f32x16{}; p1 = f32x16{}; }
    const ATT_LAS char* kb[4];
#pragma unroll
    for (int dd = 0; dd < 4; ++dd) kb[dd] = Kb + kswz<DQK>(r32, dd * 2 + hi);
    bf16x8 fa[2][GD], fb[2][GD];
#define ATT_KLD(G_, B_) do { _Pragma("unroll") for (int i_ = 0; i_ < GD; ++i_) { const int d0_ = (G_) * GD + i_; \
        const ATT_LAS char* a_ = (DQK >= 128) ? (const ATT_LAS char*)(((unsigned)(uintptr_t)kb[d0_ & 3] ^ (unsigned)(((d0_ >> 2) & 1) << 7))) + (d0_ >> 3) * 256 : kb[d0_ & 3] + (d0_ >> 2) * 128;     \
        fa[B_][i_] = *(const ATT_LAS bf16x8*)(a_); fb[B_][i_] = *(const ATT_LAS bf16x8*)(a_ + 32 * DQK * 2); } } while (0)
    ATT_KLD(0, 0);
#pragma unroll
    for (int g = 0; g < NG; ++g) {
        if (g + 1 < NG) { if ((g & 1) == 0) ATT_KLD(g + 1, 1); else ATT_KLD(g + 1, 0); }
        ATT_SBAR();
#pragma unroll
        for (int i = 0; i < GD; ++i) {
            p0 = __builtin_amdgcn_mfma_f32_32x32x16_bf16(fa[g & 1][i], qr[g * GD + i], p0, 0, 0, 0);
            p1 = __builtin_amdgcn_mfma_f32_32x32x16_bf16(fb[g & 1][i], qr[g * GD + i], p1, 0, 0, 0); }
        ATT_SBAR();
    }
#undef ATT_KLD
}
template <int DV, int VOFF>
__device__ __forceinline__ void pv_tile(f32x16* o, int vb0, bf16x8 pa0, bf16x8 pa1, bf16x8 pa2, bf16x8 pa3) {
    constexpr int NCB = DV / 32, KS = NCB * 1024, HF = NCB * 512;
#define ATT_TRRD(dst, off) asm volatile("ds_read_b64_tr_b16 %0, %1 offset:%2" : "=&v"(dst) : "v"(vb0), "i"(off) : "memory")
#define ATT_VLD(B_, D_) do { constexpr int b_ = VOFF + (D_) * 512; \
        ATT_TRRD(vl[B_][0], b_); ATT_TRRD(vh[B_][0], b_ + HF); ATT_TRRD(vl[B_][1], b_ + KS); ATT_TRRD(vh[B_][1], b_ + KS + HF); \
        ATT_TRRD(vl[B_][2], b_ + 2 * KS); ATT_TRRD(vh[B_][2], b_ + 2 * KS + HF); ATT_TRRD(vl[B_][3], b_ + 3 * KS); ATT_TRRD(vh[B_][3], b_ + 3 * KS + HF); } while (0)
#define ATT_VFR(B_, k_) (bf16x8){vl[B_][k_][0], vl[B_][k_][1], vl[B_][k_][2], vl[B_][k_][3], vh[B_][k_][0], vh[B_][k_][1], vh[B_][k_][2], vh[B_][k_][3]}
#define ATT_PVD(B_, D_) do { o[D_] = __builtin_amdgcn_mfma_f32_32x32x16_bf16(pa0, ATT_VFR(B_, 0), o[D_], 0, 0, 0); o[D_] = __builtin_amdgcn_mfma_f32_32x32x16_bf16(pa1, ATT_VFR(B_, 1), o[D_], 0, 0, 0); \
        o[D_] = __builtin_amdgcn_mfma_f32_32x32x16_bf16(pa2, ATT_VFR(B_, 2), o[D_], 0, 0, 0); o[D_] = __builtin_amdgcn_mfma_f32_32x32x16_bf16(pa3, ATT_VFR(B_, 3), o[D_], 0, 0, 0); } while (0)
    s16x4 vl[2][4], vh[2][4];
    ATT_VLD(0, 0);
    if constexpr (NCB == 2) {
        ATT_VLD(1, 1); asm volatile("s_waitcnt lgkmcnt(8)" ::: "memory"); ATT_SBAR(); ATT_PVD(0, 0);
        asm volatile("s_waitcnt lgkmcnt(0)" ::: "memory"); ATT_SBAR(); ATT_PVD(1, 1);
    } else {
        static_assert(NCB == 4 || NCB == 2, "pv_tile: DV is 64 or 128");
        ATT_VLD(1, 1); asm volatile("s_waitcnt lgkmcnt(8)" ::: "memory"); ATT_SBAR(); ATT_PVD(0, 0); ATT_SBAR();
        ATT_VLD(0, 2); asm volatile("s_waitcnt lgkmcnt(8)" ::: "memory"); ATT_SBAR(); ATT_PVD(1, 1); ATT_SBAR();
        ATT_VLD(1, 3); asm volatile("s_waitcnt lgkmcnt(8)" ::: "memory"); ATT_SBAR(); ATT_PVD(0, 2); ATT_SBAR();
        asm volatile("s_waitcnt lgkmcnt(0)" ::: "memory"); ATT_SBAR(); ATT_PVD(1, 3);
    }
#undef ATT_TRRD
#undef ATT_VLD
#undef ATT_VFR
#undef ATT_PVD
}

template <int DV>
__device__ __forceinline__ void epilogue_rows(const f32x16* o, float l_reg, ATT_LAS float* li_l, ATT_LAS char* stg, const bf16_t* Gw, int ldg, bf16_t* Yw, int ldy, int lane) {
    constexpr int NCB = DV / 32, RS = DV * 2 + 16, CH = DV / 8, RPP = 64 / CH, NP = 32 / RPP;
    const int r32 = lane & 31, hi = lane >> 5;
    if (hi == 0) li_l[r32] = l_reg;
    asm volatile("s_waitcnt lgkmcnt(0)" ::: "memory");
#pragma unroll
    for (int r = 0; r < 16; ++r) { const int orow = crow(r, hi); const float rl = __builtin_amdgcn_rcpf(li_l[orow]);
#pragma unroll
        for (int d0 = 0; d0 < NCB; ++d0) { const unsigned w = cvtpk(o[d0][r] * rl, 0.f); *(ATT_LAS unsigned short*)(stg + orow * RS + (d0 * 32 + r32) * 2) = (unsigned short)w; } }
    asm volatile("s_waitcnt lgkmcnt(0)" ::: "memory");
    int opq = 0; asm volatile("" : "+v"(opq));
#pragma unroll
    for (int i = 0; i < NP; ++i) { const int row = i * RPP + lane / CH + opq, ch = lane % CH;
        const u32x4 ov = *(const ATT_LAS u32x4*)(stg + row * RS + ch * 16);
        const u32x4 gv = *(const u32x4*)(Gw + (size_t)row * ldg + ch * 8);
        u32x4 yv;
#pragma unroll
        for (int e = 0; e < 4; ++e) { const float a0 = __uint_as_float(ov[e] << 16) * __uint_as_float(gv[e] << 16), a1 = __uint_as_float(ov[e] & 0xffff0000u) * __uint_as_float(gv[e] & 0xffff0000u); yv[e] = cvtpk(a0, a1); }
        *(u32x4*)(Yw + (size_t)row * ldy + ch * 8) = yv; }
}

template <int DV>
__device__ __forceinline__ void gate_prefetch(u32x4 (&gv)[32 / (64 / (DV / 8))], const bf16_t* Gw, int ldg, int lane) {
    constexpr int CH = DV / 8, RPP = 64 / CH, NP = 32 / RPP;
#pragma unroll
    for (int i = 0; i < NP; ++i) { const int row = i * RPP + lane / CH, ch = lane % CH; gv[i] = *(const u32x4*)(Gw + (size_t)row * ldg + ch * 8); }
}
template <int DV>
__device__ __forceinline__ void epilogue_rows_pre(const f32x16* o, float l_reg, ATT_LAS float* li_l, ATT_LAS char* stg, const u32x4 (&gv)[32 / (64 / (DV / 8))], bf16_t* Yw, int ldy, int lane) {
    constexpr int NCB = DV / 32, RS = DV * 2 + 16, CH = DV / 8, RPP = 64 / CH, NP = 32 / RPP;
    const int r32 = lane & 31, hi = lane >> 5;
    if (hi == 0) li_l[r32] = l_reg;
    asm volatile("s_waitcnt lgkmcnt(0)" ::: "memory");
#pragma unroll
    for (int r = 0; r < 16; ++r) { const int orow = crow(r, hi); const float rl = __builtin_amdgcn_rcpf(li_l[orow]);
#pragma unroll
        for (int d0 = 0; d0 < NCB; ++d0) { const unsigned w = cvtpk(o[d0][r] * rl, 0.f); *(ATT_LAS unsigned short*)(stg + orow * RS + (d0 * 32 + r32) * 2) = (unsigned short)w; } }
    asm volatile("s_waitcnt lgkmcnt(0)" ::: "memory");
    int opq = 0; asm volatile("" : "+v"(opq));
#pragma unroll
    for (int i = 0; i < NP; ++i) { const int row = i * RPP + lane / CH + opq, ch = lane % CH;
        const u32x4 ov = *(const ATT_LAS u32x4*)(stg + row * RS + ch * 16);
        u32x4 yv;
#pragma unroll
        for (int e = 0; e < 4; ++e) { const float a0 = __uint_as_float(ov[e] << 16) * __uint_as_float(gv[i][e] << 16), a1 = __uint_as_float(ov[e] & 0xffff0000u) * __uint_as_float(gv[i][e] & 0xffff0000u); yv[e] = cvtpk(a0, a1); }
        *(u32x4*)(Yw + (size_t)row * ldy + ch * 8) = yv; }
}

__device__ __forceinline__ void mla_core_dma(ATT_LAS char* lds, const bf16_t* Qw, int ldq, const bf16_t* K0, int ldk0, const bf16_t* K1, int ldk1, const bf16_t* V, int ldv,
        int NT, int qpos0, const bf16_t* Gw, int ldg, bf16_t* Yw, int ldy, int tid_in) {
    constexpr int DQK = 192, DV = 128, NCB = 4, VBY = 16384, KBY = 24576, K_OFF = 2 * VBY, WS_OFF = K_OFF + 2 * KBY, ROPE = 16384;
    int tid_ = tid_in; asm volatile("" : "+v"(tid_));
    const int tid = tid_, wid = __builtin_amdgcn_readfirstlane(tid >> 6), lane = tid & 63, r32 = lane & 31, hi = lane >> 5;
    ATT_LAS float* ws = (ATT_LAS float*)(lds + WS_OFF) + wid * 64; ATT_LAS float* li_l = ws; ATT_LAS float* al_l = ws + 32;
    const int vb0 = (int)(unsigned)(uintptr_t)lds + v_rd_base(lane);
    unsigned sn0, sr0, sv0;
    { const int row = 4 * wid + (lane >> 4), cp = lane & 15, ch = cp ^ (row & 15);
      sn0 = (unsigned)(row * ldk0 + ch * 8) * 2u; }
    { const int row = 8 * wid + (lane >> 3), cp = lane & 7, ch = cp ^ ((row >> 1) & 7);
      sr0 = (unsigned)(row * ldk1 + ch * 8) * 2u; }
    { const int st = 2 * wid + (lane >> 5), kkh = st >> 2, cb = st & 3, q = (lane & 31) >> 2, c = cb * 32 + (lane & 3) * 8;
      const int kk = kkh * 8 + q, k = (kk & ~0xC) | ((kk & 4) << 1) | ((kk & 8) >> 1);
      sv0 = (unsigned)(k * ldv + c) * 2u; }
    const size_t stepK0 = (size_t)64 * ldk0 * 2, stepK1 = (size_t)64 * ldk1 * 2, stepV = (size_t)64 * ldv * 2;
    const unsigned ldsw = (unsigned)wid * 1024u;
#define MLA_DMA(BUF, t_) do { const char* kb0_ = uptr((const char*)K0 + (size_t)(t_) * stepK0); const char* kb0b_ = uptr((const char*)K0 + (size_t)(t_) * stepK0 + (size_t)64 * ldk0); \
        const char* kb1_ = uptr((const char*)K1 + (size_t)(t_) * stepK1); const char* vb_ = uptr((const char*)V + (size_t)(t_) * stepV); const char* vbb_ = uptr((const char*)V + (size_t)(t_) * stepV + (size_t)64 * ldv); \
        unsigned sn0_ = sn0, sr0_ = sr0, sv0_ = sv0; asm volatile("" : "+v"(sn0_), "+v"(sr0_), "+v"(sv0_));     \
        __builtin_amdgcn_global_load_lds((const unsigned*)(kb0_ + sn0_), (ATT_LAS unsigned*)(lds + K_OFF + (BUF) * KBY + ldsw), 16, 0, 0); \
        __builtin_amdgcn_global_load_lds((const unsigned*)(kb0b_ + sn0_), (ATT_LAS unsigned*)(lds + K_OFF + (BUF) * KBY + 8192 + ldsw), 16, 0, 0); \
        __builtin_amdgcn_global_load_lds((const unsigned*)(kb1_ + sr0_), (ATT_LAS unsigned*)(lds + K_OFF + (BUF) * KBY + ROPE + ldsw), 16, 0, 0); \
        __builtin_amdgcn_global_load_lds((const unsigned*)(vb_ + sv0_), (ATT_LAS unsigned*)(lds + (BUF) * VBY + ldsw), 16, 0, 0); \
        __builtin_amdgcn_global_load_lds((const unsigned*)(vbb_ + sv0_), (ATT_LAS unsigned*)(lds + (BUF) * VBY + 8192 + ldsw), 16, 0, 0); } while (0)
    MLA_DMA(0, 0);
    bf16x8 qr[DQK / 16];
    { const char* qb_ = uptr((const char*)Qw); unsigned qo_ = (unsigned)(r32 * ldq + hi * 8) * 2u; asm volatile("" : "+v"(qo_));
#pragma unroll
      for (int d0 = 0; d0 < DQK / 16; ++d0) qr[d0] = *(const __attribute__((address_space(1))) bf16x8*)(uintptr_t)(qb_ + qo_ + d0 * 32); }
    float m_reg = -1e30f, l_reg = 0.f; f32x16 o[NCB];
    { float z_ = 0.f; asm volatile("" : "+v"(z_));
#pragma unroll
      for (int d = 0; d < NCB; ++d)
#pragma unroll
          for (int r = 0; r < 16; ++r) o[d][r] = z_; }
    asm volatile("s_waitcnt vmcnt(0)" ::: "memory");
    __syncthreads();
    const int qm = qpos0 + r32 - 4 * hi;
    const int kn0 = r32 * 256 + ((hi ^ (r32 & 15)) << 4), kr0 = ROPE + r32 * 128 + ((hi ^ ((r32 >> 1) & 7)) << 4);
#define MLA_KA(d0) ((d0) < 8 ? (kn0 ^ ((((d0) & 3) << 5) | (((d0) >> 2) << 7))) : (kr0 ^ (((d0) - 8) << 5)))
#define MLA_KH(d0) ((d0) < 8 ? 8192 : 4096)
#define MLA_KLD(G_, B_) do { _Pragma("unroll") for (int i_ = 0; i_ < 4; ++i_) { const int d0_ = (G_) * 4 + i_; \
        fa[B_][i_] = *(const ATT_LAS bf16x8*)(Kb_ + MLA_KA(d0_)); fb[B_][i_] = *(const ATT_LAS bf16x8*)(Kb_ + MLA_KA(d0_) + MLA_KH(d0_)); } } while (0)
#define MLA_QKT(BUF) do { const ATT_LAS char* Kb_ = lds + K_OFF + (BUF) * KBY; bf16x8 fa[2][4], fb[2][4]; p0 = f32x16{}; p1 = f32x16{}; \
        MLA_KLD(0, 0); \
        _Pragma("unroll") for (int g = 0; g < 3; ++g) { \
            if (g + 1 < 3) { if ((g & 1) == 0) MLA_KLD(g + 1, 1); else MLA_KLD(g + 1, 0); } \
            ATT_SBAR(); \
            _Pragma("unroll") for (int i = 0; i < 4; ++i) { p0 = __builtin_amdgcn_mfma_f32_32x32x16_bf16(fa[g & 1][i], qr[g * 4 + i], p0, 0, 0, 0); p1 = __builtin_amdgcn_mfma_f32_32x32x16_bf16(fb[g & 1][i], qr[g * 4 + i], p1, 0, 0, 0); } \
            ATT_SBAR(); } } while (0)
#define MLA_STEP(BF, t, GATE) do { \
        const int kb_ = (t) * 64; \
        if ((t) + 1 < NT) MLA_DMA(1 - (BF), (t) + 1); \
        ATT_SBAR(); \
        if (kb_ <= qpos0 + 31) {                                                 \
        f32x16 p0, p1; \
        MLA_QKT(BF); \
        GATE; \
        if (kb_ + 63 > qpos0) { const int dq = qm - kb_; const float NEG = -__builtin_inff(); \
            _Pragma("unroll") for (int r = 0; r < 16; ++r) { const int c = (r & 3) + 8 * (r >> 2); if (dq - c < 0) p0[r] = NEG; if (dq - c - 32 < 0) p1[r] = NEG; } } \
        float alpha; softmax_exp(p0, p1, m_reg, alpha); \
        if (__any(alpha < 1.f)) { int l_; asm volatile("v_mbcnt_lo_u32_b32 %0, -1, 0\n\tv_mbcnt_hi_u32_b32 %0, -1, %0" : "=v"(l_));     \
            ATT_LAS float* al2_ = (ATT_LAS float*)(lds + WS_OFF) + wid * 64 + 32; const int hi_ = l_ >> 5; \
            if (hi_ == 0) al2_[l_] = alpha; asm volatile("s_waitcnt lgkmcnt(0)" ::: "memory"); \
            _Pragma("unroll") for (int d_ = 0; d_ < NCB; ++d_) _Pragma("unroll") for (int r = 0; r < 16; ++r) o[d_][r] *= al2_[crow(r, hi_)]; } \
        bf16x8 pa0, pa1, pa2, pa3; softmax_pack(p0, p1, alpha, l_reg, pa0, pa1, pa2, pa3); ATT_SBAR(); \
        pv_tile<DV, (BF) * VBY>(o, vb0, pa0, pa1, pa2, pa3); \
        } else { GATE; } \
        asm volatile("s_waitcnt vmcnt(0)" ::: "memory"); \
        __syncthreads(); } while (0)
    for (int t = 0; t + 2 < NT; t += 2) { MLA_STEP(0, t, (void)0); MLA_STEP(1, t + 1, (void)0); }
    u32x4 gv[8];
    MLA_STEP(0, NT - 2, (void)0); MLA_STEP(1, NT - 1, gate_prefetch<DV>(gv, Gw, ldg, lane));
#undef MLA_STEP
#undef MLA_QKT
#undef MLA_KLD
#undef MLA_KA
#undef MLA_KH
#undef MLA_DMA
    { int lane2; asm volatile("v_mbcnt_lo_u32_b32 %0, -1, 0\n\tv_mbcnt_hi_u32_b32 %0, -1, %0" : "=v"(lane2));
      epilogue_rows_pre<DV>(o, l_reg, (ATT_LAS float*)(lds + WS_OFF) + wid * 64, lds + wid * (32 * (DV * 2 + 16)), gv, Yw, ldy, lane2); }
    __syncthreads();
}

__device__ __forceinline__ void mem_core_dma(ATT_LAS char* lds, const bf16_t* Qw, int ldq, const bf16_t* K0, int ldk0, const bf16_t* V, int ldv,
        const bf16_t* Gw, int ldg, bf16_t* Yw, int ldy, int tid_in) {
    constexpr int DQK = 256, DV = 128, NCB = 4, VBY = 16384, KBY = 32768, K_OFF = 2 * VBY, WS_OFF = K_OFF + 2 * KBY, NT = 4;
    int tid_ = tid_in; asm volatile("" : "+v"(tid_));
    const int tid = tid_, wid = __builtin_amdgcn_readfirstlane(tid >> 6), lane = tid & 63, r32 = lane & 31, hi = lane >> 5;
    ATT_LAS float* ws = (ATT_LAS float*)(lds + WS_OFF) + wid * 64; ATT_LAS float* li_l = ws; ATT_LAS float* al_l = ws + 32;
    const int vb0 = (int)(unsigned)(uintptr_t)lds + v_rd_base(lane);
    const char* sk0; const char* sv0; const char* sv1;
    { const int row = 2 * wid + (lane >> 5), cp = lane & 31, ch = (cp & 16) | ((cp & 15) ^ (row & 15));
      sk0 = (const char*)(K0 + (size_t)row * ldk0 + ch * 8); }
    { const int st = 2 * wid + (lane >> 5), kkh = st >> 2, cb = st & 3, q = (lane & 31) >> 2, c = cb * 32 + (lane & 3) * 8;
      const int kk = kkh * 8 + q, k = (kk & ~0xC) | ((kk & 4) << 1) | ((kk & 8) >> 1);
      sv0 = (const char*)(V + (size_t)k * ldv + c);
      const int st1 = st + 16, kkh1 = st1 >> 2, kk1 = kkh1 * 8 + q, k1 = (kk1 & ~0xC) | ((kk1 & 4) << 1) | ((kk1 & 8) >> 1);
      sv1 = (const char*)(V + (size_t)k1 * ldv + c); }
    const size_t stepK = (size_t)64 * ldk0 * 2, stepV = (size_t)64 * ldv * 2, rows16 = (size_t)16 * ldk0 * 2;
    const unsigned ldsw = (unsigned)wid * 1024u;
#define MEM_DMA(BUF, t_) do { \
        _Pragma("unroll") for (int i_ = 0; i_ < 4; ++i_) \
            __builtin_amdgcn_global_load_lds((const unsigned*)(sk0 + (size_t)(t_) * stepK + i_ * rows16), (ATT_LAS unsigned*)(lds + K_OFF + (BUF) * KBY + i_ * 8192 + ldsw), 16, 0, 0); \
        __builtin_amdgcn_global_load_lds((const unsigned*)(sv0 + (size_t)(t_) * stepV), (ATT_LAS unsigned*)(lds + (BUF) * VBY + ldsw), 16, 0, 0); \
        __builtin_amdgcn_global_load_lds((const unsigned*)(sv1 + (size_t)(t_) * stepV), (ATT_LAS unsigned*)(lds + (BUF) * VBY + 8192 + ldsw), 16, 0, 0); } while (0)
    MEM_DMA(0, 0);
    bf16x8 qr[DQK / 16];
#pragma unroll
    for (int d0 = 0; d0 < DQK / 16; ++d0) qr[d0] = *(const bf16x8*)(Qw + (size_t)r32 * ldq + d0 * 16 + hi * 8);
    float m_reg = -1e30f, l_reg = 0.f; f32x16 o[NCB];
    { float z_ = 0.f; asm volatile("" : "+v"(z_));
#pragma unroll
      for (int d = 0; d < NCB; ++d)
#pragma unroll
          for (int r = 0; r < 16; ++r) o[d][r] = z_; }
    asm volatile("s_waitcnt vmcnt(0)" ::: "memory");
    __syncthreads();
#define MEM_STEP(BF, t) do { \
        if ((t) + 1 < NT) MEM_DMA(1 - (BF), (t) + 1); \
        ATT_SBAR(); \
        f32x16 p0, p1; \
        qkt<DQK, 2>(p0, p1, lds + K_OFF + (BF) * KBY, r32, hi, qr); \
        float alpha; softmax_exp(p0, p1, m_reg, alpha); \
        if (__any(alpha < 1.f)) { if (hi == 0) al_l[r32] = alpha; asm volatile("s_waitcnt lgkmcnt(0)" ::: "memory"); \
            _Pragma("unroll") for (int d_ = 0; d_ < NCB; ++d_) _Pragma("unroll") for (int r = 0; r < 16; ++r) o[d_][r] *= al_l[crow(r, hi)]; } \
        bf16x8 pa0, pa1, pa2, pa3; softmax_pack(p0, p1, alpha, l_reg, pa0, pa1, pa2, pa3); ATT_SBAR(); \
        pv_tile<DV, (BF) * VBY>(o, vb0, pa0, pa1, pa2, pa3); \
        asm volatile("s_waitcnt vmcnt(0)" ::: "memory"); \
        __syncthreads(); } while (0)
    MEM_STEP(0, 0); MEM_STEP(1, 1); MEM_STEP(0, 2); MEM_STEP(1, 3);
#undef MEM_STEP
#undef MEM_DMA
    epilogue_rows<DV>(o, l_reg, li_l, lds + wid * (32 * (DV * 2 + 16)), Gw, ldg, Yw, ldy, lane);
    __syncthreads();
}

__device__ __forceinline__ void mem_core2(ATT_LAS char* lds, const bf16_t* Qw, int ldq, const bf16_t* K0, int ldk0, const bf16_t* V, int ldv,
        const bf16_t* Gw, int ldg, bf16_t* Yw, int ldy, int tid_in) {
    constexpr int DQK = 256, DV = 128, NCB = 4, VBY = 16384, KBY = 32768, K_OFF = 2 * VBY, WS_OFF = 102400;
    int tid_ = tid_in; asm volatile("" : "+v"(tid_));
    const int tid = tid_, wid = __builtin_amdgcn_readfirstlane(tid >> 6), lane = tid & 63, r32 = lane & 31, hi = lane >> 5;
    ATT_LAS float* ws = (ATT_LAS float*)(lds + WS_OFF) + wid * 160; ATT_LAS float* li_l = ws; ATT_LAS float* al_l = ws + 32;
    const int vb0 = (int)(unsigned)(uintptr_t)lds + v_rd_base(lane);
    const char* sk0; const char* sv0; const char* sv1;
    { const int row = 2 * wid + (lane >> 5), cp = lane & 31, ch = (cp & 16) | ((cp & 15) ^ (row & 15));
      sk0 = (const char*)(K0 + (size_t)row * ldk0 + ch * 8); }
    { const int st = 2 * wid + (lane >> 5), kkh = st >> 2, cb = st & 3, q = (lane & 31) >> 2, c = cb * 32 + (lane & 3) * 8;
      const int kk = kkh * 8 + q, k = (kk & ~0xC) | ((kk & 4) << 1) | ((kk & 8) >> 1);
      sv0 = (const char*)(V + (size_t)k * ldv + c);
      const int st1 = st + 16, kkh1 = st1 >> 2, kk1 = kkh1 * 8 + q, k1 = (kk1 & ~0xC) | ((kk1 & 4) << 1) | ((kk1 & 8) >> 1);
      sv1 = (const char*)(V + (size_t)k1 * ldv + c); }
    const size_t stepK = (size_t)64 * ldk0 * 2, stepV = (size_t)64 * ldv * 2, rows16 = (size_t)16 * ldk0 * 2;
    const unsigned ldsw = (unsigned)wid * 1024u;
#define MEM_DMAK(BUF, t_) do { _Pragma("unroll") for (int i_ = 0; i_ < 4; ++i_) \
            __builtin_amdgcn_global_load_lds((const unsigned*)(sk0 + (size_t)(t_) * stepK + i_ * rows16), (ATT_LAS unsigned*)(lds + K_OFF + (BUF) * KBY + i_ * 8192 + ldsw), 16, 0, 0); } while (0)
#define MEM_DMAV(BUF, i_) do { \
        __builtin_amdgcn_global_load_lds((const unsigned*)(sv0 + (size_t)((i_) & 3) * stepV + ((i_) >> 2) * 256), (ATT_LAS unsigned*)(lds + (BUF) * VBY + ldsw), 16, 0, 0); \
        __builtin_amdgcn_global_load_lds((const unsigned*)(sv1 + (size_t)((i_) & 3) * stepV + ((i_) >> 2) * 256), (ATT_LAS unsigned*)(lds + (BUF) * VBY + 8192 + ldsw), 16, 0, 0); } while (0)
    MEM_DMAK(0, 0);
    bf16x8 qr[DQK / 16];
#pragma unroll
    for (int d0 = 0; d0 < DQK / 16; ++d0) qr[d0] = *(const bf16x8*)(Qw + (size_t)r32 * ldq + d0 * 16 + hi * 8);
    float m_reg = -1e30f, l_reg = 0.f;
    asm volatile("s_waitcnt vmcnt(0)" ::: "memory");
    __syncthreads();
    bf16x8 P0[4], P1[4], P2[4], P3[4]; bool fl1 = false, fl2 = false, fl3 = false;
#define MEM_QK(BF, t, PP, FL) do { \
        if ((t) + 1 < 4) MEM_DMAK(1 - (BF), (t) + 1); \
        if ((t) == 2) MEM_DMAV(0, 0); \
        if ((t) == 3) MEM_DMAV(1, 1); \
        ATT_SBAR(); \
        f32x16 p0, p1; \
        qkt<DQK, 2>(p0, p1, lds + K_OFF + (BF) * KBY, r32, hi, qr); \
        float alpha; softmax_exp(p0, p1, m_reg, alpha); \
        FL = __any(alpha < 1.f); \
        if (hi == 0) al_l[(t) * 32 + r32] = alpha; \
        softmax_pack(p0, p1, alpha, l_reg, PP[0], PP[1], PP[2], PP[3]); ATT_SBAR(); \
        asm volatile("s_waitcnt vmcnt(0) lgkmcnt(0)" ::: "memory"); \
        __syncthreads(); } while (0)
    { bool fl0; MEM_QK(0, 0, P0, fl0); (void)fl0; } MEM_QK(1, 1, P1, fl1); MEM_QK(0, 2, P2, fl2); MEM_QK(1, 3, P3, fl3);
#undef MEM_QK
#define MEM_PV(i, PP, FL) do { \
        if ((i) >= 1 && (i) + 1 < 8) MEM_DMAV(((i) + 1) & 1, (i) + 1); \
        if (((i) & 3) == 1) { asm volatile("" ::: "memory"); ATT_SBAR(); gate_prefetch<DV>(gv, Gw + ((i) >> 2) * 128, ldg, lane); }     \
        ATT_SBAR(); \
        if (((i) & 3) != 0 && (FL)) { _Pragma("unroll") for (int d_ = 0; d_ < NCB; ++d_) _Pragma("unroll") for (int r = 0; r < 16; ++r) o[d_][r] *= al_l[((i) & 3) * 32 + crow(r, hi)]; } \
        pv_tile<DV, ((i) & 1) * VBY>(o, vb0, PP[0], PP[1], PP[2], PP[3]); \
        if (((i) & 3) == 3) epilogue_rows_pre<DV>(o, l_reg, li_l, lds + K_OFF + wid * (32 * (DV * 2 + 16)), gv, Yw + ((i) >> 2) * 128, ldy, lane); \
        if (((i) & 3) == 1) asm volatile("s_waitcnt vmcnt(8)" ::: "memory");          \
        else asm volatile("s_waitcnt vmcnt(0)" ::: "memory"); \
        __builtin_amdgcn_s_barrier(); } while (0)
#pragma unroll
    for (int h = 0; h < 2; ++h) {
        f32x16 o[NCB]; u32x4 gv[8];
        { float z_ = 0.f; asm volatile("" : "+v"(z_));
#pragma unroll
          for (int d = 0; d < NCB; ++d)
#pragma unroll
              for (int r = 0; r < 16; ++r) o[d][r] = z_; }
        if (h == 0) { MEM_PV(0, P0, false); MEM_PV(1, P1, fl1); MEM_PV(2, P2, fl2); MEM_PV(3, P3, fl3); }
        else        { MEM_PV(4, P0, false); MEM_PV(5, P1, fl1); MEM_PV(6, P2, fl2); MEM_PV(7, P3, fl3); }
    }
#undef MEM_PV
#undef MEM_DMAK
#undef MEM_DMAV
}

struct SwaUnit { int b, kvh, qb; };
__device__ __forceinline__ SwaUnit swa_decode(int U) { SwaUnit u; u.qb = U & 31; u.kvh = (U >> 5) & 7; u.b = U >> 8; return u; }
struct SwaPre { bf16x8 k[4], v[4]; };
constexpr int SWA_TN = 320, SWA_TOFF = 96;
constexpr int SWA_V = 0, SWA_K = 32768, SWA_WS = 65536, SWA_BIAS = 65536 + 2048, SWA_STG = 83968, SWA_NU = 1024;
__device__ __forceinline__ void swa_prefetch(SwaPre& P, const SwaUnit& u, const bf16_t* proj, int tid) {
    const int j_lo = (2 * u.qb - 2) > 0 ? (2 * u.qb - 2) : 0, NT = 2 * u.qb + 2 - j_lo;
    const size_t kr0 = (size_t)u.b * SEQ + j_lo * 64 + (tid >> 3);
    const bf16_t* kp = proj + kr0 * B_IN + B_OFF_K + u.kvh * 64 + (tid & 7) * 8;
    const bf16_t* vp = proj + kr0 * B_IN + B_OFF_V + u.kvh * 64 + (tid & 7) * 8;
#pragma unroll
    for (int tt = 0; tt < 4; ++tt) if (tt < NT) { P.k[tt] = *(const bf16x8*)(kp + (size_t)tt * 64 * B_IN); P.v[tt] = *(const bf16x8*)(vp + (size_t)tt * 64 * B_IN); }
}
__device__ __forceinline__ void swa_bias_dma(ATT_LAS char* lds, int tb, const SwaUnit& u, const float* ebias, int wid, int lane) {
    __builtin_amdgcn_global_load_lds((const unsigned*)((const char*)(ebias + (size_t)u.kvh * 6 * SWA_TN) + (wid * 64 + lane) * 16), (ATT_LAS unsigned*)(lds + SWA_BIAS + tb * 8192 + wid * 1024), 16, 0, 0);
}
__device__ __forceinline__ void swa_prefetch_q(bf16x8 (&q)[4], const SwaUnit& u, int pass, const bf16_t* proj, int wid, int r32, int hi) {
    const int head = u.kvh * 6 + pass * 2 + (wid >> 2), pos0 = u.qb * 128 + (wid & 3) * 32;
    const bf16_t* qp = proj + ((size_t)u.b * SEQ + pos0 + r32) * B_IN + B_OFF_Q + head * 64 + hi * 8;
#pragma unroll
    for (int d0 = 0; d0 < 4; ++d0) q[d0] = *(const bf16x8*)(qp + d0 * 16);
}
__device__ __forceinline__ void swa_phase(ATT_LAS char* lds, const bf16_t* proj, bf16_t* Y, const float* ebias, const float* sinks  , int vcu, int G, int tid_in) {
    int tid_ = tid_in; asm volatile("" : "+v"(tid_));
    const int tid = tid_, wid = __builtin_amdgcn_readfirstlane(tid >> 6), lane = tid & 63, r32 = lane & 31, hi = lane >> 5;
    ATT_LAS float* ws = (ATT_LAS float*)(lds + SWA_WS) + wid * 64; ATT_LAS float* li_l = ws; ATT_LAS float* al_l = ws + 32;
    const int vb0 = (int)(unsigned)(uintptr_t)lds + SWA_V + v_rd_base(lane);
    constexpr int NU = SWA_NU;
    int U = vcu; if (U >= NU) return;
    SwaPre P; bf16x8 qn[4]; SwaUnit u = swa_decode(U); int tb = 0;
    swa_bias_dma(lds, 0, u, ebias, wid, lane);
    swa_prefetch(P, u, proj, tid);
    swa_prefetch_q(qn, u, 0, proj, wid, r32, hi);
#pragma unroll 1
    for (;;) {
        const int j_lo = (2 * u.qb - 2) > 0 ? (2 * u.qb - 2) : 0, NT = 2 * u.qb + 2 - j_lo, kbase = j_lo * 64;
        { const int rr = tid >> 3, rc = (tid & 7) * 8;
#pragma unroll
          for (int tt = 0; tt < 4; ++tt) if (tt < NT) { *(ATT_LAS bf16x8*)(lds + SWA_V + tt * 8192 + v_st<64>(rr, rc)) = P.v[tt]; *(ATT_LAS bf16x8*)(lds + SWA_K + tt * 8192 + kswz<64>(rr, tid & 7)) = P.k[tt]; }
        }
        asm volatile("s_waitcnt vmcnt(0)" ::: "memory");
        __syncthreads();
        const int Un = U + G; const bool more = Un < NU; SwaUnit un = u;
        if (more) { un = swa_decode(Un); swa_prefetch(P, un, proj, tid); }
        ATT_SBAR();
#pragma unroll 1
        for (int pass = 0; pass < 3; ++pass) {
            bf16x8 qr[4];
#pragma unroll
            for (int d0 = 0; d0 < 4; ++d0) qr[d0] = qn[d0];
            if (pass < 2) swa_prefetch_q(qn, u, pass + 1, proj, wid, r32, hi); else if (more) swa_prefetch_q(qn, un, 0, proj, wid, r32, hi);
            ATT_SBAR();
            const int hsel = pass * 2 + (wid >> 2), head = u.kvh * 6 + hsel, pos0 = u.qb * 128 + (wid & 3) * 32;
            const ATT_LAS float* biasS = (const ATT_LAS float*)(lds + SWA_BIAS + tb * 8192) + hsel * SWA_TN;
            float m_reg = sinks[head] * LOG2E, l_reg = 1.f; f32x16 o[2]; o[0] = f32x16{}; o[1] = f32x16{};
            const int qm = pos0 + r32 - 4 * hi;
            u32x4 gv[4]; gate_prefetch<64>(gv, proj + ((size_t)u.b * SEQ + pos0) * B_IN + B_OFF_Z + head * 64, B_IN, lane);
#pragma unroll 1
            for (int tt = 0; tt < NT; ++tt) {
                const int kb_ = kbase + tt * 64;
                if (!(kb_ <= pos0 + 31 && kb_ + 63 >= pos0 - 127)) continue;
                f32x16 p0, p1;
                { const ATT_LAS float* bp = biasS + (qm - kb_ + SWA_TOFF - 59);
#pragma unroll
                  for (int r = 0; r < 16; ++r) { const int c = (r & 3) + 8 * (r >> 2); p0[r] = bp[59 - c]; p1[r] = bp[59 - c - 32]; } }
                qkt<64, 4, false>(p0, p1, lds + SWA_K + tt * 8192, r32, hi, qr);
                float alpha; softmax_exp(p0, p1, m_reg, alpha);
                if (__any(alpha < 1.f)) { if (hi == 0) al_l[r32] = alpha; asm volatile("s_waitcnt lgkmcnt(0)" ::: "memory");
#pragma unroll
                    for (int d_ = 0; d_ < 2; ++d_)
#pragma unroll
                        for (int r = 0; r < 16; ++r) o[d_][r] *= al_l[crow(r, hi)]; }
                bf16x8 pa0, pa1, pa2, pa3; softmax_pack(p0, p1, alpha, l_reg, pa0, pa1, pa2, pa3); ATT_SBAR();
                pv_tile<64, 0>(o, vb0 + tt * 8192, pa0, pa1, pa2, pa3);
            }
            { const size_t rows0 = (size_t)u.b * SEQ + pos0;
              epilogue_rows_pre<64>(o, l_reg, li_l, lds + SWA_STG + wid * (32 * 144), gv, Y + rows0 * D_MODEL + head * 64, D_MODEL, lane); }
        }
        if (!more) break;
        swa_bias_dma(lds, 1 - tb, un, ebias, wid, lane);
        U = Un; u = un; tb = 1 - tb;
        __syncthreads();
    }
    __syncthreads();
}
}
constexpr int NWAVES = 8;
constexpr size_t MiB = 1u << 20;
constexpr size_t WS_CTL = 0, CTL_ZERO_BYTES = 1 * MiB;
constexpr size_t WS_COS = 1 * MiB, WS_SIN = 3 * MiB, WS_BIAS = 5 * MiB;
constexpr size_t WS_RR = 6 * MiB;
constexpr size_t WS_MKV = 8 * MiB;
constexpr size_t WS_WIN = 16 * MiB;
constexpr size_t WS_WQB = 102 * MiB;
constexpr size_t WS_WKVB = 111 * MiB;
constexpr size_t WS_WOUT = 117 * MiB;
constexpr size_t WS_HB = 150 * MiB;
constexpr size_t WS_PROJ = 286 * MiB;
constexpr size_t WS_Q = 574 * MiB;
constexpr size_t WS_HI = 718 * MiB;
constexpr size_t WS_LO = 854 * MiB;
constexpr size_t WS_WOUT2 = 982 * MiB;
constexpr size_t WS_PART = 1014 * MiB;
constexpr size_t WS_END = 1018 * MiB;
constexpr int CW_BAR = 4096;
constexpr int RING_BYTES = 131072, LDSCTL_OFF = RING_BYTES, MISC_OFF = LDSCTL_OFF + 320, LDS_BYTES = 147456;
constexpr int RRL_OFF = RING_BYTES + 2048;

#define GAS __attribute__((address_space(1)))
#define LAS __attribute__((address_space(3)))
typedef unsigned short bf16;
typedef unsigned v4u __attribute__((ext_vector_type(4)));
typedef float f32x4 __attribute__((ext_vector_type(4)));
typedef GAS unsigned gu32;
#define RLX_AGENT __ATOMIC_RELAXED, __HIP_MEMORY_SCOPE_AGENT
#define LDS_WAIT() asm volatile("s_waitcnt lgkmcnt(0)" ::: "memory")
#define VM_WAIT() asm volatile("s_waitcnt vmcnt(0)" ::: "memory")
__device__ __forceinline__ unsigned f2bf(float f) { unsigned u = __builtin_bit_cast(unsigned, f); return (u + 0x7fffu + ((u >> 16) & 1u)) >> 16; }
__device__ __forceinline__ unsigned pk2(float lo, float hi) { return f2bf(lo) | (f2bf(hi) << 16); }

#define XB_TMO      128
#define XB_XCNT(j)  (256  + 64 * (j))
#define XB_XSUB(j)  (1280 + 64 * (j))
#define XB_XGEN(j)  (2304 + 64 * (j))
#define XB_TOP      3328
#define XB_TOPGEN   3392
#define XCD_BAR_WORDS 3456
#define XB_SPIN_CAP (1u << 21)

__device__ __forceinline__ unsigned xb_ld(unsigned* p)              { return __hip_atomic_load(p, __ATOMIC_RELAXED, __HIP_MEMORY_SCOPE_AGENT); }
__device__ __forceinline__ unsigned xb_add(unsigned* p, unsigned v) { return __hip_atomic_fetch_add(p, v, __ATOMIC_RELAXED, __HIP_MEMORY_SCOPE_AGENT); }
__device__ __forceinline__ unsigned xb_xcc_id() { return (unsigned)__builtin_amdgcn_s_getreg((3 << 11) | 20) & 0xFu; }
#define XB_SPIN(cond, bar) do { unsigned _sp = 0; while (cond) { __builtin_amdgcn_s_sleep(1); \
    if ((++_sp & 255u) == 0u) { if (xb_ld(&(bar)[XB_TMO])) break; if (_sp > XB_SPIN_CAP) { atomicAdd(&(bar)[XB_TMO], 1u); break; } } } } while (0)

__device__ __forceinline__ int fresh_tid(int wave) { int l; asm volatile("v_mbcnt_lo_u32_b32 %0, -1, 0\n\tv_mbcnt_hi_u32_b32 %0, -1, %0" : "=v"(l)); return wave * 64 + l; }
struct XcdBarrier {
    unsigned* bar; unsigned x;
    volatile LAS unsigned* st;
};
__device__ __forceinline__ XcdBarrier xcd_barrier_post(unsigned* bar, volatile LAS unsigned* st) {
    XcdBarrier b; b.bar = bar; b.x = xb_xcc_id(); b.st = st;
    if (threadIdx.x == 0) (void)xb_add(&bar[XB_XCNT(b.x)], 1u);
    return b;
}
__device__ __forceinline__ void xcd_barrier_complete(unsigned* bar, unsigned x, unsigned& nloc, unsigned& nx) {
    const unsigned G = gridDim.x * gridDim.y * gridDim.z;
    unsigned sum, cnt, mine, sp = 0u;
    for (;;) {
        sum = 0u; cnt = 0u; mine = 0u;
#pragma unroll
        for (unsigned j = 0; j < 16; ++j) { const unsigned c = xb_ld(&bar[XB_XCNT(j)]); sum += c; cnt += (c > 0u) ? 1u : 0u; mine = (j == x) ? c : mine; }
        if (sum == G) break;
        __builtin_amdgcn_s_sleep(1);
        if ((++sp & 255u) == 0u) { if (xb_ld(&bar[XB_TMO])) break; if (sp > XB_SPIN_CAP) { atomicAdd(&bar[XB_TMO], 1u); break; } }
    }
    nloc = mine > 0u ? mine : 1u; nx = cnt > 0u ? cnt : 1u;
}
__device__ __forceinline__ void xcd_barrier(const XcdBarrier& b, int wave) {
    asm volatile("s_waitcnt vmcnt(0)" ::: "memory");
    __syncthreads();
    if (fresh_tid(wave) == 0) {
        unsigned* bar = b.bar;
        __builtin_amdgcn_s_waitcnt(0);
        unsigned nloc = b.st[0], nx = b.st[1];
        if (nloc == 0u) { xcd_barrier_complete(bar, b.x, nloc, nx); b.st[0] = nloc; b.st[1] = nx; }
        const unsigned old = xb_add(&bar[XB_XSUB(b.x)], 1u);
        const unsigned gen = old / nloc;
        if (old + 1u == (gen + 1u) * nloc) {
            __builtin_amdgcn_fence(__ATOMIC_RELEASE, "agent");
            asm volatile("s_waitcnt vmcnt(0)" ::: "memory");
            const unsigned og = xb_add(&bar[XB_TOP], 1u);
            const unsigned tg = og / nx;
            if (og + 1u == (tg + 1u) * nx) xb_add(&bar[XB_TOPGEN], 1u);
            else XB_SPIN(xb_ld(&bar[XB_TOPGEN]) == tg, bar);
            __builtin_amdgcn_fence(__ATOMIC_ACQUIRE, "agent");
            xb_add(&bar[XB_XGEN(b.x)], 1u);
            asm volatile("s_waitcnt vmcnt(0)" ::: "memory");
        } else {
            XB_SPIN(xb_ld(&bar[XB_XGEN(b.x)]) == gen, bar);
            __builtin_amdgcn_fence(__ATOMIC_ACQUIRE, "agent");
            asm volatile("s_waitcnt vmcnt(0)" ::: "memory");
        }
    }
    __syncthreads();
}

__device__ __forceinline__ float shx(float v, int lane, int o) { return __builtin_bit_cast(float, __builtin_amdgcn_ds_bpermute((lane ^ o) << 2, __builtin_bit_cast(int, v))); }
__device__ __forceinline__ float wave_sum(float v, int lane) {
#pragma unroll
    for (int o = 1; o < 64; o <<= 1) v += shx(v, lane, o);
    return v;
}
__device__ const unsigned char T5B[128] = {0, 1, 2, 3, 4, 5, 6, 7, 8, 9, 10, 11, 12, 13, 14, 15, 16, 16, 16, 17, 17, 18, 18, 18, 19, 19, 19, 20, 20, 20, 20, 21, 21, 21, 21, 22, 22, 22, 22, 22, 23, 23, 23, 23, 23, 23, 24, 24, 24, 24, 24, 24, 25, 25, 25, 25, 25, 25, 25, 26, 26, 26, 26, 26, 26, 26, 26, 27, 27, 27, 27, 27, 27, 27, 27, 27, 27, 28, 28, 28, 28, 28, 28, 28, 28, 28, 28, 29, 29, 29, 29, 29, 29, 29, 29, 29, 29, 29, 29, 30, 30, 30, 30, 30, 30, 30, 30, 30, 30, 30, 30, 30, 30, 31, 31, 31, 31, 31, 31, 31, 31, 31, 31, 31, 31, 31, 31, 31};

__device__ const float INVF[32] = {1.000000000e+00f, 7.498942614e-01f, 5.623413324e-01f, 4.216965139e-01f, 3.162277639e-01f, 2.371373773e-01f, 1.778279394e-01f, 1.333521307e-01f, 1.000000015e-01f, 7.498941571e-02f, 5.623413250e-02f, 4.216965288e-02f, 3.162277490e-02f, 2.371373773e-02f, 1.778279431e-02f, 1.333521493e-02f, 9.999999776e-03f, 7.498941850e-03f, 5.623413250e-03f, 4.216964822e-03f, 3.162277630e-03f, 2.371373586e-03f, 1.778279431e-03f, 1.333521446e-03f, 1.000000047e-03f, 7.498942432e-04f, 5.623413017e-04f, 4.216965172e-04f, 3.162277571e-04f, 2.371373703e-04f, 1.778279402e-04f, 1.333521504e-04f};
__device__ __forceinline__ int permrope(int i) { return i < 32 ? 2 * i : 2 * (i - 32) + 1; }
struct TrItem { const float* W; const float* gain; bf16* WT; int K, N, row_off, map, item; };
__device__ __forceinline__ void tr_load(const TrItem& d, f32x4 (&v)[16], float (&g)[16], int lane) {
    const int nblk = d.N / 64, kb = d.item / nblk, nb = d.item - kb * nblk, k0 = 64 * kb, n0 = 64 * nb, lr = lane >> 4, lc = (lane & 15) * 4;
#pragma unroll
    for (int i = 0; i < 16; ++i) v[i] = __builtin_nontemporal_load((const GAS f32x4*)(d.W + (size_t)(k0 + 4 * i + lr) * d.N + n0 + lc));
#pragma unroll
    for (int i = 0; i < 16; ++i) g[i] = d.gain ? d.gain[k0 + 4 * i + lr] : 1.0f;
}
__device__ __forceinline__ void tr_finish(const TrItem& d, const f32x4 (&v)[16], const float (&g)[16], LAS float* scr_f, int lane) {
    constexpr int ROWB = 144;
    LAS unsigned char* scr = (LAS unsigned char*)scr_f;
    const int nblk = d.N / 64, kb = d.item / nblk, nb = d.item - kb * nblk, k0 = 64 * kb, n0 = 64 * nb, lr = lane >> 4, lc = (lane & 15) * 4;
#pragma unroll
    for (int i = 0; i < 16; ++i) { const f32x4 w = v[i] * g[i];
        *(LAS unsigned long long*)(scr + (4 * i + lr) * ROWB + lc * 2) = (unsigned long long)pk2(w.x, w.y) | ((unsigned long long)pk2(w.z, w.w) << 32); }
    LDS_WAIT(); asm volatile("" ::: "memory");
    const int gq = lane >> 4, i16 = lane & 15, q = (lane >> 2) & 3, p = lane & 3;
    const int rbase = (int)(unsigned)(uintptr_t)scr + (8 * gq + q) * ROWB + 8 * p;
    typedef short s16x4 __attribute__((ext_vector_type(4)));
#pragma unroll
    for (int nb16 = 0; nb16 < 4; ++nb16)
#pragma unroll
        for (int ph = 0; ph < 2; ++ph) { s16x4 lo, hi;
            asm volatile("ds_read_b64_tr_b16 %0, %1 offset:%2" : "=&v"(lo) : "v"(rbase), "i"(ph * 32 * ROWB + nb16 * 32) : "memory");
            asm volatile("ds_read_b64_tr_b16 %0, %1 offset:%2" : "=&v"(hi) : "v"(rbase), "i"(ph * 32 * ROWB + nb16 * 32 + 4 * ROWB) : "memory");
            asm volatile("s_waitcnt lgkmcnt(0)" ::: "memory");
            int dn = n0 + 16 * nb16 + i16;
            if (d.map == 1) { if (dn >= A_OFF_KR && dn < A_OFF_XQ) dn = A_OFF_KR + permrope(dn - A_OFF_KR); }
            if (d.map == 2) { const int hc = dn % 192; if (hc >= 128) dn = dn - hc + 128 + permrope(hc - 128); }
            v4u o; o.x = (unsigned)(unsigned short)lo[0] | ((unsigned)(unsigned short)lo[1] << 16); o.y = (unsigned)(unsigned short)lo[2] | ((unsigned)(unsigned short)lo[3] << 16);
            o.z = (unsigned)(unsigned short)hi[0] | ((unsigned)(unsigned short)hi[1] << 16); o.w = (unsigned)(unsigned short)hi[2] | ((unsigned)(unsigned short)hi[3] << 16);
            *(GAS v4u*)(d.WT + (size_t)(d.row_off + dn) * d.K + k0 + 8 * (4 * ph + gq)) = o; }
    asm volatile("s_waitcnt lgkmcnt(0)" ::: "memory");
}
#define CONV_RUN(NITEMS_, DEC) do { f32x4 va_[16], vb_[16]; float ga_[16], gb_[16]; TrItem da_, db_; int it_ = gw; \
        if (it_ < (NITEMS_)) { DEC(da_, it_); tr_load(da_, va_, ga_, lane); \
            for (;;) { { const int nx_ = (it_ + NGW < (NITEMS_)) ? it_ + NGW : it_; DEC(db_, nx_); tr_load(db_, vb_, gb_, lane); }     \
                       tr_finish(da_, va_, ga_, scr, lane); it_ += NGW; if (it_ >= (NITEMS_)) break; \
                       { const int nx_ = (it_ + NGW < (NITEMS_)) ? it_ + NGW : it_; DEC(da_, nx_); tr_load(da_, va_, ga_, lane); } \
                       tr_finish(db_, vb_, gb_, scr, lane); it_ += NGW; if (it_ >= (NITEMS_)) break; } } } while (0)
__device__ __forceinline__ void rms_row_bf16(const float* xrow, const bf16* drow, float* xout, bf16* orow, int lane) {
    const GAS f32x4* xr = (const GAS f32x4*)xrow + lane;
    f32x4 v[16]; float s = 0.f;
#pragma unroll
    for (int j = 0; j < 16; ++j) v[j] = xr[64 * j];
    if (drow) { const GAS unsigned long long* dr = (const GAS unsigned long long*)drow + lane;
#pragma unroll
        for (int j = 0; j < 16; ++j) { const unsigned long long d = dr[64 * j]; const unsigned lo = (unsigned)d, hi = (unsigned)(d >> 32);
            v[j].x += __uint_as_float(lo << 16); v[j].y += __uint_as_float(lo & 0xffff0000u); v[j].z += __uint_as_float(hi << 16); v[j].w += __uint_as_float(hi & 0xffff0000u); } }
    if (xout) { GAS f32x4* xo = (GAS f32x4*)xout + lane;
#pragma unroll
        for (int j = 0; j < 16; ++j) xo[64 * j] = v[j]; }
#pragma unroll
    for (int j = 0; j < 16; ++j) s += (v[j].x * v[j].x + v[j].y * v[j].y) + (v[j].z * v[j].z + v[j].w * v[j].w);
    const float r = 1.0f / sqrtf(wave_sum(s, lane) * (1.f / D_MODEL) + EPS);
    GAS unsigned long long* o8 = (GAS unsigned long long*)orow + lane;
#pragma unroll
    for (int j = 0; j < 16; ++j) o8[64 * j] = (unsigned long long)pk2(v[j].x * r, v[j].y * r) | ((unsigned long long)pk2(v[j].z * r, v[j].w * r) << 32);
}
typedef unsigned v2u __attribute__((ext_vector_type(2)));
typedef unsigned char u8;
__device__ __forceinline__ float bf_lo(unsigned u) { return __uint_as_float(u << 16); }
__device__ __forceinline__ float bf_hi(unsigned u) { return __uint_as_float(u & 0xffff0000u); }
__device__ __forceinline__ unsigned lo_ebits(float hif) { const unsigned e = __float_as_uint(hif) & 0x7f800000u; return e > (16u << 23) ? e : (16u << 23); }
__device__ __forceinline__ float lo_dec(unsigned q, float hif) { return ((float)q - 128.f) * __uint_as_float(lo_ebits(hif) - (15u << 23)); }
__device__ __forceinline__ unsigned lo_enc(float x, float hif) { const float r = (x - hif) * __uint_as_float((269u << 23) - lo_ebits(hif)) + 128.5f;
    return (unsigned)fminf(fmaxf(r, 1.f), 255.f); }
__device__ __forceinline__ void split2(float a, float b, unsigned& h, unsigned& la, unsigned& lb) {
    const unsigned ha = f2bf(a), hb = f2bf(b); h = ha | (hb << 16); la = lo_enc(a, __uint_as_float(ha << 16)); lb = lo_enc(b, __uint_as_float(hb << 16)); }
__device__ __forceinline__ void xrow_first(const float* xrow, bf16* hrow, float* rr, int lane) {
    const GAS f32x4* xr = (const GAS f32x4*)xrow + lane; f32x4 v[16]; float s = 0.f;
#pragma unroll
    for (int j = 0; j < 16; ++j) v[j] = xr[64 * j];
    GAS unsigned long long* o8 = (GAS unsigned long long*)hrow + lane;
#pragma unroll
    for (int j = 0; j < 16; ++j) { s += (v[j].x * v[j].x + v[j].y * v[j].y) + (v[j].z * v[j].z + v[j].w * v[j].w);
        o8[64 * j] = (unsigned long long)pk2(v[j].x, v[j].y) | ((unsigned long long)pk2(v[j].z, v[j].w) << 32); }
    const float r = 1.0f / sqrtf(wave_sum(s, lane) * (1.f / D_MODEL) + EPS);
    if (lane == 0) *(GAS float*)rr = r;
}
__device__ __forceinline__ void xrow_f32(const float* xrow, const bf16* drow, bf16* hrow, u8* lrow, float* rr, int lane) {
    const GAS f32x4* xr = (const GAS f32x4*)xrow + lane; const GAS unsigned long long* dr = (const GAS unsigned long long*)drow + lane;
    f32x4 v[16]; unsigned long long d[16]; float s = 0.f;
#pragma unroll
    for (int j = 0; j < 16; ++j) v[j] = xr[64 * j];
#pragma unroll
    for (int j = 0; j < 16; ++j) d[j] = dr[64 * j];
    GAS unsigned long long* h8 = (GAS unsigned long long*)hrow + lane; GAS unsigned* l4 = (GAS unsigned*)lrow + lane;
#pragma unroll
    for (int j = 0; j < 16; ++j) { const unsigned d0 = (unsigned)d[j], d1 = (unsigned)(d[j] >> 32);
        const float a = v[j].x + bf_lo(d0), b = v[j].y + bf_hi(d0), c = v[j].z + bf_lo(d1), e = v[j].w + bf_hi(d1);
        s += (a * a + b * b) + (c * c + e * e);
        unsigned h0, h1, q0, q1, q2, q3; split2(a, b, h0, q0, q1); split2(c, e, h1, q2, q3);
        h8[64 * j] = (unsigned long long)h0 | ((unsigned long long)h1 << 32); l4[64 * j] = q0 | (q1 << 8) | (q2 << 16) | (q3 << 24); }
    const float r = 1.0f / sqrtf(wave_sum(s, lane) * (1.f / D_MODEL) + EPS);
    if (lane == 0) *(GAS float*)rr = r;
}
__device__ __forceinline__ void xrow_hl(bf16* hrow, u8* lrow, const bf16* drow, float* rr, int lane) {
    GAS v4u* hp = (GAS v4u*)hrow + lane; GAS v2u* lp = (GAS v2u*)lrow + lane; const GAS v4u* dp = (const GAS v4u*)drow + lane;
    v4u h[8], d[8]; v2u l[8]; float s = 0.f;
#pragma unroll
    for (int j = 0; j < 8; ++j) { h[j] = hp[64 * j]; l[j] = lp[64 * j]; d[j] = dp[64 * j]; }
#pragma unroll
    for (int j = 0; j < 8; ++j) { v4u ho; v2u lo = {0u, 0u};
#pragma unroll
        for (int e = 0; e < 4; ++e) { const unsigned lw = l[j][e >> 1]; const int sh = (e & 1) * 16;
            const float h0 = bf_lo(h[j][e]), h1 = bf_hi(h[j][e]);
            const float a = (h0 + lo_dec((lw >> sh) & 255u, h0)) + bf_lo(d[j][e]), b = (h1 + lo_dec((lw >> (sh + 8)) & 255u, h1)) + bf_hi(d[j][e]);
            s += a * a + b * b; unsigned hh, qa, qb; split2(a, b, hh, qa, qb); ho[e] = hh; lo[e >> 1] |= (qa << sh) | (qb << (sh + 8)); }
        hp[64 * j] = ho; lp[64 * j] = lo; }
    const float r = 1.0f / sqrtf(wave_sum(s, lane) * (1.f / D_MODEL) + EPS);
    if (lane == 0) *(GAS float*)rr = r;
}
__device__ __forceinline__ void xrow_final(float* orow, const bf16* hrow, const u8* lrow, const bf16* drow, const float* g, int lane) {
    GAS f32x4* xo = (GAS f32x4*)orow + lane; const GAS f32x4* gr = (const GAS f32x4*)g + lane;
    const GAS unsigned long long* hr = (const GAS unsigned long long*)hrow + lane; const GAS unsigned* lr = (const GAS unsigned*)lrow + lane;
    const GAS unsigned long long* dr = (const GAS unsigned long long*)drow + lane;
    unsigned long long h[16], d[16]; unsigned l[16]; f32x4 v[16]; float s = 0.f;
#pragma unroll
    for (int j = 0; j < 16; ++j) { h[j] = hr[64 * j]; l[j] = lr[64 * j]; d[j] = dr[64 * j]; }
#pragma unroll
    for (int j = 0; j < 16; ++j) { const unsigned h0 = (unsigned)h[j], h1 = (unsigned)(h[j] >> 32), d0 = (unsigned)d[j], d1 = (unsigned)(d[j] >> 32), lw = l[j];
        const float a0 = bf_lo(h0), a1 = bf_hi(h0), a2 = bf_lo(h1), a3 = bf_hi(h1);
        v[j].x = (a0 + lo_dec(lw & 255u, a0)) + bf_lo(d0); v[j].y = (a1 + lo_dec((lw >> 8) & 255u, a1)) + bf_hi(d0);
        v[j].z = (a2 + lo_dec((lw >> 16) & 255u, a2)) + bf_lo(d1); v[j].w = (a3 + lo_dec(lw >> 24, a3)) + bf_hi(d1);
        s += (v[j].x * v[j].x + v[j].y * v[j].y) + (v[j].z * v[j].z + v[j].w * v[j].w); }
    const float r = 1.0f / sqrtf(wave_sum(s, lane) * (1.f / D_MODEL) + EPS);
#pragma unroll
    for (int j = 0; j < 16; ++j) { const f32x4 gg = gr[64 * j]; xo[64 * j] = (v[j] * r) * gg; }
}
__device__ __forceinline__ float sumsq8(v4u a) {
    float s = 0.f;
#pragma unroll
    for (int i = 0; i < 4; ++i) { const float lo = __uint_as_float(a[i] << 16), hi = __uint_as_float(a[i] & 0xffff0000u); s += lo * lo + hi * hi; }
    return s;
}
__device__ __forceinline__ v4u scale8(v4u a, float r) {
    v4u o;
#pragma unroll
    for (int i = 0; i < 4; ++i) { const float lo = __uint_as_float(a[i] << 16), hi = __uint_as_float(a[i] & 0xffff0000u); o[i] = pk2(lo * r, hi * r); }
    return o;
}
__device__ __forceinline__ void cnorm_row(bf16* prow, int lane) {
    GAS v4u* p = (GAS v4u*)prow + lane;
    const v4u a = p[0], b = p[64], c = p[128];
    const float sq = wave_sum(sumsq8(a) + sumsq8(b), lane), sk = wave_sum(sumsq8(c), lane);
    const float rq = 1.0f / sqrtf(sq * (1.f / 1024.f) + EPS), rk = 1.0f / sqrtf(sk * (1.f / 512.f) + EPS);
    p[0] = scale8(a, rq); p[64] = scale8(b, rq); p[128] = scale8(c, rk);
}

#define SETI(d, W_, g_, WT_, K_, N_, ro_, map_, it_) do { d.W = (W_); d.gain = (g_); d.WT = (WT_); d.K = (K_); d.N = (N_); d.row_off = (ro_); d.map = (map_); d.item = (it_); } while (0)
#define DEC_A(d, it) do { int r_ = (it); \
        if (r_ < CA_IN) { SETI(d, a_w_in + (size_t)cj_ * D_MODEL * A_IN, norm_g + (2 * cj_) * D_MODEL, W_IN, D_MODEL, A_IN, 0, 1, r_); } \
        else if (r_ < CA_IN + CA_MKV) { SETI(d, w_mem_kv + (size_t)(2 * cj_) * D_MODEL * 2048, mem_norm_g + (2 * cj_) * D_MODEL, W_IN, D_MODEL, 2048, A_LDP, 0, r_ - CA_IN); } \
        else if (r_ < CA_IN + 2 * CA_MKV) { SETI(d, w_mem_kv + (size_t)(2 * cj_ + 1) * D_MODEL * 2048, mem_norm_g + (2 * cj_ + 1) * D_MODEL, W_IN, D_MODEL, 2048, A_LDP + 2048, 0, r_ - CA_IN - CA_MKV); } \
        else if (r_ < CA_IN + 2 * CA_MKV + CA_QB) { SETI(d, a_w_qb + (size_t)cj_ * 1024 * QW, a_q_g + cj_ * 1024, W_QB, 1024, QW, 0, 2, r_ - CA_IN - 2 * CA_MKV); } \
        else if (r_ < CA_IN + 2 * CA_MKV + CA_QB + CA_KVB) { SETI(d, a_w_kvb + (size_t)cj_ * 512 * KVW, a_kv_g + cj_ * 512, W_KVB, 512, KVW, 0, 0, r_ - CA_IN - 2 * CA_MKV - CA_QB); } \
        else { SETI(d, w_out + (size_t)(2 * cj_) * D_MODEL * D_MODEL, (const float*)nullptr, (bf16*)(ws + WS_WOUT), D_MODEL, D_MODEL, 0, 0, r_ - CA_IN - 2 * CA_MKV - CA_QB - CA_KVB); } } while (0)
#define CONV_A(jj) do { constexpr int CA_IN = 64 * (A_IN / 64), CA_MKV = 64 * 32, CA_QB = 16 * (QW / 64), CA_KVB = 8 * (KVW / 64), CA_OUT = 64 * 64; \
        constexpr int NITEMS = CA_IN + 2 * CA_MKV + CA_QB + CA_KVB + CA_OUT; const int cj_ = (jj); \
        CONV_RUN(NITEMS, DEC_A); } while (0)
#define DEC_B(d, it) do { const int r_ = (it); \
        if (r_ < CB_IN) { SETI(d, b_w_in + (size_t)cj_ * D_MODEL * B_IN, norm_g + (2 * cj_ + 1) * D_MODEL, W_IN, D_MODEL, B_IN, 0, 0, r_); } \
        else { SETI(d, w_out + (size_t)(2 * cj_ + 1) * D_MODEL * D_MODEL, (const float*)nullptr, (bf16*)(ws + WS_WOUT2), D_MODEL, D_MODEL, 0, 0, r_ - CB_IN); } } while (0)
#define CONV_B(jj) do { constexpr int CB_IN = 64 * (B_IN / 64), CB_OUT = 64 * 64, NITEMS = CB_IN + CB_OUT; const int cj_ = (jj); \
        CONV_RUN(NITEMS, DEC_B); } while (0)

__device__ __forceinline__ int xrow_map(int it, int G) { if (G != 256) return it; const int gwv = it & 2047, j = it >> 11; return ((((gwv >> 8) << 3) + j) << 8) + (gwv & 255); }
#define XROW_FOR(m) for (int it_ = gw, m = xrow_map(gw, G); it_ < M_TOK; it_ += NGW, m = xrow_map(it_, G))
struct Args { const float* in[16]; float* out; unsigned char* ws; int ph_lo, ph_hi; };

__global__ void __launch_bounds__(NWAVES * 64, 2) fwd_kernel(Args args) {
    extern __shared__ __attribute__((aligned(16))) unsigned char lds_raw[];
    LAS unsigned char* lds = (LAS unsigned char*)lds_raw;
    volatile LAS unsigned* MISC = (volatile LAS unsigned*)(lds + MISC_OFF);
    const int wave_k = __builtin_amdgcn_readfirstlane(threadIdx.x >> 6);
    const int G = gridDim.x, bx = blockIdx.x, vcu = (G % 8 == 0) ? (bx % 8) * (G / 8) + bx / 8 : bx;
#define PH_PTRS \
    const int tid = fresh_tid(wave_k), lane = tid & 63, wave = wave_k; \
    const int gw = vcu * NWAVES + wave, NGW = G * NWAVES; LAS float* scr = (LAS float*)(lds + wave * 16384); (void)lane; (void)gw; (void)NGW; (void)scr; \
    const __attribute__((address_space(4))) Args* ap_ = (const __attribute__((address_space(4))) Args*)__builtin_amdgcn_kernarg_segment_ptr(); asm volatile("" : "+s"(ap_)); \
    unsigned char* ws = ap_->ws; float* out = ap_->out; \
    const float* x_in = ap_->in[0]; const float* mem_in = ap_->in[1]; const int* pos_in = (const int*)ap_->in[2]; \
    const float* norm_g = ap_->in[3]; const float* mem_norm_g = ap_->in[4]; const float* final_g = ap_->in[5]; \
    const float* w_mem_kv = ap_->in[6]; const float* w_out = ap_->in[7]; const float* a_w_in = ap_->in[8]; \
    const float* a_q_g = ap_->in[9]; const float* a_kv_g = ap_->in[10]; const float* a_w_qb = ap_->in[11]; const float* a_w_kvb = ap_->in[12]; \
    const float* b_w_in = ap_->in[13]; const float* b_sinks = ap_->in[14]; const float* rel_bias = ap_->in[15]; \
    float* cosT = (float*)(ws + WS_COS); float* sinT = (float*)(ws + WS_SIN); float* bias2 = (float*)(ws + WS_BIAS); \
    bf16* MKV = (bf16*)(ws + WS_MKV); bf16* W_IN = (bf16*)(ws + WS_WIN); bf16* W_QB = (bf16*)(ws + WS_WQB); bf16* W_KVB = (bf16*)(ws + WS_WKVB); bf16* W_OUT = (bf16*)(ws + WS_WOUT); \
    float* PART = (float*)(ws + WS_PART); bf16* HI = (bf16*)(ws + WS_HI); u8* LO = (u8*)(ws + WS_LO); float* RR = (float*)(ws + WS_RR); bf16* Y = (bf16*)(ws + WS_HB); bf16* PROJ = (bf16*)(ws + WS_PROJ); bf16* QB = (bf16*)(ws + WS_Q); bf16* KVB = (bf16*)out; \
    (void)out; (void)x_in; (void)mem_in; (void)pos_in; (void)norm_g; (void)mem_norm_g; (void)final_g; (void)w_mem_kv; (void)w_out; (void)a_w_in; (void)a_q_g; (void)a_kv_g; (void)a_w_qb; (void)a_w_kvb; \
    (void)b_w_in; (void)b_sinks; (void)rel_bias; (void)cosT; (void)sinT; (void)bias2; (void)MKV; (void)W_IN; (void)W_QB; (void)W_KVB; (void)W_OUT; (void)PART; (void)HI; (void)LO; (void)RR; (void)Y; (void)PROJ; (void)QB; (void)KVB;
    unsigned* ctl = (unsigned*)(args.ws + WS_CTL);

    for (int u = threadIdx.x; u < (LDS_BYTES - LDSCTL_OFF) / 4; u += NWAVES * 64) ((LAS unsigned*)(lds + LDSCTL_OFF))[u] = 0u;
    __syncthreads();
    XcdBarrier bar = xcd_barrier_post(ctl + CW_BAR, MISC + 8);
    const int lo = args.ph_lo, hi = args.ph_hi;
    int pc = 0;
#define PH_RUN() (pc >= lo && pc < hi)
#define PH_END() do { if (pc >= lo && pc + 1 < hi) xcd_barrier(bar, wave_k); ++pc; } while (0)

#pragma unroll 1
    for (int j = 0; j < 2; ++j) {
        const int la = 2 * j, lb = 2 * j + 1;
        if (PH_RUN()) { PH_PTRS
            if (j == 0) CONV_A(0);
            const bf16* DL = (const bf16*)(ws + WS_Q);
            if (j == 0) { XROW_FOR(m) xrow_first(x_in + (size_t)m * D_MODEL, HI + (size_t)m * D_MODEL, RR + m, lane); }
            else { XROW_FOR(m) xrow_hl(HI + (size_t)m * D_MODEL, LO + (size_t)m * D_MODEL, DL + (size_t)m * D_MODEL, RR + m, lane); }
            if (j == 0) {
                for (int m = gw; m < M_MEM; m += NGW) rms_row_bf16(mem_in + (size_t)m * D_MODEL, nullptr, nullptr, HI + (size_t)(M_TOK + m) * D_MODEL, lane);
                for (int e = (vcu * NWAVES * 64) + tid; e < M_TOK * 32; e += G * NWAVES * 64) {
                    const int tok = e >> 5, i = e & 31;
                    const float inv = INVF[i];
                    const float ang = (float)pos_in[tok] * inv;
                    const double rev = (double)ang * 0.15915494309189535; const double fr = rev - rint(rev);
                    const float rad = (float)(fr * 6.283185307179586);
                    cosT[e] = cosf(rad); sinT[e] = sinf(rad);
                }
                for (int e = (vcu * NWAVES * 64) + tid; e < 49 * 320; e += G * NWAVES * 64) { const int h = e / 320, d = e - h * 320 - 96;
                    bias2[e] = (h < 48 && (unsigned)d < 128u) ? rel_bias[(int)T5B[d] * 48 + h] * LOG2E : -__builtin_inff(); }
            }
        }
        PH_END();
        if (PH_RUN()) { PH_PTRS
            pg8::Gemm g{HI, W_IN, D_MODEL, D_MODEL, D_MODEL}; pg8::SchedAin S; S.o.init(64, 27, 64, G, bx);
            pg8::Unit u0; u0.pm = 0; u0.pn = 0; (void)S.o.next(0, u0);
            LAS float* rrl = (LAS float*)(lds + RRL_OFF); if (tid < 256) rrl[tid] = RR[u0.pm * 256 + tid]; __syncthreads();
            pg8::EpiAin E{PROJ, MKV, cosT, sinT, RR, rrl, u0.pm, PART};
            pg8::gemm_phase<pg8::EpiAin, pg8::SchedAin, true, true>(lds, g, S, E, tid);
        }
        PH_END();
        if (PH_RUN()) { PH_PTRS
            pg8::Unit u0; u0.pm = 0; u0.pn = 0; { pg8::StaticOrder o; o.init(64, QW / 256, 0, G, bx); (void)o.next(0, u0); }
            LAS float* rrq = (LAS float*)(lds + RRL_OFF); LAS float* rrk = rrq + 256;
            { const int r = tid >> 1, hs = tid & 1; const GAS f32x4* p4 = (const GAS f32x4*)(PART + (size_t)(u0.pm * 256 + r) * 48);
              float sq = 0.f, sk = 0.f;
#pragma unroll
              for (int i = 0; i < 4; ++i) { const f32x4 a = p4[hs * 4 + i]; sq += (a.x + a.y) + (a.z + a.w); }
#pragma unroll
              for (int i = 0; i < 2; ++i) { const f32x4 a = p4[8 + hs * 2 + i]; sk += (a.x + a.y) + (a.z + a.w); }
              sq += shx(sq, lane, 1); sk += shx(sk, lane, 1);
              if (hs == 0) { rrq[r] = 1.0f / sqrtf(sq * (1.f / 1024.f) + EPS); rrk[r] = 1.0f / sqrtf(sk * (1.f / 512.f) + EPS); }
              __syncthreads(); }
            { pg8::Gemm g{PROJ + A_OFF_CQ, W_QB, A_LDP, 1024, 1024}; pg8::SchedPlain S; S.o.init(64, QW / 256, 0, G, bx);
              pg8::EpiQ E{QB, cosT, sinT, PART, rrq, u0.pm}; pg8::gemm_phase<pg8::EpiQ, pg8::SchedPlain, true, true>(lds, g, S, E, tid); }
            { pg8::Gemm g{PROJ + A_OFF_CKV, W_KVB, A_LDP, 512, 512}; pg8::SchedKV S; S.o.init(64, KVW / 256, 0, G, bx);
              pg8::EpiKV E{KVB, PART, rrk, u0.pm}; pg8::gemm_phase<pg8::EpiKV, pg8::SchedKV, true, true>(lds, g, S, E, tid); }
        }
        PH_END();
        if (PH_RUN()) { PH_PTRS
#pragma unroll 1
            for (int P = vcu; P < 768; P += G) {
                const int bh = P >> 3, xq = P & 7, b = bh / 24, h = bh % 24;
#pragma unroll 1
                for (int pass = 0; pass < 2; ++pass) {
                    const int qb = pass ? 15 - xq : xq; const size_t rows0 = (size_t)b * SEQ + qb * 256 + wave * 32, kr0 = (size_t)b * SEQ;
                    att::mla_core_dma((LAS char*)lds, QB + rows0 * QW + h * 192, QW, KVB + kr0 * KVW + h * 256, KVW, PROJ + kr0 * A_LDP + A_OFF_KR, A_LDP,
                                  KVB + kr0 * KVW + h * 256 + 128, KVW, 4 * (qb + 1), qb * 256 + wave * 32,
                                  PROJ + rows0 * A_LDP + A_OFF_Z + h * 128, A_LDP, Y + rows0 * D_MODEL + h * 128, D_MODEL, fresh_tid(wave_k));
                }
            }
#pragma unroll 1
            for (int U = vcu; U < 256; U += G) {
                const int qb = U & 15, xh = (U >> 4) & 3, b = U >> 6; const size_t rows0 = (size_t)b * SEQ + qb * 256 + wave * 32;
                const bf16* mk = MKV + (size_t)(b * N_MEM) * 2048; const int yc = 3072 + xh * 256;
                att::mem_core2((LAS char*)lds, PROJ + rows0 * A_LDP + A_OFF_XQ + xh * 256, A_LDP, mk + xh * 256, 2048, mk + 1024 + xh * 256, 2048,
                                  PROJ + rows0 * A_LDP + A_OFF_Z + yc, A_LDP, Y + rows0 * D_MODEL + yc, D_MODEL, fresh_tid(wave_k));
            }
        }
        PH_END();
        if (PH_RUN()) { PH_PTRS
            pg8::Gemm g{Y, (bf16*)(ws + WS_WOUT), D_MODEL, D_MODEL, D_MODEL};
            pg8::EpiPlain E{(bf16*)(ws + WS_Q), D_MODEL};
            const int nb = (bx & 7) & 3;
            { pg8::SchedRange S; S.o.init(64, 16, 0, G, bx); S.i0 = 0; S.n = nb; pg8::gemm_phase<pg8::EpiPlain, pg8::SchedRange, true, true>(lds, g, S, E, tid); }
            CONV_B(j); __syncthreads();
            { pg8::SchedRange S; S.o.init(64, 16, 0, G, bx); S.i0 = nb; S.n = 1 << 30; pg8::gemm_phase<pg8::EpiPlain, pg8::SchedRange, true, true>(lds, g, S, E, tid); }
        }
        PH_END();
        if (PH_RUN()) { PH_PTRS
            { const bf16* DL = (const bf16*)(ws + WS_Q);
              if (j == 0) { XROW_FOR(m) xrow_f32(x_in + (size_t)m * D_MODEL, DL + (size_t)m * D_MODEL, HI + (size_t)m * D_MODEL, LO + (size_t)m * D_MODEL, RR + m, lane); }
              else { XROW_FOR(m) xrow_hl(HI + (size_t)m * D_MODEL, LO + (size_t)m * D_MODEL, DL + (size_t)m * D_MODEL, RR + m, lane); } }
        }
        PH_END();
        if (PH_RUN()) { PH_PTRS
            pg8::Gemm g{HI, W_IN, D_MODEL, D_MODEL, D_MODEL}; pg8::SchedPlain S; S.o.init(64, B_IN / 256, 0, G, bx);
            pg8::Unit u0; u0.pm = 0; u0.pn = 0; (void)S.o.next(0, u0);
            LAS float* rrl = (LAS float*)(lds + RRL_OFF); if (tid < 256) rrl[tid] = RR[u0.pm * 256 + tid]; __syncthreads();
            pg8::EpiBin E{PROJ, RR, rrl, u0.pm};
            pg8::gemm_phase<pg8::EpiBin, pg8::SchedPlain, true, true>(lds, g, S, E, tid);
        }
        PH_END();
        if (PH_RUN()) { PH_PTRS
            { att::swa_phase((LAS char*)lds, PROJ, Y, bias2, b_sinks + j * 48, vcu, G, tid); }
#pragma unroll 1
            for (int U = vcu; U < 256; U += G) {
                const int qb = U & 15, xh = (U >> 4) & 3, b = U >> 6; const size_t rows0 = (size_t)b * SEQ + qb * 256 + wave * 32;
                const bf16* mk = MKV + (size_t)M_MEM * 2048 + (size_t)(b * N_MEM) * 2048; const int yc = 3072 + xh * 256;
                att::mem_core2((LAS char*)lds, PROJ + rows0 * B_IN + B_OFF_XQ + xh * 256, B_IN, mk + xh * 256, 2048, mk + 1024 + xh * 256, 2048,
                                  PROJ + rows0 * B_IN + B_OFF_Z + yc, B_IN, Y + rows0 * D_MODEL + yc, D_MODEL, fresh_tid(wave_k));
            }
        }
        PH_END();
        if (PH_RUN()) { PH_PTRS
            pg8::Gemm g{Y, (bf16*)(ws + WS_WOUT2), D_MODEL, D_MODEL, D_MODEL};
            pg8::EpiPlain E{(bf16*)(ws + WS_Q), D_MODEL};
            const int nb = (bx & 7) & 3;
            { pg8::SchedRange S; S.o.init(64, 16, 0, G, bx); S.i0 = 0; S.n = nb; pg8::gemm_phase<pg8::EpiPlain, pg8::SchedRange, true, true>(lds, g, S, E, tid); }
            if (j == 0) CONV_A(1);
            __syncthreads();
            { pg8::SchedRange S; S.o.init(64, 16, 0, G, bx); S.i0 = nb; S.n = 1 << 30; pg8::gemm_phase<pg8::EpiPlain, pg8::SchedRange, true, true>(lds, g, S, E, tid); }
        }
        PH_END();
    }
    if (PH_RUN()) { PH_PTRS XROW_FOR(m) xrow_final(out + (size_t)m * D_MODEL, HI + (size_t)m * D_MODEL, LO + (size_t)m * D_MODEL, (const bf16*)(ws + WS_Q) + (size_t)m * D_MODEL, final_g, lane); }
#undef PH_RUN
#undef PH_END
}

constexpr int N_PHASES = 19;
extern "C" void kernel_launch(void* const* d_in, const int* in_sizes, int n_in, void* d_out, int out_size, void* d_ws, size_t ws_size, hipStream_t stream) {
    static int grid = 0;
    if (grid == 0) {
        if (n_in != 16 || in_sizes[0] != M_TOK * D_MODEL || out_size != M_TOK * D_MODEL || ws_size < WS_END) {
            fprintf(stderr, "kernel_launch: unexpected shapes (n_in %d, in0 %d, out %d, ws %zu)\n", n_in, n_in > 0 ? in_sizes[0] : -1, out_size, ws_size); grid = -1; return; }
        int dev = 0, cus = 0, per_cu = 0;
        if (hipGetDevice(&dev) != hipSuccess || hipDeviceGetAttribute(&cus, hipDeviceAttributeMultiprocessorCount, dev) != hipSuccess) { grid = -1; return; }
        if (hipFuncSetAttribute((const void*)fwd_kernel, hipFuncAttributeMaxDynamicSharedMemorySize, LDS_BYTES) != hipSuccess) { fprintf(stderr, "kernel_launch: hipFuncSetAttribute failed\n"); grid = -1; return; }
        if (hipOccupancyMaxActiveBlocksPerMultiprocessor(&per_cu, (const void*)fwd_kernel, NWAVES * 64, LDS_BYTES) != hipSuccess || per_cu < 1)
            fprintf(stderr, "kernel_launch: note: occupancy query reports %d workgroups per CU\n", per_cu);
        (void)hipGetLastError();
        grid = cus;
    }
    if (grid < 0) return;
    if (hipMemsetAsync((char*)d_ws + WS_CTL, 0, CTL_ZERO_BYTES, stream) != hipSuccess) return;
    Args a{};
    for (int i = 0; i < 16; ++i) a.in[i] = (const float*)d_in[i];
    a.out = (float*)d_out; a.ws = (unsigned char*)d_ws;
#if defined(MK_PER_PHASE)
    for (int p = 0; p < N_PHASES; ++p) { a.ph_lo = p; a.ph_hi = p + 1; hipLaunchKernelGGL(fwd_kernel, dim3(grid), dim3(NWAVES * 64), LDS_BYTES, stream, a); }
#else
    a.ph_lo = 0; a.ph_hi = N_PHASES;
    hipLaunchKernelGGL(fwd_kernel, dim3(grid), dim3(NWAVES * 64), LDS_BYTES, stream, a);
#endif
    const hipError_t le = hipPeekAtLastError();
    if (le != hipSuccess) fprintf(stderr, "kernel_launch: launch failed: %s\n", hipGetErrorName(le));
}
```
